# Optimizing an MI355X kernel written in HIP

```python
import jax, jax.numpy as jnp
from jax import lax
import numpy as np

D_MODEL = 1024
BATCH = 4
SEQ = 8192
DEPTH = 4

GRID_W = 64
CTX_LEN = 256
N_MIXERS = 2
N_RET_LAYERS = (DEPTH + 1) // 2
N_MLA_LAYERS = DEPTH // 2
RET_HEADS = 4
RET_DK = D_MODEL // RET_HEADS
RET_DV = 2 * RET_DK
RET_CHUNK = 128
RET_THETA_BASE = 10000.0
RET_IN_COLS = 2 * RET_HEADS * RET_DK + 3 * RET_HEADS * RET_DV
MLA_HEADS = 8
MLA_NOPE = 128
MLA_ROPE = 64
MLA_V = 128
MLA_Q_LORA = 384
MLA_KV_LORA = 256
MLA_IN_COLS = MLA_Q_LORA + MLA_KV_LORA + MLA_ROPE
ROPE_BASE = 10000.0
Q_BLOCK = 128
N_EXPERTS = 32
TOP_K = 4
D_FF = D_MODEL
SWIGLU_ALPHA = 1.702
SWIGLU_LIMIT = 7.0
EPS = 1e-6
GN_EPS = 1e-5

kernel_name = "hybrid_retention_mla_moe_diffusion_trunk"


def rmsnorm(x, g):
    xf = x.astype(jnp.float32)
    xf = xf * lax.rsqrt(jnp.mean(xf * xf, axis=-1, keepdims=True) + EPS)
    return xf.astype(x.dtype) * g


def group_norm_heads(y, g):
    B, L, H, DV = y.shape
    yf = y.astype(jnp.float32)
    mu = jnp.mean(yf, axis=-1, keepdims=True)
    var = jnp.mean(jnp.square(yf - mu), axis=-1, keepdims=True)
    out = (yf - mu) * lax.rsqrt(var + GN_EPS)
    return out.reshape(B, L, H * DV).astype(y.dtype) * g


def modulate(h, shift, scale):
    return h * (1.0 + scale) + shift


def apply_rotary(x, ang):
    cos = jnp.cos(ang).astype(x.dtype)
    sin = jnp.sin(ang).astype(x.dtype)
    x1, x2 = jnp.split(x, 2, axis=-1)
    return jnp.concatenate([x1 * cos - x2 * sin, x1 * sin + x2 * cos], axis=-1)


def chunk_retention(q, k, v, log_g, s0):
    B, L, H, _ = q.shape
    DV = v.shape[-1]
    n = L // RET_CHUNK

    def to_chunks(t):
        return t.reshape(B, n, RET_CHUNK, H, t.shape[-1]).transpose(1, 0, 3, 2, 4)

    pos = jnp.arange(RET_CHUNK, dtype=jnp.float32)
    lg = log_g[:, None]
    q_decay = jnp.exp(lg * (pos + 1.0)).astype(q.dtype)
    k_decay = jnp.exp(lg * (RET_CHUNK - 1.0 - pos)).astype(q.dtype)
    rel = pos[:, None] - pos[None, :]
    d_mask = jnp.where(rel >= 0, jnp.exp(lg[:, :, None] * jnp.maximum(rel, 0.0)), 0.0).astype(q.dtype)
    chunk_decay = jnp.exp(log_g * RET_CHUNK).astype(q.dtype)

    def step(s, qkv):
        qi, ki, vi = qkv
        scores = jnp.einsum('bhid,bhjd->bhij', qi, ki) * d_mask
        o = (jnp.einsum('bhij,bhjv->bhiv', scores, vi)
             + jnp.einsum('bhid,bhdv->bhiv', qi * q_decay[..., None], s))
        s = s * chunk_decay[:, None, None] + jnp.einsum('bhjd,bhjv->bhdv', ki * k_decay[..., None], vi)
        return s, o

    s_final, o = lax.scan(step, s0, (to_chunks(q), to_chunks(k), to_chunks(v)))
    o = o.transpose(1, 0, 3, 2, 4).reshape(B, L, H, DV)
    return o, s_final


def retention_mixer(h_ctx, h_lat, w_in, decay_logit, gn_g, w_out, ang_lat, need_ctx):
    def project(h, ang):
        B, L, _ = h.shape
        p = h @ w_in
        q, k, v, g_f, g_b = jnp.split(p, np.cumsum([RET_HEADS * RET_DK, RET_HEADS * RET_DK,
                                                     RET_HEADS * RET_DV, RET_HEADS * RET_DV]).tolist(), axis=-1)
        q = q.reshape(B, L, RET_HEADS, RET_DK)
        k = k.reshape(B, L, RET_HEADS, RET_DK) * (RET_DK ** -0.5)
        v = v.reshape(B, L, RET_HEADS, RET_DV)
        if ang is not None:
            q = apply_rotary(q, ang[:, None, :])
            k = apply_rotary(k, ang[:, None, :])
        return q, k, v, g_f, g_b

    q_c, k_c, v_c, gf_c, gb_c = project(h_ctx, None)
    q_l, k_l, v_l, gf_l, gb_l = project(h_lat, ang_lat)
    B = h_lat.shape[0]
    log_g = jax.nn.log_sigmoid(decay_logit.astype(jnp.float32))
    s_zero = jnp.zeros((B, RET_HEADS, RET_DK, RET_DV), dtype=q_l.dtype)
    flip = lambda t: t[:, ::-1]

    o_cf, s_cf = chunk_retention(q_c, k_c, v_c, log_g[0], s_zero)
    o_lf, _ = chunk_retention(q_l, k_l, v_l, log_g[0], s_cf)
    o_cb, s_cb = chunk_retention(flip(q_c), flip(k_c), flip(v_c), log_g[1], s_zero)
    o_lb, _ = chunk_retention(flip(q_l), flip(k_l), flip(v_l), log_g[1], s_cb)
    o_cb, o_lb = flip(o_cb), flip(o_lb)

    def merge(o_f, o_b, g_f, g_b):
        y = jax.nn.silu(g_f) * group_norm_heads(o_f, gn_g[0]) + jax.nn.silu(g_b) * group_norm_heads(o_b, gn_g[1])
        return y @ w_out

    y_lat = merge(o_lf, o_lb, gf_l, gb_l)
    y_ctx = merge(o_cf, o_cb, gf_c, gb_c) if need_ctx else None
    return y_ctx, y_lat


def mla_mixer(h_ctx, h_lat, w_in, q_norm, kv_norm, w_uq, w_ukv, w_out, ang_lat, need_ctx):
    def project(h, ang):
        B, L, _ = h.shape
        p = h @ w_in
        c_q, c_kv, k_r = jnp.split(p, [MLA_Q_LORA, MLA_Q_LORA + MLA_KV_LORA], axis=-1)
        c_q = rmsnorm(c_q, q_norm)
        c_kv = rmsnorm(c_kv, kv_norm)
        q = (c_q @ w_uq).reshape(B, L, MLA_HEADS, MLA_NOPE + MLA_ROPE)
        kv = (c_kv @ w_ukv).reshape(B, L, MLA_HEADS, MLA_NOPE + MLA_V)
        q_nope, q_rope = jnp.split(q, [MLA_NOPE], axis=-1)
        k_nope, v = jnp.split(kv, [MLA_NOPE], axis=-1)
        if ang is not None:
            q_rope = apply_rotary(q_rope, ang[:, None, :])
            k_r = apply_rotary(k_r, ang)
        k_r = jnp.broadcast_to(k_r[:, :, None, :], (B, L, MLA_HEADS, MLA_ROPE))
        q = jnp.concatenate([q_nope, q_rope], axis=-1)
        k = jnp.concatenate([k_nope, k_r], axis=-1)
        return q, k, v

    scale = (MLA_NOPE + MLA_ROPE) ** -0.5
    q_c, k_c, v_c = project(h_ctx, None)
    q_l, k_l, v_l = project(h_lat, ang_lat)

    def attend(q, k, v):
        s = jnp.einsum('bqhd,bkhd->bhqk', q, k).astype(jnp.float32) * scale
        p = jax.nn.softmax(s, axis=-1).astype(v.dtype)
        return jnp.einsum('bhqk,bkhd->bqhd', p, v)

    B, L = h_lat.shape[0], h_lat.shape[1]
    k_all = jnp.concatenate([k_c, k_l], axis=1)
    v_all = jnp.concatenate([v_c, v_l], axis=1)
    n_blk = L // Q_BLOCK
    q_blocks = q_l.reshape(B, n_blk, Q_BLOCK, MLA_HEADS, MLA_NOPE + MLA_ROPE).transpose(1, 0, 2, 3, 4)
    o_l = lax.map(lambda qb: attend(qb, k_all, v_all), q_blocks)
    o_l = o_l.transpose(1, 0, 2, 3, 4).reshape(B, L, MLA_HEADS * MLA_V)
    y_lat = o_l @ w_out
    y_ctx = None
    if need_ctx:
        o_c = attend(q_c, k_c, v_c).reshape(B, h_ctx.shape[1], MLA_HEADS * MLA_V)
        y_ctx = o_c @ w_out
    return y_ctx, y_lat


def moe_ffn(h, router_w, router_b, w_up, b_up, w_down, b_down):
    shp = h.shape
    t = h.reshape(-1, shp[-1])
    logits = (t @ router_w + router_b).astype(jnp.float32)
    top_v, top_i = lax.top_k(logits, TOP_K)
    probs = jax.nn.softmax(top_v, axis=-1)
    gates = jnp.sum(jax.nn.one_hot(top_i, N_EXPERTS, dtype=jnp.float32) * probs[..., None], axis=1).astype(t.dtype)
    out = jnp.zeros_like(t)
    for e in range(N_EXPERTS):
        u = t @ w_up[e] + b_up[e]
        glu, lin = jnp.split(u, 2, axis=-1)
        glu = jnp.minimum(glu, SWIGLU_LIMIT)
        lin = jnp.clip(lin, -SWIGLU_LIMIT, SWIGLU_LIMIT)
        act = glu * jax.nn.sigmoid(SWIGLU_ALPHA * glu) * (lin + 1.0)
        out = out + gates[:, e:e + 1] * (act @ w_down[e] + b_down[e])
    return out.reshape(shp)


def setup_inputs(seed: int = 0) -> dict:
    key = jax.random.key(seed)
    ks = jax.random.split(key, 32)
    f32 = jnp.float32
    nrm = lambda k, shp, s: jax.random.normal(k, shp, f32) * s
    D = D_MODEL
    base_logit = jnp.log(2.0 ** (5.0 + jnp.arange(RET_HEADS, dtype=f32)) - 1.0)
    return {
        'x': nrm(ks[0], (BATCH, SEQ, D), 1.0),
        'c': nrm(ks[1], (BATCH, D), 1.0),
        'ctx': nrm(ks[2], (BATCH, CTX_LEN, D), 1.0),
        'c_ctx': nrm(ks[3], (D,), 0.5),
        'ret_w_in': nrm(ks[4], (N_RET_LAYERS, D, RET_IN_COLS), D ** -0.5),
        'ret_decay_logit': base_logit[None, None, :] + nrm(ks[5], (N_RET_LAYERS, 2, RET_HEADS), 0.1),
        'ret_gn': 1.0 + nrm(ks[6], (N_RET_LAYERS, 2, RET_HEADS * RET_DV), 0.02),
        'ret_w_out': nrm(ks[7], (N_RET_LAYERS, RET_HEADS * RET_DV, D), (RET_HEADS * RET_DV) ** -0.5),
        'mla_w_in': nrm(ks[8], (N_MLA_LAYERS, D, MLA_IN_COLS), D ** -0.5),
        'mla_q_norm': 1.0 + nrm(ks[9], (N_MLA_LAYERS, MLA_Q_LORA), 0.02),
        'mla_kv_norm': 1.0 + nrm(ks[10], (N_MLA_LAYERS, MLA_KV_LORA), 0.02),
        'mla_w_uq': nrm(ks[11], (N_MLA_LAYERS, MLA_Q_LORA, MLA_HEADS * (MLA_NOPE + MLA_ROPE)), MLA_Q_LORA ** -0.5),
        'mla_w_ukv': nrm(ks[12], (N_MLA_LAYERS, MLA_KV_LORA, MLA_HEADS * (MLA_NOPE + MLA_V)), MLA_KV_LORA ** -0.5),
        'mla_w_out': nrm(ks[13], (N_MLA_LAYERS, MLA_HEADS * MLA_V, D), (MLA_HEADS * MLA_V) ** -0.5),
        'ada_w': nrm(ks[14], (DEPTH, D, 6 * D), 0.5 * D ** -0.5),
        'ada_b': nrm(ks[15], (DEPTH, 6 * D), 0.02),
        'norm_mix': 1.0 + nrm(ks[16], (DEPTH, D), 0.02),
        'norm_ffn': 1.0 + nrm(ks[17], (DEPTH, D), 0.02),
        'router_w': nrm(ks[18], (DEPTH, D, N_EXPERTS), D ** -0.5),
        'router_b': nrm(ks[19], (DEPTH, N_EXPERTS), 0.01),
        'exp_w_up': nrm(ks[20], (DEPTH, N_EXPERTS, D, 2 * D_FF), D ** -0.5),
        'exp_b_up': nrm(ks[21], (DEPTH, N_EXPERTS, 2 * D_FF), 0.02),
        'exp_w_down': nrm(ks[22], (DEPTH, N_EXPERTS, D_FF, D), D_FF ** -0.5),
        'exp_b_down': nrm(ks[23], (DEPTH, N_EXPERTS, D), 0.02),
        'final_norm': 1.0 + nrm(ks[24], (D,), 0.02),
    }


def reference(x, c, ctx, c_ctx, ret_w_in, ret_decay_logit, ret_gn, ret_w_out, mla_w_in, mla_q_norm,
              mla_kv_norm, mla_w_uq, mla_w_ukv, mla_w_out, ada_w, ada_b, norm_mix, norm_ffn, router_w,
              router_b, exp_w_up, exp_b_up, exp_w_down, exp_b_down, final_norm):
    B, L, D = x.shape
    rows = L // GRID_W
    row = jnp.broadcast_to(jnp.arange(rows, dtype=jnp.float32)[:, None], (rows, GRID_W)).reshape(-1)
    col = jnp.broadcast_to(jnp.arange(GRID_W, dtype=jnp.float32)[None, :], (rows, GRID_W)).reshape(-1)
    n_ax = MLA_ROPE // 4
    ax_freq = ROPE_BASE ** (-jnp.arange(n_ax, dtype=jnp.float32) / n_ax)
    ang_mla = jnp.concatenate([row[:, None] * ax_freq, col[:, None] * ax_freq], axis=-1)
    ret_theta = 1.0 / (RET_THETA_BASE ** jnp.linspace(0.0, 1.0, RET_DK // 2, dtype=jnp.float32))
    ang_ret = jnp.arange(L, dtype=jnp.float32)[:, None] * ret_theta[None, :]

    sc_lat = jax.nn.silu(c)
    sc_ctx = jax.nn.silu(c_ctx)
    x_lat, x_ctx = x, ctx
    for layer in range(DEPTH):
        last = layer == DEPTH - 1
        j = layer // N_MIXERS
        mod_l = jnp.split((sc_lat @ ada_w[layer] + ada_b[layer])[:, None, :], 6, axis=-1)
        mod_c = jnp.split(sc_ctx @ ada_w[layer] + ada_b[layer], 6, axis=-1)
        sh1_l, s1_l, g1_l, sh2_l, s2_l, g2_l = mod_l
        sh1_c, s1_c, g1_c, sh2_c, s2_c, g2_c = mod_c

        h_lat = modulate(rmsnorm(x_lat, norm_mix[layer]), sh1_l, s1_l)
        h_ctx = modulate(rmsnorm(x_ctx, norm_mix[layer]), sh1_c, s1_c)
        if layer % N_MIXERS == 0:
            y_ctx, y_lat = retention_mixer(h_ctx, h_lat, ret_w_in[j], ret_decay_logit[j], ret_gn[j],
                                           ret_w_out[j], ang_ret, not last)
        else:
            y_ctx, y_lat = mla_mixer(h_ctx, h_lat, mla_w_in[j], mla_q_norm[j], mla_kv_norm[j], mla_w_uq[j],
                                     mla_w_ukv[j], mla_w_out[j], ang_mla, not last)
        x_lat = x_lat + g1_l * y_lat

        h_lat = modulate(rmsnorm(x_lat, norm_ffn[layer]), sh2_l, s2_l)
        moe_args = (router_w[layer], router_b[layer], exp_w_up[layer], exp_b_up[layer],
                    exp_w_down[layer], exp_b_down[layer])
        if last:
            x_lat = x_lat + g2_l * moe_ffn(h_lat, *moe_args)
        else:
            x_ctx = x_ctx + g1_c * y_ctx
            h_ctx = modulate(rmsnorm(x_ctx, norm_ffn[layer]), sh2_c, s2_c)
            f = moe_ffn(jnp.concatenate([h_ctx, h_lat], axis=1), *moe_args)
            x_ctx = x_ctx + g2_c * f[:, :CTX_LEN]
            x_lat = x_lat + g2_l * f[:, CTX_LEN:]
    return rmsnorm(x_lat, final_norm)
```

```cpp
#include <hip/hip_runtime.h>
#include <cstdio>
#include <cstdint>
#include <cmath>
namespace pg8 {
#define PG8_LAS __attribute__((address_space(3)))
typedef unsigned short bf16_t;
typedef short bf16x8 __attribute__((ext_vector_type(8)));
typedef float f32x4 __attribute__((ext_vector_type(4)));
typedef unsigned u32x4 __attribute__((ext_vector_type(4)));
typedef unsigned u32x2 __attribute__((ext_vector_type(2)));
constexpr int BM = 256, BK = 64, HALF = 128, HTB = HALF * BK * 2, STAGE_BYTES = 8 * HTB, NXCD = 8, WGM = 8;
__host__ __device__ __forceinline__ int lds_byte(int r, int c) { const int st = (r >> 4) * 2 + (c >> 5), rr = r & 15, cc = c & 31, ob = rr * 64 + cc * 2; return st * 1024 + (ob ^ (((ob >> 9) & 1) << 5)); }
__host__ __device__ __forceinline__ void stage_rc(int b, int& R, int& C) { const int st = b / 1024, sb = b % 1024, swz = sb ^ (((sb >> 9) & 1) << 5); R = (st >> 1) * 16 + swz / 64; C = (st & 1) * 32 + (swz % 64) / 2; }
__host__ __device__ __forceinline__ int perm32(int rho) { const int n = rho >> 4, i = rho & 15; return 8 * (i >> 2) + 4 * n + (i & 3); }
struct Unit { int pm, pn, pc; };
struct Gemm { const bf16_t* A; const bf16_t* Bt; int K, lda, ldb; };
struct StaticOrder {
    int nM, nN, nwg, G, c;
    __host__ __device__ void init(int M, int N, int G_, int c_) { nM = M / BM; nN = N / BM; nwg = nM * nN; G = G_; c = c_; }
    __host__ __device__ bool next(int i, Unit& u) const {
        const long L = (long)i * G + c; if (L >= nwg) return false;
        int wgid = (int)L; { const int q = nwg / NXCD, r = nwg % NXCD, xcd = wgid % NXCD, off = wgid / NXCD; wgid = (xcd < r ? xcd * (q + 1) : r * (q + 1) + (xcd - r) * q) + off; }
        const int nig = WGM * nN, gid = wgid / nig, fm = gid * WGM, gsz = (nM - fm) < WGM ? (nM - fm) : WGM;
        u.pm = fm + ((wgid % nig) % gsz); u.pn = (wgid % nig) / gsz; u.pc = u.pn; return true;
    }
    __device__ __forceinline__ void a_ready(const Unit&) const {}
    __device__ __forceinline__ void done(const Unit&) const {}
};
__device__ __forceinline__ unsigned cvt_pk_bf16(float lo, float hi) { unsigned r; asm volatile("v_cvt_pk_bf16_f32 %0, %1, %2" : "=v"(r) : "v"(lo), "v"(hi)); return r; }

struct EpiF32 {
    static constexpr bool PERM = false, AFTER_DRAIN = false;
    float* C; int ldc; const float* bias; int npg; int bstride;
    __device__ __forceinline__ void operator()(const f32x4 (&acc)[2][2][4][2], const Unit& u, int wr, int wc, int fr, int fq) const {
        const int row0 = u.pm * BM + wr * 64 + fr, col0 = u.pc * BM + wc * 32 + 4 * fq;
        const float* bp = bias ? bias + (size_t)(u.pn / npg) * bstride : nullptr;
        f32x4 bv[2][2];
#pragma unroll
        for (int bj = 0; bj < 2; ++bj)
#pragma unroll
            for (int n = 0; n < 2; ++n) bv[bj][n] = bp ? *(const f32x4*)(bp + col0 + bj * HALF + n * 16) : (f32x4){0.f, 0.f, 0.f, 0.f};
#pragma unroll
        for (int ai = 0; ai < 2; ++ai)
#pragma unroll
            for (int m = 0; m < 4; ++m) { float* rowp = C + (size_t)(row0 + ai * HALF + m * 16) * ldc + col0;
#pragma unroll
                for (int bj = 0; bj < 2; ++bj)
#pragma unroll
                    for (int n = 0; n < 2; ++n) *(f32x4*)(rowp + bj * HALF + n * 16) = acc[ai][bj][m][n] + bv[bj][n]; }
    }
};

template <class Epi, class Sched, bool ALIGN_EPI = false, bool SP2 = false>
__device__ __forceinline__ void gemm_phase(PG8_LAS unsigned char* lds, const Gemm g, const Sched& S, const Epi& E) {
    const int tid = threadIdx.x, wid = __builtin_amdgcn_readfirstlane(tid >> 6), lane = tid & 63, wr = wid >> 2, wc = wid & 3, fr = lane & 15, fq = lane >> 4;
    const int K = g.K, nt = K / BK;
    unsigned voffA[2], voffB[2];
#pragma unroll
    for (int i = 0; i < 2; ++i) { int R, C; stage_rc(tid * 16 + i * 8192, R, C); const int Rb = Epi::PERM ? ((R & ~31) + perm32(R & 31)) : R;
        voffA[i] = (unsigned)(R * g.lda + C) * 2u; voffB[i] = (unsigned)(Rb * g.ldb + C) * 2u; }
    const size_t kstep = (size_t)(BK * 2);
    const size_t hstepA = (size_t)HALF * g.lda * 2, hstepB = (size_t)HALF * g.ldb * 2;
    const size_t tstepA = 2 * hstepA, tstepB = 2 * hstepB;
    const unsigned ldsw = (unsigned)wid * 1024u;
    const int aoff = lds_byte(wr * 64 + fr, fq * 8), boff = lds_byte(wc * 32 + fr, fq * 8);
#define PG8_SA(b, h) (((b) * 2 + (h)) * HTB)
#define PG8_SB(b, h) ((4 + (b) * 2 + (h)) * HTB)
#define PG8_STAGE(bufoff, gbase, voff) do { _Pragma("unroll") for (int _i = 0; _i < 2; ++_i) \
        __builtin_amdgcn_global_load_lds((const unsigned*)((const char*)(gbase) + (voff)[_i]), (PG8_LAS unsigned*)(lds + (bufoff) + ldsw + _i * 8192), 16, 0, 0); } while (0)
#define PG8_LDA(dst, b, h) do { _Pragma("unroll") for (int m = 0; m < 4; ++m) _Pragma("unroll") for (int k = 0; k < 2; ++k) dst[m][k] = *(const PG8_LAS bf16x8*)(lds + PG8_SA(b, h) + aoff + m * 2048 + k * 1024); } while (0)
#define PG8_LDB(dst, b, h) do { _Pragma("unroll") for (int n = 0; n < 2; ++n) _Pragma("unroll") for (int k = 0; k < 2; ++k) dst[n][k] = *(const PG8_LAS bf16x8*)(lds + PG8_SB(b, h) + boff + n * 2048 + k * 1024); } while (0)
#define PG8_MMA(ai, bj, At, Bt) do { __builtin_amdgcn_s_setprio(1); _Pragma("unroll") for (int m = 0; m < 4; ++m) _Pragma("unroll") for (int n = 0; n < 2; ++n) _Pragma("unroll") for (int k = 0; k < 2; ++k) \
        acc[ai][bj][m][n] = __builtin_amdgcn_mfma_f32_16x16x32_bf16(Bt[n][k], At[m][k], acc[ai][bj][m][n], 0, 0, 0); __builtin_amdgcn_s_setprio(0); } while (0)
#define PG8_WAIT_V(n) asm volatile("s_waitcnt vmcnt(" #n ")" ::: "memory")
#define PG8_WAIT_L(n) asm volatile("s_waitcnt lgkmcnt(" #n ")" ::: "memory")
#define PG8_BAR __builtin_amdgcn_s_barrier()
#define PG8_SCHED __builtin_amdgcn_sched_barrier(0)
    Unit cur, nxt; int ui = 0;
    if (!S.next(0, cur)) return;
    f32x4 acc[2][2][4][2];
#pragma unroll
    for (int a = 0; a < 2; ++a)
#pragma unroll
        for (int b = 0; b < 2; ++b)
#pragma unroll
            for (int m = 0; m < 4; ++m)
#pragma unroll
                for (int n = 0; n < 2; ++n) acc[a][b][m][n] = (f32x4){0.f, 0.f, 0.f, 0.f};
    bf16x8 At[4][2], B0[2][2], B1[2][2];
    const char* cA = (const char*)g.A + (size_t)cur.pm * tstepA; const char* cB = (const char*)g.Bt + (size_t)cur.pn * tstepB;
    S.a_ready(cur);
    if constexpr (SP2) {
        PG8_STAGE(PG8_SB(0, 0), cB, voffB); PG8_STAGE(PG8_SB(0, 1), cB + hstepB, voffB); PG8_STAGE(PG8_SA(0, 0), cA, voffA); PG8_STAGE(PG8_SA(0, 1), cA + hstepA, voffA);
        if (wr == 1) PG8_BAR;
        PG8_WAIT_V(2); PG8_BAR;
        PG8_STAGE(PG8_SB(1, 0), cB + kstep, voffB); PG8_STAGE(PG8_SA(1, 0), cA + kstep, voffA); PG8_STAGE(PG8_SB(1, 1), cB + hstepB + kstep, voffB);
        PG8_WAIT_V(6); PG8_BAR;
    } else {
        PG8_STAGE(PG8_SB(0, 0), cB, voffB); PG8_STAGE(PG8_SA(0, 0), cA, voffA); PG8_STAGE(PG8_SB(0, 1), cB + hstepB, voffB); PG8_STAGE(PG8_SA(0, 1), cA + hstepA, voffA);
        if (wr == 1) PG8_BAR;
        PG8_WAIT_V(4); PG8_BAR;
        PG8_STAGE(PG8_SB(1, 0), cB + kstep, voffB); PG8_STAGE(PG8_SA(1, 0), cA + kstep, voffA); PG8_STAGE(PG8_SB(1, 1), cB + hstepB + kstep, voffB);
        PG8_WAIT_V(6); PG8_BAR;
    }
    for (;;) {
        const bool has_next = S.next(ui + 1, nxt);
        const char* nA = has_next ? (const char*)g.A + (size_t)nxt.pm * tstepA : cA; const char* nB = has_next ? (const char*)g.Bt + (size_t)nxt.pn * tstepB : cB;
        for (int t = 0; t < nt; t += 2) {
            const bool last = (t == nt - 2);
            const char* a1 = cA + (size_t)(t + 1) * kstep;
            const char* a2 = last ? nA : cA + (size_t)(t + 2) * kstep; const char* b2 = last ? nB : cB + (size_t)(t + 2) * kstep;
            const char* a3 = a2 + kstep; const char* b3 = b2 + kstep;
            if (last && has_next) S.a_ready(nxt);
            if constexpr (SP2) {
            PG8_LDB(B0, 0, 0); PG8_LDB(B1, 0, 1); PG8_SCHED; PG8_LDA(At, 0, 0); PG8_STAGE(PG8_SA(1, 1), a1 + hstepA, voffA);
            PG8_WAIT_V(8); PG8_WAIT_L(0); PG8_BAR; PG8_MMA(0, 0, At, B0); PG8_MMA(0, 1, At, B1); PG8_BAR; PG8_SCHED;
            PG8_LDA(At, 0, 1); PG8_STAGE(PG8_SB(0, 0), b2, voffB); PG8_STAGE(PG8_SB(0, 1), b2 + hstepB, voffB); PG8_STAGE(PG8_SA(0, 0), a2, voffA);
            PG8_WAIT_V(8); PG8_WAIT_L(0); PG8_BAR; PG8_MMA(1, 0, At, B0); PG8_MMA(1, 1, At, B1); PG8_BAR; PG8_SCHED;
            PG8_LDB(B0, 1, 0); PG8_LDB(B1, 1, 1); PG8_SCHED; PG8_LDA(At, 1, 0); PG8_STAGE(PG8_SA(0, 1), a2 + hstepA, voffA);
            PG8_WAIT_V(8); PG8_WAIT_L(0); PG8_BAR; PG8_MMA(0, 0, At, B0); PG8_MMA(0, 1, At, B1); PG8_BAR; PG8_SCHED;
            PG8_LDA(At, 1, 1); PG8_STAGE(PG8_SB(1, 0), b3, voffB); PG8_STAGE(PG8_SB(1, 1), b3 + hstepB, voffB); PG8_STAGE(PG8_SA(1, 0), a3, voffA);
            PG8_WAIT_V(8); PG8_WAIT_L(0); PG8_BAR; PG8_MMA(1, 0, At, B0); PG8_MMA(1, 1, At, B1); PG8_BAR; PG8_SCHED;
            } else {
            PG8_LDB(B0, 0, 0); PG8_SCHED; PG8_LDA(At, 0, 0); PG8_STAGE(PG8_SA(1, 1), a1 + hstepA, voffA);
            PG8_WAIT_L(8); PG8_BAR; PG8_WAIT_L(0); PG8_MMA(0, 0, At, B0); PG8_BAR; PG8_SCHED;
            PG8_LDB(B1, 0, 1); PG8_STAGE(PG8_SB(0, 0), b2, voffB);
            PG8_BAR; PG8_WAIT_L(0); PG8_MMA(0, 1, At, B1); PG8_BAR;
            PG8_LDA(At, 0, 1); PG8_STAGE(PG8_SA(0, 0), a2, voffA);
            PG8_BAR; PG8_WAIT_L(0); PG8_MMA(1, 0, At, B0); PG8_BAR; PG8_SCHED;
            PG8_STAGE(PG8_SB(0, 1), b2 + hstepB, voffB);
            PG8_WAIT_V(6); PG8_BAR; PG8_MMA(1, 1, At, B1); PG8_BAR;
            PG8_LDB(B0, 1, 0); PG8_SCHED; PG8_LDA(At, 1, 0); PG8_STAGE(PG8_SA(0, 1), a2 + hstepA, voffA);
            PG8_WAIT_L(8); PG8_BAR; PG8_WAIT_L(0); PG8_MMA(0, 0, At, B0); PG8_BAR; PG8_SCHED;
            PG8_LDB(B1, 1, 1); PG8_STAGE(PG8_SB(1, 0), b3, voffB);
            PG8_BAR; PG8_WAIT_L(0); PG8_MMA(0, 1, At, B1); PG8_BAR;
            PG8_LDA(At, 1, 1); PG8_STAGE(PG8_SA(1, 0), a3, voffA);
            PG8_BAR; PG8_WAIT_L(0); PG8_MMA(1, 0, At, B0); PG8_BAR; PG8_SCHED;
            PG8_STAGE(PG8_SB(1, 1), b3 + hstepB, voffB);
            PG8_WAIT_V(6); PG8_BAR; PG8_MMA(1, 1, At, B1); PG8_BAR;
            }
        }
        if constexpr (ALIGN_EPI) { if (wr == 0) PG8_BAR; }
        if constexpr (!Epi::AFTER_DRAIN) { E(acc, cur, wr, wc, fr, fq); S.done(cur); }
        if (!has_next) break;
#pragma unroll
        for (int a = 0; a < 2; ++a)
#pragma unroll
            for (int b = 0; b < 2; ++b)
#pragma unroll
                for (int m = 0; m < 4; ++m)
#pragma unroll
                    for (int n = 0; n < 2; ++n) acc[a][b][m][n] = (f32x4){0.f, 0.f, 0.f, 0.f};
        cur = nxt; cA = nA; cB = nB; ++ui;
        if constexpr (ALIGN_EPI) { if (wr == 1) PG8_BAR; }
    }
    PG8_WAIT_V(0);
    if constexpr (!ALIGN_EPI) { if (wr == 0) PG8_BAR; }
    PG8_BAR;
#undef PG8_SA
#undef PG8_SB
#undef PG8_STAGE
#undef PG8_LDA
#undef PG8_LDB
#undef PG8_MMA
#undef PG8_WAIT_V
#undef PG8_WAIT_L
#undef PG8_BAR
#undef PG8_SCHED
}
}
#define LAS __attribute__((address_space(3)))
typedef unsigned short bf16_t;
typedef short bf16x8 __attribute__((ext_vector_type(8)));
typedef float f32x4 __attribute__((ext_vector_type(4)));
typedef unsigned u32x4 __attribute__((ext_vector_type(4)));
typedef unsigned u32x2 __attribute__((ext_vector_type(2)));
constexpr int D = 1024, NB = 4, SEQ = 8192, CTXL = 256, LT = SEQ + CTXL, NTOK = NB * LT, DEPTH = 4;
constexpr int RH = 4, RDK = 256, RDV = 512, RIN = 8192;
constexpr int MH = 8, MQL = 384, MKVL = 256, MIN_ = 704, MINP = 768;
constexpr int NE = 32, TOPK = 4;
constexpr int MAXTILES = 560, MAXSLOTS = MAXTILES * 256;
constexpr float EPS = 1e-6f, GN_EPS = 1e-5f;

__device__ __forceinline__ unsigned f2bf(float f) { unsigned u = __builtin_bit_cast(unsigned, f); return (u + 0x7fffu + ((u >> 16) & 1u)) >> 16; }
__device__ __forceinline__ unsigned pk2(float lo, float hi) { return f2bf(lo) | (f2bf(hi) << 16); }
__device__ __forceinline__ float bf2f(unsigned short b) { return __builtin_bit_cast(float, (unsigned)b << 16); }
__device__ __forceinline__ float bflo(unsigned w) { return __builtin_bit_cast(float, w << 16); }
__device__ __forceinline__ float bfhi(unsigned w) { return __builtin_bit_cast(float, w & 0xffff0000u); }
__device__ __forceinline__ float wave_sum(float v) {
#pragma unroll
    for (int o = 1; o < 64; o <<= 1) v += __shfl_xor(v, o);
    return v;
}
__device__ __forceinline__ float wave_max(float v) {
#pragma unroll
    for (int o = 1; o < 64; o <<= 1) v = fmaxf(v, __shfl_xor(v, o));
    return v;
}
__device__ __forceinline__ float silu_f(float x) { return x / (1.0f + __expf(-x)); }
__device__ __forceinline__ void sincos_red(float ang, float& s, float& c) {
    const double a = (double)ang; const double n = rint(a * 0.15915494309189535); const float rf = (float)(a - n * 6.283185307179586);
    s = __sinf(rf); c = __cosf(rf);
}
__device__ __forceinline__ float ret_theta(int d) { return (float)exp2(-(double)d * (13.287712379549449 / 127.0)); }
__device__ __forceinline__ float ax_freq(int i) { return (float)exp2(-(double)i * (13.287712379549449 / 16.0)); }
struct GemmP { const bf16_t* A; const bf16_t* Bt; float* C; const float* bias; int M, N, K, lda, ldb, ldc; };
__global__ void __launch_bounds__(512, 2) k_gemm(GemmP p) {
    extern __shared__ __attribute__((aligned(16))) unsigned char lds[];
    pg8::Gemm g{p.A, p.Bt, p.K, p.lda, p.ldb};
    pg8::StaticOrder S; S.init(p.M, p.N, (int)gridDim.x, (int)blockIdx.x);
    pg8::EpiF32 E{p.C, p.ldc, p.bias, 1 << 30, 0};
    pg8::gemm_phase<pg8::EpiF32, pg8::StaticOrder, true, true>((LAS unsigned char*)lds, g, S, E);
}
struct MoeOrder {
    const int* plan; int nN, G, c;
    __device__ bool next(int i, pg8::Unit& u) const {
        const int T = plan[64]; const long L = (long)i * G + c; if (L >= (long)T * nN) return false;
        const int pm = (int)(L / nN), pcl = (int)(L % nN); const int e = plan[128 + pm];
        u.pm = pm; u.pn = e * nN + pcl; u.pc = pcl; return true;
    }
    __device__ __forceinline__ void a_ready(const pg8::Unit&) const {}
    __device__ __forceinline__ void done(const pg8::Unit&) const {}
};
struct MoeGemmP { const bf16_t* A; const bf16_t* Bt; float* C; const float* bias; const int* plan; int nN, K, ldc, bstride; };
__global__ void __launch_bounds__(512, 2) k_moe_gemm(MoeGemmP p) {
    extern __shared__ __attribute__((aligned(16))) unsigned char lds[];
    pg8::Gemm g{p.A, p.Bt, p.K, p.K, p.K};
    MoeOrder S{p.plan, p.nN, (int)gridDim.x, (int)blockIdx.x};
    pg8::EpiF32 E{p.C, p.ldc, p.bias, p.nN, p.bstride};
    pg8::gemm_phase<pg8::EpiF32, MoeOrder, true, true>((LAS unsigned char*)lds, g, S, E);
}

struct TrP { const float* src; bf16_t* dst; int K, N, ldd, nbatch; long sstride, dstride; };
__global__ void __launch_bounds__(512) k_transpose(TrP p) {
    __shared__ float tile[64][129];
    const int tid = threadIdx.x;
    const int nkb = p.K / 64, nnb = (p.N + 127) / 128; const long per = (long)nkb * nnb, ntl = per * p.nbatch;
    for (long it = blockIdx.x; it < ntl; it += gridDim.x) {
        const int bt = (int)(it / per), r = (int)(it % per), kb = r / nnb, nb = r % nnb, k0 = kb * 64, n0 = nb * 128;
        const float* s = p.src + (size_t)bt * p.sstride; bf16_t* d = p.dst + (size_t)bt * p.dstride;
#pragma unroll
        for (int i = 0; i < 16; ++i) { const int kk = i * 4 + (tid >> 7), nn = tid & 127; tile[kk][nn] = (n0 + nn < p.N) ? s[(size_t)(k0 + kk) * p.N + n0 + nn] : 0.f; }
        __syncthreads();
#pragma unroll
        for (int j = 0; j < 2; ++j) { const int nn = (tid >> 3) + 64 * j, c = tid & 7;
            if (n0 + nn < p.N) { u32x4 o; o.x = pk2(tile[8 * c][nn], tile[8 * c + 1][nn]); o.y = pk2(tile[8 * c + 2][nn], tile[8 * c + 3][nn]); o.z = pk2(tile[8 * c + 4][nn], tile[8 * c + 5][nn]); o.w = pk2(tile[8 * c + 6][nn], tile[8 * c + 7][nn]);
                *(u32x4*)(d + (size_t)(n0 + nn) * p.ldd + k0 + 8 * c) = o; } }
        __syncthreads();
    }
}
__global__ void k_zero16(u32x4* p, long n16) { for (long i = blockIdx.x * (long)blockDim.x + threadIdx.x; i < n16; i += (long)gridDim.x * blockDim.x) p[i] = (u32x4){0u, 0u, 0u, 0u}; }

__global__ void __launch_bounds__(512) k_adaln(const float* c, const float* c_ctx, const float* ada_w, const float* ada_b, float* MOD) {
    __shared__ float sv[5][1024]; __shared__ float red[8][5][64];
    const int tid = threadIdx.x;
    for (int i = tid; i < 5 * 1024; i += 512) { const int v = i >> 10, k = i & 1023; const float x = v < 4 ? c[v * 1024 + k] : c_ctx[k]; sv[v][k] = silu_f(x); }
    __syncthreads();
    for (int item = blockIdx.x; item < DEPTH * 96; item += gridDim.x) {
        const int l = item / 96, n0 = (item % 96) * 64, cc = tid & 63, ks = tid >> 6;
        const float* w = ada_w + (size_t)l * 1024 * 6144 + n0 + cc;
        float a0 = 0, a1 = 0, a2 = 0, a3 = 0, a4 = 0;
        for (int k = ks * 128; k < ks * 128 + 128; ++k) { const float wv = w[(size_t)k * 6144]; a0 += sv[0][k] * wv; a1 += sv[1][k] * wv; a2 += sv[2][k] * wv; a3 += sv[3][k] * wv; a4 += sv[4][k] * wv; }
        red[ks][0][cc] = a0; red[ks][1][cc] = a1; red[ks][2][cc] = a2; red[ks][3][cc] = a3; red[ks][4][cc] = a4;
        __syncthreads();
        if (tid < 320) { const int v = tid >> 6; float s = 0; for (int q = 0; q < 8; ++q) s += red[q][v][cc]; MOD[((size_t)l * 5 + v) * 6144 + n0 + cc] = s + ada_b[(size_t)l * 6144 + n0 + cc]; }
        __syncthreads();
    }
}
__global__ void k_rot_tables(float* COSR, float* SINR, float* COSM, float* SINM) {
    const long gt = blockIdx.x * (long)blockDim.x + threadIdx.x, NG = (long)gridDim.x * blockDim.x;
    for (long i = gt; i < (long)SEQ * 128; i += NG) { const int t = (int)(i >> 7), d = (int)(i & 127); float s, c; sincos_red((float)t * ret_theta(d), s, c); COSR[i] = c; SINR[i] = s; }
    for (long i = gt; i < (long)SEQ * 32; i += NG) { const int t = (int)(i >> 5), j = (int)(i & 31); const int row = t >> 6, col = t & 63;
        const float ang = j < 16 ? (float)row * ax_freq(j) : (float)col * ax_freq(j - 16); float s, c; sincos_red(ang, s, c); COSM[i] = c; SINM[i] = s; }
}

struct RowP {
    const float* x_in; const float* ctx_in;
    float* X; bf16_t* H; float* out;
    const float* Z;
    const float* YD; const int* tokinfo; const int* planprev;
    const float* gvec;
    const float* normw; const float* shiftv; const float* scalev;
    const float* router_w; const float* router_b;
    int* cnt; int* tokinfo_out; int* list;
    int skip_ctx;
};
#ifndef EXPERIMENT_MOE_SCALE
#define EXPERIMENT_MOE_SCALE 1.0f
#endif
enum { RP_FIRST = 1, RP_ADD_DENSE = 2, RP_ADD_MOE = 4, RP_ROUTER = 8, RP_FINAL = 16 };
template <int F> __global__ void __launch_bounds__(512) k_rowphase(RowP p) {
    extern __shared__ __attribute__((aligned(16))) unsigned char lds[];
    float* rw = (float*)lds;
    int* hist = (int*)(lds + 131072); int* base = hist + 32; int* rec = (int*)(lds + 131072 + 256);
    const int tid = threadIdx.x, lane = tid & 63, wave = tid >> 6;
    if (F & RP_ROUTER) {
        for (int i = tid; i < 1024 * 32; i += 512) { const int d = i >> 5, e = i & 31; const int ln = (d & 255) >> 2, ii = d & 3, j = d >> 8;
            rw[(((j * 4 + ii) * 8 + (e >> 2)) * 64 + ln) * 4 + (e & 3)] = p.router_w[i]; }
        if (tid < 32) hist[tid] = 0;
        __syncthreads();
    }
    const int gw = blockIdx.x * 8 + wave, NGW = gridDim.x * 8; int nrec = 0;
    for (int tok = gw; tok < NTOK; tok += NGW) {
        const int b = tok / LT, s = tok % LT; const bool isctx = s < CTXL; const int v = isctx ? 4 : b;
        if ((F & RP_FINAL) && isctx) continue;
        const float* src = (F & RP_FIRST) ? (isctx ? p.ctx_in + ((size_t)b * CTXL + s) * D : p.x_in + ((size_t)b * SEQ + (s - CTXL)) * D) : p.X + (size_t)tok * D;
        f32x4 xv[4];
#pragma unroll
        for (int j = 0; j < 4; ++j) xv[j] = *(const f32x4*)(src + 4 * lane + 256 * j);
        if (F & RP_ADD_DENSE) {
#pragma unroll
            for (int j = 0; j < 4; ++j) { const f32x4 g = *(const f32x4*)(p.gvec + (size_t)v * 6144 + 4 * lane + 256 * j); const f32x4 z = *(const f32x4*)(p.Z + (size_t)tok * D + 4 * lane + 256 * j); xv[j] += g * z; }
        }
        if (F & RP_ADD_MOE) {
            if (!(p.skip_ctx && isctx)) {
            f32x4 a[4] = {{0,0,0,0},{0,0,0,0},{0,0,0,0},{0,0,0,0}};
            for (int k = 0; k < 4; ++k) { const int e = p.tokinfo[(tok * 4 + k) * 4], pos = p.tokinfo[(tok * 4 + k) * 4 + 1]; const float gt = __builtin_bit_cast(float, p.tokinfo[(tok * 4 + k) * 4 + 2]);
                const float* yr = p.YD + (size_t)(p.planprev[e] + pos) * D;
#pragma unroll
                for (int j = 0; j < 4; ++j) a[j] += gt * *(const f32x4*)(yr + 4 * lane + 256 * j); }
#pragma unroll
            for (int j = 0; j < 4; ++j) { const f32x4 g = *(const f32x4*)(p.gvec + (size_t)v * 6144 + 4 * lane + 256 * j); xv[j] += g * a[j] * EXPERIMENT_MOE_SCALE; }
            }
        }
        if (F & (RP_FIRST | RP_ADD_DENSE | RP_ADD_MOE)) {
            if (!(F & RP_FINAL)) {
#pragma unroll
            for (int j = 0; j < 4; ++j) *(f32x4*)(p.X + (size_t)tok * D + 4 * lane + 256 * j) = xv[j]; }
        }
        float ss = 0.f;
#pragma unroll
        for (int j = 0; j < 4; ++j) ss += (xv[j].x * xv[j].x + xv[j].y * xv[j].y) + (xv[j].z * xv[j].z + xv[j].w * xv[j].w);
        const float r = rsqrtf(wave_sum(ss) * (1.0f / D) + EPS);
        if (F & RP_FINAL) {
#pragma unroll
            for (int j = 0; j < 4; ++j) { const f32x4 nw = *(const f32x4*)(p.normw + 4 * lane + 256 * j); *(f32x4*)(p.out + ((size_t)b * SEQ + (s - CTXL)) * D + 4 * lane + 256 * j) = xv[j] * r * nw; }
            continue;
        }
        f32x4 h[4];
#pragma unroll
        for (int j = 0; j < 4; ++j) { const int col = 4 * lane + 256 * j; const f32x4 nw = *(const f32x4*)(p.normw + col), sh = *(const f32x4*)(p.shiftv + (size_t)v * 6144 + col), sc = *(const f32x4*)(p.scalev + (size_t)v * 6144 + col);
            h[j] = (xv[j] * r * nw) * (1.0f + sc) + sh;
            u32x2 w; w.x = pk2(h[j].x, h[j].y); w.y = pk2(h[j].z, h[j].w); *(u32x2*)(p.H + (size_t)tok * D + col) = w; }
        if (F & RP_ROUTER) {
            if (p.skip_ctx && isctx) continue;
            float lg[32];
#pragma unroll
            for (int e = 0; e < 32; ++e) lg[e] = 0.f;
#pragma unroll
            for (int j = 0; j < 4; ++j)
#pragma unroll
                for (int ii = 0; ii < 4; ++ii) { const float hv = h[j][ii];
#pragma unroll
                    for (int ec = 0; ec < 8; ++ec) { const f32x4 w = *(const f32x4*)(rw + (((j * 4 + ii) * 8 + ec) * 64 + lane) * 4);
                        lg[ec * 4 + 0] += hv * w.x; lg[ec * 4 + 1] += hv * w.y; lg[ec * 4 + 2] += hv * w.z; lg[ec * 4 + 3] += hv * w.w; } }
#pragma unroll
            for (int e = 0; e < 32; ++e) lg[e] = wave_sum(lg[e]) + p.router_b[e];
            float v0 = -3.0e38f, v1 = -3.0e38f, v2 = -3.0e38f, v3 = -3.0e38f; int i0 = 0, i1 = 0, i2 = 0, i3 = 0;
#pragma unroll
            for (int e = 0; e < 32; ++e) { const float xx = lg[e]; const bool g0 = xx > v0, g1 = xx > v1, g2 = xx > v2, g3 = xx > v3;
                v3 = g2 ? v2 : (g3 ? xx : v3); i3 = g2 ? i2 : (g3 ? e : i3);
                v2 = g1 ? v1 : (g2 ? xx : v2); i2 = g1 ? i1 : (g2 ? e : i2);
                v1 = g0 ? v0 : (g1 ? xx : v1); i1 = g0 ? i0 : (g1 ? e : i1);
                v0 = g0 ? xx : v0; i0 = g0 ? e : i0; }
            const float pe0 = 1.0f, pe1 = __expf(v1 - v0), pe2 = __expf(v2 - v0), pe3 = __expf(v3 - v0); const float ps = (pe0 + pe1) + (pe2 + pe3);
            if (lane < 4) { int e = i0; float g = pe0;
                if (lane == 1) { e = i1; g = pe1; } if (lane == 2) { e = i2; g = pe2; } if (lane == 3) { e = i3; g = pe3; }
                g = g / ps;
                const int lpos = atomicAdd(&hist[e], 1);
                int* rc = rec + ((wave * 17 + nrec) * 4 + lane) * 4; rc[0] = tok; rc[1] = e; rc[2] = lpos; rc[3] = __builtin_bit_cast(int, g); }
            ++nrec;
        }
    }
    if (F & RP_ROUTER) {
        __syncthreads();
        if (tid < 32) base[tid] = atomicAdd(&p.cnt[tid], hist[tid]);
        __syncthreads();
        for (int i = lane; i < nrec * 4; i += 64) { const int* rc = rec + (wave * 17 * 4 + i) * 4; const int tok = rc[0], e = rc[1], pos = base[e] + rc[2]; const int k = i & 3;
            int* ti = p.tokinfo_out + (tok * 4 + k) * 4; ti[0] = e; ti[1] = pos; ti[2] = rc[3]; ti[3] = 0;
            p.list[(size_t)e * NTOK + pos] = tok; }
    }
}
struct RetPostP { const float* P; const float* COSR; const float* SINR; bf16_t* Q; bf16_t* Kb; bf16_t* VT; bf16_t* GF; bf16_t* GB; };
__global__ void __launch_bounds__(512) k_ret_post(RetPostP p) {
    const int lane = threadIdx.x & 63, gw = blockIdx.x * 8 + (threadIdx.x >> 6), NGW = gridDim.x * 8;
    for (int grp = gw; grp < NTOK / 8; grp += NGW) {
        const int tok0 = grp * 8, b = tok0 / LT, s0 = tok0 % LT; const bool isctx = s0 < CTXL;
        for (int i = 0; i < 8; ++i) {
            const int tok = tok0 + i; const float* pr = p.P + (size_t)tok * RIN; const int t = s0 + i - CTXL;
#pragma unroll
            for (int qk = 0; qk < 2; ++qk) {
                const float sc = qk ? 0.0625f : 1.0f; bf16_t* dst = (qk ? p.Kb : p.Q) + (size_t)tok * 1024;
#pragma unroll
                for (int h = 0; h < 4; ++h)
#pragma unroll
                    for (int jj = 0; jj < 2; ++jj) { const int d = lane + 64 * jj; const float x1 = pr[qk * 1024 + h * 256 + d] * sc, x2 = pr[qk * 1024 + h * 256 + 128 + d] * sc; float o1 = x1, o2 = x2;
                        if (!isctx) { const float c = p.COSR[(size_t)t * 128 + d], sn = p.SINR[(size_t)t * 128 + d]; o1 = x1 * c - x2 * sn; o2 = x1 * sn + x2 * c; }
                        dst[h * 256 + d] = (bf16_t)f2bf(o1); dst[h * 256 + 128 + d] = (bf16_t)f2bf(o2); }
            }
#pragma unroll
            for (int jj = 0; jj < 8; ++jj) { const int c4 = (lane + 64 * jj) * 4; const f32x4 gf = *(const f32x4*)(pr + 4096 + c4), gb = *(const f32x4*)(pr + 6144 + c4);
                u32x2 w; w.x = pk2(silu_f(gf.x), silu_f(gf.y)); w.y = pk2(silu_f(gf.z), silu_f(gf.w)); *(u32x2*)(p.GF + (size_t)tok * 2048 + c4) = w;
                w.x = pk2(silu_f(gb.x), silu_f(gb.y)); w.y = pk2(silu_f(gb.z), silu_f(gb.w)); *(u32x2*)(p.GB + (size_t)tok * 2048 + c4) = w; }
        }
        for (int jj = 0; jj < 32; ++jj) { const int col = lane + 64 * jj;
            float vv[8];
#pragma unroll
            for (int i = 0; i < 8; ++i) vv[i] = p.P[(size_t)(tok0 + i) * RIN + 2048 + col];
            u32x4 o; o.x = pk2(vv[0], vv[1]); o.y = pk2(vv[2], vv[3]); o.z = pk2(vv[4], vv[5]); o.w = pk2(vv[6], vv[7]);
            *(u32x4*)(p.VT + ((size_t)b * 2048 + col) * LT + s0) = o; }
    }
}
struct RetDecayP { const float* S; bf16_t* PF; bf16_t* PB; const float* logit; int h; };
__global__ void __launch_bounds__(256) k_ret_decay(RetDecayP p) {
    const float lf = -log1pf(expf(-p.logit[p.h])) * 1.4426950408889634f, lb = -log1pf(expf(-p.logit[4 + p.h])) * 1.4426950408889634f;
    const long n8 = (long)LT * (LT / 8);
    for (long i8 = blockIdx.x * (long)blockDim.x + threadIdx.x; i8 < n8; i8 += (long)gridDim.x * blockDim.x) {
        const int i = (int)(i8 / (LT / 8)), j0 = (int)(i8 % (LT / 8)) * 8; const int ibi = i < CTXL ? 255 - i : 8703 - i;
        const f32x4 s0 = *(const f32x4*)(p.S + (size_t)i * LT + j0), s1 = *(const f32x4*)(p.S + (size_t)i * LT + j0 + 4);
        float sv[8] = {s0.x, s0.y, s0.z, s0.w, s1.x, s1.y, s1.z, s1.w}; float f[8], bk[8];
#pragma unroll
        for (int q = 0; q < 8; ++q) { const int j = j0 + q; const int ibj = j < CTXL ? 255 - j : 8703 - j;
            f[q] = i >= j ? sv[q] * exp2f((float)(i - j) * lf) : 0.f; bk[q] = ibi >= ibj ? sv[q] * exp2f((float)(ibi - ibj) * lb) : 0.f; }
        u32x4 o; o.x = pk2(f[0], f[1]); o.y = pk2(f[2], f[3]); o.z = pk2(f[4], f[5]); o.w = pk2(f[6], f[7]); *(u32x4*)(p.PF + (size_t)i * LT + j0) = o;
        o.x = pk2(bk[0], bk[1]); o.y = pk2(bk[2], bk[3]); o.z = pk2(bk[4], bk[5]); o.w = pk2(bk[6], bk[7]); *(u32x4*)(p.PB + (size_t)i * LT + j0) = o;
    }
}
struct RetGateP { const float* OF; const float* OB; const bf16_t* GF; const bf16_t* GB; const float* gn; bf16_t* Y; };
__global__ void __launch_bounds__(512) k_ret_gate(RetGateP p) {
    const int lane = threadIdx.x & 63, gw = blockIdx.x * 8 + (threadIdx.x >> 6), NGW = gridDim.x * 8;
    for (int tok = gw; tok < NTOK; tok += NGW) {
#pragma unroll
        for (int h = 0; h < 4; ++h) {
            const int c0 = h * 512 + lane * 8; float yo[8];
#pragma unroll
            for (int dir = 0; dir < 2; ++dir) {
                const float* o = (dir ? p.OB : p.OF) + (size_t)tok * 2048 + c0; const f32x4 a = *(const f32x4*)o, bq = *(const f32x4*)(o + 4);
                float v[8] = {a.x, a.y, a.z, a.w, bq.x, bq.y, bq.z, bq.w}; float sm = 0.f;
#pragma unroll
                for (int q = 0; q < 8; ++q) sm += v[q];
                const float mu = wave_sum(sm) * (1.0f / 512.0f); float sq = 0.f;
#pragma unroll
                for (int q = 0; q < 8; ++q) { v[q] -= mu; sq += v[q] * v[q]; }
                const float rstd = rsqrtf(wave_sum(sq) * (1.0f / 512.0f) + GN_EPS);
                const u32x4 gw4 = *(const u32x4*)((dir ? p.GB : p.GF) + (size_t)tok * 2048 + c0);
                const float g[8] = {bflo(gw4.x), bfhi(gw4.x), bflo(gw4.y), bfhi(gw4.y), bflo(gw4.z), bfhi(gw4.z), bflo(gw4.w), bfhi(gw4.w)};
                const float* gnp = p.gn + dir * 2048 + c0;
#pragma unroll
                for (int q = 0; q < 8; ++q) { const float t = g[q] * (v[q] * rstd * gnp[q]); yo[q] = dir ? yo[q] + t : t; }
            }
            u32x4 o; o.x = pk2(yo[0], yo[1]); o.y = pk2(yo[2], yo[3]); o.z = pk2(yo[4], yo[5]); o.w = pk2(yo[6], yo[7]);
            *(u32x4*)(p.Y + (size_t)tok * 2048 + c0) = o;
        }
    }
}
struct MlaPostP { const float* P; const float* qn; const float* kvn; const float* COSM; const float* SINM; bf16_t* CQ; bf16_t* CKV; float* KR; };
__global__ void __launch_bounds__(512) k_mla_post(MlaPostP p) {
    const int lane = threadIdx.x & 63, gw = blockIdx.x * 8 + (threadIdx.x >> 6), NGW = gridDim.x * 8;
    for (int tok = gw; tok < NTOK; tok += NGW) {
        const float* pr = p.P + (size_t)tok * MINP; const int s = tok % LT; const bool isctx = s < CTXL; const int t = s - CTXL;
        float q[6], ss = 0.f;
#pragma unroll
        for (int i = 0; i < 6; ++i) { q[i] = pr[lane + 64 * i]; ss += q[i] * q[i]; }
        float r = rsqrtf(wave_sum(ss) * (1.0f / 384.0f) + EPS);
#pragma unroll
        for (int i = 0; i < 6; ++i) p.CQ[(size_t)tok * 384 + lane + 64 * i] = (bf16_t)f2bf(q[i] * r * p.qn[lane + 64 * i]);
        float kv[4]; ss = 0.f;
#pragma unroll
        for (int i = 0; i < 4; ++i) { kv[i] = pr[384 + lane + 64 * i]; ss += kv[i] * kv[i]; }
        r = rsqrtf(wave_sum(ss) * (1.0f / 256.0f) + EPS);
#pragma unroll
        for (int i = 0; i < 4; ++i) p.CKV[(size_t)tok * 256 + lane + 64 * i] = (bf16_t)f2bf(kv[i] * r * p.kvn[lane + 64 * i]);
        if (lane < 32) { const float x1 = pr[640 + lane], x2 = pr[672 + lane]; float o1 = x1, o2 = x2;
            if (!isctx) { const float c = p.COSM[(size_t)t * 32 + lane], sn = p.SINM[(size_t)t * 32 + lane]; o1 = x1 * c - x2 * sn; o2 = x1 * sn + x2 * c; }
            p.KR[(size_t)tok * 64 + lane] = o1; p.KR[(size_t)tok * 64 + 32 + lane] = o2; }
    }
}
struct MlaBuildP { const float* QF; const float* KVF; const float* KR; const float* COSM; const float* SINM; bf16_t* Qp; bf16_t* Kp; bf16_t* VT; };
__global__ void __launch_bounds__(512) k_mla_build(MlaBuildP p) {
    const int lane = threadIdx.x & 63, gw = blockIdx.x * 8 + (threadIdx.x >> 6), NGW = gridDim.x * 8;
    for (int grp = gw; grp < NTOK / 8; grp += NGW) {
        const int tok0 = grp * 8, b = tok0 / LT, s0 = tok0 % LT; const bool isctx = s0 < CTXL;
        for (int i = 0; i < 8; ++i) {
            const int tok = tok0 + i, t = s0 + i - CTXL; const float* qf = p.QF + (size_t)tok * 1536; const float* kvf = p.KVF + (size_t)tok * 2048; const float* kr = p.KR + (size_t)tok * 64;
#pragma unroll
            for (int h = 0; h < 8; ++h) {
                bf16_t* qd = p.Qp + (size_t)tok * 2048 + h * 256; bf16_t* kd = p.Kp + (size_t)tok * 2048 + h * 256;
                qd[lane] = (bf16_t)f2bf(qf[h * 192 + lane]); qd[64 + lane] = (bf16_t)f2bf(qf[h * 192 + 64 + lane]);
                { const int ii = lane & 31; const float x1 = qf[h * 192 + 128 + ii], x2 = qf[h * 192 + 160 + ii]; float o1 = x1, o2 = x2;
                  if (!isctx) { const float c = p.COSM[(size_t)t * 32 + ii], sn = p.SINM[(size_t)t * 32 + ii]; o1 = x1 * c - x2 * sn; o2 = x1 * sn + x2 * c; }
                  qd[128 + lane] = (bf16_t)f2bf(lane < 32 ? o1 : o2); }
                qd[192 + lane] = 0;
                kd[lane] = (bf16_t)f2bf(kvf[h * 256 + lane]); kd[64 + lane] = (bf16_t)f2bf(kvf[h * 256 + 64 + lane]);
                kd[128 + lane] = (bf16_t)f2bf(kr[lane]); kd[192 + lane] = 0;
            }
        }
        for (int jj = 0; jj < 16; ++jj) { const int col = lane + 64 * jj; const int h = col >> 7, dv = col & 127;
            float vv[8];
#pragma unroll
            for (int i = 0; i < 8; ++i) vv[i] = p.KVF[(size_t)(tok0 + i) * 2048 + h * 256 + 128 + dv];
            u32x4 o; o.x = pk2(vv[0], vv[1]); o.y = pk2(vv[2], vv[3]); o.z = pk2(vv[4], vv[5]); o.w = pk2(vv[6], vv[7]);
            *(u32x4*)(p.VT + (((size_t)b * 8 + h) * 256 + dv) * LT + s0) = o; }
    }
}
__global__ void __launch_bounds__(512) k_softmax(const float* S, bf16_t* P, int M, int N, int ldsm, int ldp, float scale) {
    const int lane = threadIdx.x & 63, gw = blockIdx.x * 8 + (threadIdx.x >> 6), NGW = gridDim.x * 8;
    const float c = scale * 1.4426950408889634f;
    for (int r = gw; r < M; r += NGW) {
        const float* sr = S + (size_t)r * ldsm; float mx = -3.0e38f;
        for (int j = lane * 4; j < N; j += 256) { const f32x4 v = *(const f32x4*)(sr + j); mx = fmaxf(fmaxf(mx, fmaxf(v.x, v.y)), fmaxf(v.z, v.w)); }
        mx = wave_max(mx); float sm = 0.f;
        for (int j = lane * 4; j < N; j += 256) { const f32x4 v = *(const f32x4*)(sr + j); sm += exp2f((v.x - mx) * c) + exp2f((v.y - mx) * c) + exp2f((v.z - mx) * c) + exp2f((v.w - mx) * c); }
        const float inv = 1.0f / wave_sum(sm);
        for (int j = lane * 4; j < N; j += 256) { const f32x4 v = *(const f32x4*)(sr + j); u32x2 w; w.x = pk2(exp2f((v.x - mx) * c) * inv, exp2f((v.y - mx) * c) * inv); w.y = pk2(exp2f((v.z - mx) * c) * inv, exp2f((v.w - mx) * c) * inv);
            *(u32x2*)(P + (size_t)r * ldp + j) = w; }
    }
}
__global__ void k_mla_opack(const float* OFm, bf16_t* O) {
    for (long i = blockIdx.x * (long)blockDim.x + threadIdx.x; i < (long)NTOK * 256; i += (long)gridDim.x * blockDim.x) { const long tok = i >> 8; const int c4 = (int)(i & 255) * 4; const int h = c4 >> 7, dv = c4 & 127;
        const f32x4 v = *(const f32x4*)(OFm + tok * 2048 + h * 256 + dv); u32x2 w; w.x = pk2(v.x, v.y); w.y = pk2(v.z, v.w); *(u32x2*)(O + tok * 1024 + c4) = w; }
}
__global__ void k_moe_plan(const int* cnt, int* plan) {
    if (threadIdx.x == 0 && blockIdx.x == 0) { int off = 0, nt = 0;
        for (int e = 0; e < NE; ++e) { const int c = cnt[e]; plan[e] = off; plan[32 + e] = c; const int tl = (c + 255) / 256; for (int q = 0; q < tl; ++q) plan[128 + nt + q] = e; nt += tl; off += tl * 256; }
        plan[64] = nt; }
}
__global__ void __launch_bounds__(512) k_moe_gather(const bf16_t* H, const int* plan, const int* list, bf16_t* AP) {
    const int lane = threadIdx.x & 63, gw = blockIdx.x * 8 + (threadIdx.x >> 6), NGW = gridDim.x * 8; const int nrows = plan[64] * 256;
    for (int r = gw; r < nrows; r += NGW) { const int e = plan[128 + (r >> 8)], pos = r - plan[e]; u32x4 a = {0, 0, 0, 0}, bq = {0, 0, 0, 0};
        if (pos < plan[32 + e]) { const int tok = list[(size_t)e * NTOK + pos]; a = *(const u32x4*)(H + (size_t)tok * D + lane * 8); bq = *(const u32x4*)(H + (size_t)tok * D + 512 + lane * 8); }
        *(u32x4*)(AP + (size_t)r * D + lane * 8) = a; *(u32x4*)(AP + (size_t)r * D + 512 + lane * 8) = bq; }
}
__global__ void k_moe_act(const float* U, const int* plan, bf16_t* ACT) {
    const long n = (long)plan[64] * 256 * 256;
    for (long i = blockIdx.x * (long)blockDim.x + threadIdx.x; i < n; i += (long)gridDim.x * blockDim.x) { const long r = i >> 8; const int c4 = (int)(i & 255) * 4;
        const f32x4 g = *(const f32x4*)(U + r * 2048 + c4), l = *(const f32x4*)(U + r * 2048 + 1024 + c4); float o[4];
#pragma unroll
        for (int q = 0; q < 4; ++q) { const float gl = fminf(g[q], 7.0f), ln = fminf(fmaxf(l[q], -7.0f), 7.0f); o[q] = gl / (1.0f + __expf(-1.702f * gl)) * (ln + 1.0f); }
        u32x2 w; w.x = pk2(o[0], o[1]); w.y = pk2(o[2], o[3]); *(u32x2*)(ACT + r * 1024 + c4) = w; }
}
struct WsMap {
    size_t CTL, MOD, COSR, SINR, COSM, SINM, TOKINFO, LIST, PLAN, WRI, WRO, WMI, WUQ, WUKV, WMO, WUP, WDN, X, H, RA, RB, RC, END;
};
static size_t al256(size_t x) { return (x + 255) & ~(size_t)255; }
static WsMap make_map() {
    WsMap m; size_t o = 0;
    auto take = [&](size_t bytes) { size_t r = o; o = al256(o + bytes); return r; };
    m.CTL = take(1 << 20);
    m.MOD = take((size_t)DEPTH * 5 * 6144 * 4);
    m.COSR = take((size_t)SEQ * 128 * 4); m.SINR = take((size_t)SEQ * 128 * 4); m.COSM = take((size_t)SEQ * 32 * 4); m.SINM = take((size_t)SEQ * 32 * 4);
    m.TOKINFO = take((size_t)NTOK * 16 * 4); m.LIST = take((size_t)NE * NTOK * 4); m.PLAN = take((size_t)DEPTH * 1024 * 4);
    m.WRI = take((size_t)2 * 8192 * 1024 * 2); m.WRO = take((size_t)2 * 1024 * 2048 * 2); m.WMI = take((size_t)2 * MINP * 1024 * 2);
    m.WUQ = take((size_t)2 * 1536 * 384 * 2); m.WUKV = take((size_t)2 * 2048 * 256 * 2); m.WMO = take((size_t)2 * 1024 * 1024 * 2);
    m.WUP = take((size_t)DEPTH * NE * 2048 * 1024 * 2); m.WDN = take((size_t)DEPTH * NE * 1024 * 1024 * 2);
    m.X = take((size_t)NTOK * D * 4); m.H = take((size_t)NTOK * D * 2);
    m.RA = take((size_t)MAXSLOTS * 2048 * 4);
    m.RB = take((size_t)1107296256 + 4096);
    m.RC = take((size_t)NTOK * D * 4 + (size_t)MAXSLOTS * D * 4);
    m.END = o; return m;
}
static void gemm(hipStream_t st, const bf16_t* A, const bf16_t* Bt, float* C, int M, int N, int K, int lda, int ldb, int ldc, const float* bias = nullptr) {
    GemmP p{A, Bt, C, bias, M, N, K, lda, ldb, ldc};
    hipLaunchKernelGGL(k_gemm, dim3(256), dim3(512), 131072, st, p);
}
static void transpose(hipStream_t st, const float* src, bf16_t* dst, int K, int N, int ldd, int nbatch, long sstride, long dstride) {
    TrP p{src, dst, K, N, ldd, nbatch, sstride, dstride};
    hipLaunchKernelGGL(k_transpose, dim3(2048), dim3(512), 0, st, p);
}

__global__ void k_dump(const void* src, int is_bf16, long ld, long coloff, float* out) {
    for (long i = blockIdx.x * (long)blockDim.x + threadIdx.x; i < (long)NB * SEQ * D; i += (long)gridDim.x * blockDim.x) { const long r = i >> 10, c = i & 1023; const long b = r / SEQ, t = r % SEQ; const long tok = b * LT + CTXL + t;
        out[i] = is_bf16 ? bf2f(((const bf16_t*)src)[tok * ld + coloff + c]) : ((const float*)src)[tok * ld + coloff + c]; }
}
#ifndef STOP_AT
#define STOP_AT 0
#endif
#define DUMP(id, src, isbf, ld, coloff) do { if (STOP_AT == (id)) { hipLaunchKernelGGL(k_dump, dim3(2048), dim3(256), 0, st, (const void*)(src), (int)(isbf), (long)(ld), (long)(coloff), (float*)d_out); return; } } while (0)
extern "C" void kernel_launch(void* const* d_in, const int* in_sizes, int n_in, void* d_out, int out_size, void* d_ws, size_t ws_size, hipStream_t stream) {
    static int ok = 0; static WsMap m;
    if (ok == 0) {
        m = make_map();
        if (n_in != 25 || ws_size < m.END) { fprintf(stderr, "kernel_launch: bad shapes n_in %d ws %zu need %zu\n", n_in, ws_size, m.END); ok = -1; return; }
        hipFuncSetAttribute((const void*)k_gemm, hipFuncAttributeMaxDynamicSharedMemorySize, 131072);
        hipFuncSetAttribute((const void*)k_moe_gemm, hipFuncAttributeMaxDynamicSharedMemorySize, 131072);
        hipFuncSetAttribute((const void*)k_rowphase<RP_ADD_DENSE | RP_ROUTER>, hipFuncAttributeMaxDynamicSharedMemorySize, 140032);
        ok = 1;
    }
    if (ok < 0) return;
    const float* x = (const float*)d_in[0]; const float* c = (const float*)d_in[1]; const float* ctx = (const float*)d_in[2]; const float* c_ctx = (const float*)d_in[3];
    const float* ret_w_in = (const float*)d_in[4]; const float* ret_decay = (const float*)d_in[5]; const float* ret_gn = (const float*)d_in[6]; const float* ret_w_out = (const float*)d_in[7];
    const float* mla_w_in = (const float*)d_in[8]; const float* mla_qn = (const float*)d_in[9]; const float* mla_kvn = (const float*)d_in[10]; const float* mla_w_uq = (const float*)d_in[11];
    const float* mla_w_ukv = (const float*)d_in[12]; const float* mla_w_out = (const float*)d_in[13]; const float* ada_w = (const float*)d_in[14]; const float* ada_b = (const float*)d_in[15];
    const float* norm_mix = (const float*)d_in[16]; const float* norm_ffn = (const float*)d_in[17]; const float* router_w = (const float*)d_in[18]; const float* router_b = (const float*)d_in[19];
    const float* exp_w_up = (const float*)d_in[20]; const float* exp_b_up = (const float*)d_in[21]; const float* exp_w_down = (const float*)d_in[22]; const float* exp_b_down = (const float*)d_in[23];
    const float* final_norm = (const float*)d_in[24];
    char* ws = (char*)d_ws; hipStream_t st = stream;
    int* CTL = (int*)(ws + m.CTL); float* MOD = (float*)(ws + m.MOD);
    float* COSR = (float*)(ws + m.COSR); float* SINR = (float*)(ws + m.SINR); float* COSM = (float*)(ws + m.COSM); float* SINM = (float*)(ws + m.SINM);
    int* TOKINFO = (int*)(ws + m.TOKINFO); int* LIST = (int*)(ws + m.LIST); int* PLAN = (int*)(ws + m.PLAN);
    bf16_t* WRI = (bf16_t*)(ws + m.WRI); bf16_t* WRO = (bf16_t*)(ws + m.WRO); bf16_t* WMI = (bf16_t*)(ws + m.WMI); bf16_t* WUQ = (bf16_t*)(ws + m.WUQ);
    bf16_t* WUKV = (bf16_t*)(ws + m.WUKV); bf16_t* WMO = (bf16_t*)(ws + m.WMO); bf16_t* WUP = (bf16_t*)(ws + m.WUP); bf16_t* WDN = (bf16_t*)(ws + m.WDN);
    float* X = (float*)(ws + m.X); bf16_t* H = (bf16_t*)(ws + m.H);
    char* RA = ws + m.RA; char* RB = ws + m.RB; char* RC = ws + m.RC;
    float* Z = (float*)RC; float* YD = (float*)(RC + (size_t)NTOK * D * 4);
    hipMemsetAsync(ws + m.CTL, 0, 1 << 20, st);
    int* CNT = CTL + 1024;
    transpose(st, ret_w_in, WRI, 1024, 8192, 1024, 2, (long)1024 * 8192, (long)8192 * 1024);
    transpose(st, ret_w_out, WRO, 2048, 1024, 2048, 2, (long)2048 * 1024, (long)1024 * 2048);
    hipLaunchKernelGGL(k_zero16, dim3(256), dim3(256), 0, st, (u32x4*)WMI, (long)(2 * MINP * 1024 * 2 / 16));
    transpose(st, mla_w_in, WMI, 1024, MIN_, 1024, 2, (long)1024 * MIN_, (long)MINP * 1024);
    transpose(st, mla_w_uq, WUQ, 384, 1536, 384, 2, (long)384 * 1536, (long)1536 * 384);
    transpose(st, mla_w_ukv, WUKV, 256, 2048, 256, 2, (long)256 * 2048, (long)2048 * 256);
    transpose(st, mla_w_out, WMO, 1024, 1024, 1024, 2, (long)1024 * 1024, (long)1024 * 1024);
    transpose(st, exp_w_up, WUP, 1024, 2048, 1024, DEPTH * NE, (long)1024 * 2048, (long)2048 * 1024);
    transpose(st, exp_w_down, WDN, 1024, 1024, 1024, DEPTH * NE, (long)1024 * 1024, (long)1024 * 1024);
    hipLaunchKernelGGL(k_adaln, dim3(256), dim3(512), 0, st, c, c_ctx, ada_w, ada_b, MOD);
    hipLaunchKernelGGL(k_rot_tables, dim3(512), dim3(256), 0, st, COSR, SINR, COSM, SINM);
    for (int layer = 0; layer < DEPTH; ++layer) {
        const int j = layer / 2; const bool last = layer == DEPTH - 1;
        const float* modl = MOD + (size_t)layer * 5 * 6144;
        { RowP p{}; p.x_in = x; p.ctx_in = ctx; p.X = X; p.H = H; p.normw = norm_mix + layer * D; p.shiftv = modl + 0 * 1024; p.scalev = modl + 1 * 1024;
          if (layer == 0) hipLaunchKernelGGL(k_rowphase<RP_FIRST>, dim3(256), dim3(512), 0, st, p);
          else { p.YD = YD; p.tokinfo = TOKINFO; p.planprev = PLAN + (layer - 1) * 1024; p.gvec = MOD + (size_t)(layer - 1) * 5 * 6144 + 5 * 1024; p.skip_ctx = 0;
                 hipLaunchKernelGGL(k_rowphase<RP_ADD_MOE>, dim3(256), dim3(512), 0, st, p); } }
        DUMP(1, H, 1, 1024, 0);
        if (layer % 2 == 0) {
            float* P = (float*)RA;
            gemm(st, H, WRI + (size_t)j * 8192 * 1024, P, NTOK, 8192, 1024, 1024, 1024, 8192);
            bf16_t* Q = (bf16_t*)RB; bf16_t* Kb = Q + (size_t)NTOK * 1024; bf16_t* VT = Kb + (size_t)NTOK * 1024; bf16_t* GF = VT + (size_t)NTOK * 2048; bf16_t* GB = GF + (size_t)NTOK * 2048;
            float* OF = (float*)(GB + (size_t)NTOK * 2048); float* OB = OF + (size_t)NTOK * 2048; bf16_t* Y = Q;
            DUMP(2, P, 0, 8192, 4096);
            { RetPostP p{P, COSR, SINR, Q, Kb, VT, GF, GB}; hipLaunchKernelGGL(k_ret_post, dim3(256), dim3(512), 0, st, p); }
            DUMP(3, Q, 1, 1024, 0); DUMP(4, GF, 1, 2048, 1024);
            float* S = (float*)RA; bf16_t* PF = (bf16_t*)(RA + (size_t)LT * LT * 4); bf16_t* PB = PF + (size_t)LT * LT;
            for (int b = 0; b < NB; ++b) for (int h = 0; h < RH; ++h) {
                const bf16_t* qa = Q + (size_t)b * LT * 1024 + h * 256; const bf16_t* ka = Kb + (size_t)b * LT * 1024 + h * 256;
                gemm(st, qa, ka, S, LT, LT, 256, 1024, 1024, LT);
                { RetDecayP p{S, PF, PB, ret_decay + j * 8, h}; hipLaunchKernelGGL(k_ret_decay, dim3(2048), dim3(256), 0, st, p); }
                const bf16_t* vt = VT + ((size_t)b * 2048 + h * 512) * LT;
                gemm(st, PF, vt, OF + (size_t)b * LT * 2048 + h * 512, LT, 512, LT, LT, LT, 2048);
                gemm(st, PB, vt, OB + (size_t)b * LT * 2048 + h * 512, LT, 512, LT, LT, LT, 2048);
            }
            DUMP(5, OF, 0, 2048, 512); DUMP(6, OB, 0, 2048, 1024);
            { RetGateP p{OF, OB, GF, GB, ret_gn + (size_t)j * 2 * 2048, Y}; hipLaunchKernelGGL(k_ret_gate, dim3(256), dim3(512), 0, st, p); }
            DUMP(7, Y, 1, 2048, 0);
            gemm(st, Y, WRO + (size_t)j * 1024 * 2048, Z, NTOK, 1024, 2048, 2048, 2048, 1024);
            DUMP(8, Z, 0, 1024, 0);
        } else {
            float* Pm = (float*)RA; float* QF = Pm + (size_t)NTOK * MINP; float* KVF = QF + (size_t)NTOK * 1536; float* S = KVF + (size_t)NTOK * 2048; bf16_t* Pa = (bf16_t*)(S + (size_t)SEQ * LT);
            bf16_t* CQ = (bf16_t*)RB; bf16_t* CKV = CQ + (size_t)NTOK * 384; float* KR = (float*)(CKV + (size_t)NTOK * 256); bf16_t* Qp = (bf16_t*)(KR + (size_t)NTOK * 64);
            bf16_t* Kp = Qp + (size_t)NTOK * 2048; bf16_t* VT = Kp + (size_t)NTOK * 2048; float* OFm = (float*)(VT + (size_t)NTOK * 2048); bf16_t* O = (bf16_t*)(OFm + (size_t)NTOK * 2048);
            gemm(st, H, WMI + (size_t)j * MINP * 1024, Pm, NTOK, MINP, 1024, 1024, 1024, MINP);
            { MlaPostP p{Pm, mla_qn + j * 384, mla_kvn + j * 256, COSM, SINM, CQ, CKV, KR}; hipLaunchKernelGGL(k_mla_post, dim3(256), dim3(512), 0, st, p); }
            gemm(st, CQ, WUQ + (size_t)j * 1536 * 384, QF, NTOK, 1536, 384, 384, 384, 1536);
            gemm(st, CKV, WUKV + (size_t)j * 2048 * 256, KVF, NTOK, 2048, 256, 256, 256, 2048);
            { MlaBuildP p{QF, KVF, KR, COSM, SINM, Qp, Kp, VT}; hipLaunchKernelGGL(k_mla_build, dim3(256), dim3(512), 0, st, p); }
            const float scale = 0.07216878364870322f;
            for (int b = 0; b < NB; ++b) for (int h = 0; h < MH; ++h) {
                const bf16_t* kb = Kp + (size_t)b * LT * 2048 + h * 256; const bf16_t* vt = VT + ((size_t)b * 8 + h) * 256 * LT;
                gemm(st, Qp + ((size_t)b * LT + CTXL) * 2048 + h * 256, kb, S, SEQ, LT, 256, 2048, 2048, LT);
                hipLaunchKernelGGL(k_softmax, dim3(256), dim3(512), 0, st, (const float*)S, Pa, SEQ, LT, LT, LT, scale);
                gemm(st, Pa, vt, OFm + ((size_t)b * LT + CTXL) * 2048 + h * 256, SEQ, 256, LT, LT, LT, 2048);
                gemm(st, Qp + ((size_t)b * LT) * 2048 + h * 256, kb, S, CTXL, CTXL, 256, 2048, 2048, CTXL);
                hipLaunchKernelGGL(k_softmax, dim3(32), dim3(512), 0, st, (const float*)S, Pa, CTXL, CTXL, CTXL, CTXL, scale);
                gemm(st, Pa, vt, OFm + ((size_t)b * LT) * 2048 + h * 256, CTXL, 256, CTXL, CTXL, LT, 2048);
            }
            hipLaunchKernelGGL(k_mla_opack, dim3(2048), dim3(256), 0, st, (const float*)OFm, O);
            gemm(st, O, WMO + (size_t)j * 1024 * 1024, Z, NTOK, 1024, 1024, 1024, 1024, 1024);
        }
        { RowP p{}; p.X = X; p.H = H; p.Z = Z; p.gvec = modl + 2 * 1024; p.normw = norm_ffn + layer * D; p.shiftv = modl + 3 * 1024; p.scalev = modl + 4 * 1024;
          p.router_w = router_w + (size_t)layer * 1024 * 32; p.router_b = router_b + layer * 32; p.cnt = CNT + layer * 32; p.tokinfo_out = TOKINFO; p.list = LIST; p.skip_ctx = last ? 1 : 0;
          hipLaunchKernelGGL(k_rowphase<RP_ADD_DENSE | RP_ROUTER>, dim3(256), dim3(512), 140032, st, p); }
        int* plan = PLAN + layer * 1024;
        hipLaunchKernelGGL(k_moe_plan, dim3(1), dim3(64), 0, st, (const int*)(CNT + layer * 32), plan);
        bf16_t* AP = (bf16_t*)RB; bf16_t* ACT = AP + (size_t)MAXSLOTS * D; float* U = (float*)RA;
        hipLaunchKernelGGL(k_moe_gather, dim3(256), dim3(512), 0, st, (const bf16_t*)H, (const int*)plan, (const int*)LIST, AP);
        { MoeGemmP p{AP, WUP + (size_t)layer * NE * 2048 * 1024, U, exp_b_up + (size_t)layer * NE * 2048, plan, 8, 1024, 2048, 2048}; hipLaunchKernelGGL(k_moe_gemm, dim3(256), dim3(512), 131072, st, p); }
        hipLaunchKernelGGL(k_moe_act, dim3(2048), dim3(256), 0, st, (const float*)U, (const int*)plan, ACT);
        { MoeGemmP p{ACT, WDN + (size_t)layer * NE * 1024 * 1024, YD, exp_b_down + (size_t)layer * NE * 1024, plan, 4, 1024, 1024, 1024}; hipLaunchKernelGGL(k_moe_gemm, dim3(256), dim3(512), 131072, st, p); }
    }
    { RowP p{}; p.X = X; p.out = (float*)d_out; p.YD = YD; p.tokinfo = TOKINFO; p.planprev = PLAN + (DEPTH - 1) * 1024; p.gvec = MOD + (size_t)(DEPTH - 1) * 5 * 6144 + 5 * 1024; p.normw = final_norm; p.skip_ctx = 1;
      hipLaunchKernelGGL(k_rowphase<RP_ADD_MOE | RP_FINAL>, dim3(256), dim3(512), 0, st, p); }
}
```

```cpp
#include <hip/hip_runtime.h>
#include <cstdio>
#include <cstdint>
#include <cmath>
constexpr int LDS_GTAB = 131072, LDS_MISC_BASE = 155648, LDS_WVTAB = LDS_MISC_BASE + 512;
__device__ __forceinline__ unsigned hw_wave_slot() { return (unsigned)__builtin_amdgcn_s_getreg((5 << 11) | 4) & 0x3fu; }
__device__ __forceinline__ int ph_tid() {
    const unsigned a = (unsigned)LDS_WVTAB + hw_wave_slot() * 4u;
    const unsigned wv = (unsigned)__builtin_amdgcn_readfirstlane((int)*(volatile __attribute__((address_space(3))) unsigned*)(unsigned long long)a);
    unsigned m = ~0u; asm volatile("" : "+s"(m));
    const unsigned lane = __builtin_amdgcn_mbcnt_hi(m, __builtin_amdgcn_mbcnt_lo(m, 0u));
    return (int)(wv * 64u + lane);
}
namespace pg8 {
#define PG8_LAS __attribute__((address_space(3)))
typedef unsigned short bf16_t;
typedef short bf16x8 __attribute__((ext_vector_type(8)));
typedef float f32x4 __attribute__((ext_vector_type(4)));
typedef unsigned u32x4 __attribute__((ext_vector_type(4)));
typedef unsigned u32x2 __attribute__((ext_vector_type(2)));
typedef long i64x2 __attribute__((ext_vector_type(2)));
typedef int i32x4 __attribute__((ext_vector_type(4)));
typedef int i32x8 __attribute__((ext_vector_type(8)));
constexpr int BM = 256, BK = 64, HALF = 128, HTB = HALF * BK * 2, STAGE_BYTES = 8 * HTB, NXCD = 8, WGM = 8;
__host__ __device__ __forceinline__ int lds_byte(int r, int c) { const int st = (r >> 4) * 2 + (c >> 5), rr = r & 15, cc = c & 31, ob = rr * 64 + cc * 2; return st * 1024 + (ob ^ (((ob >> 9) & 1) << 5)); }
__host__ __device__ __forceinline__ void stage_rc(int b, int& R, int& C) { const int st = b / 1024, sb = b % 1024, swz = sb ^ (((sb >> 9) & 1) << 5); R = (st >> 1) * 16 + swz / 64; C = (st & 1) * 32 + (swz % 64) / 2; }
__host__ __device__ __forceinline__ int perm32(int rho) { const int n = rho >> 4, i = rho & 15; return 8 * (i >> 2) + 4 * n + (i & 3); }
struct Unit { int pm, pn, pc; unsigned ka, kb; };
struct Gemm { const bf16_t* A; const bf16_t* Bt; int K, lda, ldb; };
struct StaticOrder {
    static constexpr bool GATHER = false;
    int nM, nN, nwg, G, c;
    __host__ __device__ void init(int M, int N, int G_, int c_) { nM = M / BM; nN = N / BM; nwg = nM * nN; G = G_; c = c_; }
    __host__ __device__ bool next(int i, Unit& u) const {
        const long L = (long)i * G + c; if (L >= nwg) return false;
        int wgid = (int)L; { const int q = nwg / NXCD, r = nwg % NXCD, xcd = wgid % NXCD, off = wgid / NXCD; wgid = (xcd < r ? xcd * (q + 1) : r * (q + 1) + (xcd - r) * q) + off; }
        const int nig = WGM * nN, gid = wgid / nig, fm = gid * WGM, gsz = (nM - fm) < WGM ? (nM - fm) : WGM;
        u.pm = fm + ((wgid % nig) % gsz); u.pn = (wgid % nig) / gsz; u.pc = u.pn; u.ka = 0u; u.kb = 0u; return true;
    }
    __device__ __forceinline__ void a_ready(const Unit&) const {}
    __device__ __forceinline__ void done(const Unit&) const {}
};
__device__ __forceinline__ unsigned cvt_pk_bf16(float lo, float hi) { unsigned r; asm volatile("v_cvt_pk_bf16_f32 %0, %1, %2" : "=v"(r) : "v"(lo), "v"(hi)); return r; }

struct EpiF32 {
    static constexpr bool PERM = false, AFTER_DRAIN = false;
    float* C; int ldc; const float* bias; int npg; int bstride;
    __device__ __forceinline__ void operator()(const f32x4 (&acc)[2][2][4][2], const Unit& u, int wr, int wc, int fr, int fq) const {
        int row0 = u.pm * BM + wr * 64 + fr, col0 = u.pc * BM + wc * 32 + 4 * fq; asm volatile("" : "+v"(row0), "+v"(col0));
        const float* bp = bias ? bias + (size_t)(u.pn / npg) * bstride : nullptr;
        f32x4 bv[2][2];
#pragma unroll
        for (int bj = 0; bj < 2; ++bj)
#pragma unroll
            for (int n = 0; n < 2; ++n) bv[bj][n] = bp ? *(const f32x4*)(bp + col0 + bj * HALF + n * 16) : (f32x4){0.f, 0.f, 0.f, 0.f};
#pragma unroll
        for (int ai = 0; ai < 2; ++ai)
#pragma unroll
            for (int m = 0; m < 4; ++m) { float* rowp = C + (size_t)(row0 + ai * HALF + m * 16) * ldc + col0;
#pragma unroll
                for (int bj = 0; bj < 2; ++bj)
#pragma unroll
                    for (int n = 0; n < 2; ++n) *(f32x4*)(rowp + bj * HALF + n * 16) = acc[ai][bj][m][n] + bv[bj][n]; }
    }
};

template <class Epi, class Sched, bool ALIGN_EPI = false, bool SP2 = false, bool FP8 = false>
__device__ __forceinline__ void gemm_phase(PG8_LAS unsigned char* lds, const Gemm g, const Sched& S, const Epi& E) {
    const int tid = ph_tid(), wid = __builtin_amdgcn_readfirstlane(tid >> 6), lane = tid & 63, wr = wid >> 2, wc = wid & 3, fr = lane & 15, fq = lane >> 4;
    const int K = g.K, nt = K / BK;
    unsigned voffA[2], voffB[2];
    unsigned gaddr[2];
#pragma unroll
    for (int i = 0; i < 2; ++i) { int R, C; stage_rc(tid * 16 + i * 8192, R, C); const int Rb = Epi::PERM ? ((R & ~31) + perm32(R & 31)) : R;
        voffA[i] = Sched::GATHER ? (unsigned)C * 2u : (unsigned)(R * g.lda + C) * 2u; voffB[i] = (unsigned)(Rb * g.ldb + C) * 2u; gaddr[i] = (unsigned)LDS_GTAB + (unsigned)R * 4u; }
#define PG8_GLD(dst, ui_, h_) do { _Pragma("unroll") for (int _i = 0; _i < 2; ++_i) (dst)[_i] = *(const PG8_LAS unsigned*)(unsigned long long)(gaddr[_i] + (unsigned)(ui_) * 1024u + (unsigned)(h_) * 512u) + voffA[_i]; } while (0)
#define PG8_STAGEA(bufoff, kbase, h_, nx_) do { if constexpr (Sched::GATHER) { unsigned _vn[2]; PG8_GLD(_vn, (nx_) ? ui + 1 : ui, h_); PG8_STAGE(bufoff, kbase, _vn); } \
        else PG8_STAGE(bufoff, (kbase) + (h_) * hstepA, voffA); } while (0)
    const size_t kstep = (size_t)(BK * 2);
    const size_t hstepA = (size_t)HALF * g.lda * 2, hstepB = (size_t)HALF * g.ldb * 2;
    const size_t tstepA = Sched::GATHER ? 0 : 2 * hstepA, tstepB = 2 * hstepB;
    const unsigned ldsw = (unsigned)wid * 1024u;
    const int aoff = lds_byte(wr * 64 + fr, fq * 8), boff = lds_byte(wc * 32 + fr, fq * 8);
#define PG8_SA(b, h) (((b) * 2 + (h)) * HTB)
#define PG8_SB(b, h) ((4 + (b) * 2 + (h)) * HTB)
#define PG8_STAGE(bufoff, gbase, voff) do { _Pragma("unroll") for (int _i = 0; _i < 2; ++_i) \
        __builtin_amdgcn_global_load_lds((const unsigned*)((const char*)(gbase) + (voff)[_i]), (PG8_LAS unsigned*)(lds + (bufoff) + ldsw + _i * 8192), 16, 0, 0); } while (0)
#define PG8_RD16(off) (*(const PG8_LAS i32x4*)(lds + (off)))
#define PG8_LDA(dst, b, h) do { _Pragma("unroll") for (int m = 0; m < 4; ++m) { if constexpr (FP8) dst##8[m] = __builtin_shufflevector(PG8_RD16(PG8_SA(b, h) + aoff + m * 2048), PG8_RD16(PG8_SA(b, h) + aoff + m * 2048 + 1024), 0, 1, 2, 3, 4, 5, 6, 7); \
        else { _Pragma("unroll") for (int k = 0; k < 2; ++k) dst[m][k] = *(const PG8_LAS bf16x8*)(lds + PG8_SA(b, h) + aoff + m * 2048 + k * 1024); } } } while (0)
#define PG8_LDB(dst, b, h) do { _Pragma("unroll") for (int n = 0; n < 2; ++n) { if constexpr (FP8) dst##8[n] = __builtin_shufflevector(PG8_RD16(PG8_SB(b, h) + boff + n * 2048), PG8_RD16(PG8_SB(b, h) + boff + n * 2048 + 1024), 0, 1, 2, 3, 4, 5, 6, 7); \
        else { _Pragma("unroll") for (int k = 0; k < 2; ++k) dst[n][k] = *(const PG8_LAS bf16x8*)(lds + PG8_SB(b, h) + boff + n * 2048 + k * 1024); } } } while (0)
#define PG8_MMA(ai, bj, At, Bt) do { __builtin_amdgcn_s_setprio(1); _Pragma("unroll") for (int m = 0; m < 4; ++m) _Pragma("unroll") for (int n = 0; n < 2; ++n) { \
        if constexpr (FP8) asm volatile("v_mfma_f32_16x16x128_f8f6f4 %0, %1, %2, %0" : "+v"(acc[ai][bj][m][n]) : "v"(Bt##8[n]), "v"(At##8[m])); \
        else { _Pragma("unroll") for (int k = 0; k < 2; ++k) acc[ai][bj][m][n] = __builtin_amdgcn_mfma_f32_16x16x32_bf16(Bt[n][k], At[m][k], acc[ai][bj][m][n], 0, 0, 0); } } __builtin_amdgcn_s_setprio(0); } while (0)
#define PG8_WAIT_V(n) asm volatile("s_waitcnt vmcnt(" #n ")" ::: "memory")
#define PG8_WAIT_L(n) asm volatile("s_waitcnt lgkmcnt(" #n ")" ::: "memory")
#define PG8_BAR __builtin_amdgcn_s_barrier()
#define PG8_SCHED __builtin_amdgcn_sched_barrier(0)
    Unit cur, nxt; int ui = 0;
    if (!S.next(0, cur)) return;
    f32x4 acc[2][2][4][2];
#pragma unroll
    for (int a = 0; a < 2; ++a)
#pragma unroll
        for (int b = 0; b < 2; ++b)
#pragma unroll
            for (int m = 0; m < 4; ++m)
#pragma unroll
                for (int n = 0; n < 2; ++n) acc[a][b][m][n] = (f32x4){0.f, 0.f, 0.f, 0.f};
    bf16x8 At[4][2], B0[2][2], B1[2][2]; i32x8 At8[4], B08[2], B18[2];
    const char* cA = (const char*)g.A + (size_t)cur.pm * tstepA + cur.ka; const char* cB = (const char*)g.Bt + (size_t)cur.pn * tstepB + cur.kb;
    S.a_ready(cur);
    if constexpr (Sched::GATHER) { static_assert(!Sched::GATHER || SP2, "gather: SP2 loop only"); }
    if constexpr (SP2) {
        PG8_STAGE(PG8_SB(0, 0), cB, voffB); PG8_STAGE(PG8_SB(0, 1), cB + hstepB, voffB); PG8_STAGEA(PG8_SA(0, 0), cA, 0, false); PG8_STAGEA(PG8_SA(0, 1), cA, 1, false);
        if (wr == 1) PG8_BAR;
        PG8_WAIT_V(2); PG8_BAR;
        PG8_STAGE(PG8_SB(1, 0), cB + kstep, voffB); PG8_STAGEA(PG8_SA(1, 0), cA + kstep, 0, false); PG8_STAGE(PG8_SB(1, 1), cB + hstepB + kstep, voffB);
        PG8_WAIT_V(6); PG8_BAR;
    } else {
        PG8_STAGE(PG8_SB(0, 0), cB, voffB); PG8_STAGE(PG8_SA(0, 0), cA, voffA); PG8_STAGE(PG8_SB(0, 1), cB + hstepB, voffB); PG8_STAGE(PG8_SA(0, 1), cA + hstepA, voffA);
        if (wr == 1) PG8_BAR;
        PG8_WAIT_V(4); PG8_BAR;
        PG8_STAGE(PG8_SB(1, 0), cB + kstep, voffB); PG8_STAGE(PG8_SA(1, 0), cA + kstep, voffA); PG8_STAGE(PG8_SB(1, 1), cB + hstepB + kstep, voffB);
        PG8_WAIT_V(6); PG8_BAR;
    }
    for (;;) {
        const bool has_next = S.next(ui + 1, nxt);
        const char* nA = has_next ? (const char*)g.A + (size_t)nxt.pm * tstepA + nxt.ka : cA; const char* nB = has_next ? (const char*)g.Bt + (size_t)nxt.pn * tstepB + nxt.kb : cB;
#pragma unroll 1
        for (int t = 0; t < nt; t += 2) {
            const bool last = (t == nt - 2);
            const char* a1 = cA + (size_t)(t + 1) * kstep;
            const char* a2 = last ? nA : cA + (size_t)(t + 2) * kstep; const char* b2 = last ? nB : cB + (size_t)(t + 2) * kstep;
            const char* a3 = a2 + kstep; const char* b3 = b2 + kstep;
            if (last && has_next) S.a_ready(nxt);
            const bool nx = last && has_next;
            if constexpr (SP2) {
            PG8_LDB(B0, 0, 0); PG8_LDB(B1, 0, 1); PG8_SCHED; PG8_LDA(At, 0, 0); PG8_STAGEA(PG8_SA(1, 1), a1, 1, false);
            PG8_WAIT_V(8); PG8_WAIT_L(0); PG8_BAR; PG8_MMA(0, 0, At, B0); PG8_MMA(0, 1, At, B1); PG8_BAR; PG8_SCHED;
            PG8_LDA(At, 0, 1); PG8_STAGE(PG8_SB(0, 0), b2, voffB); PG8_STAGE(PG8_SB(0, 1), b2 + hstepB, voffB); PG8_STAGEA(PG8_SA(0, 0), a2, 0, nx);
            PG8_WAIT_V(8); PG8_WAIT_L(0); PG8_BAR; PG8_MMA(1, 0, At, B0); PG8_MMA(1, 1, At, B1); PG8_BAR; PG8_SCHED;
            PG8_LDB(B0, 1, 0); PG8_LDB(B1, 1, 1); PG8_SCHED; PG8_LDA(At, 1, 0); PG8_STAGEA(PG8_SA(0, 1), a2, 1, nx);
            PG8_WAIT_V(8); PG8_WAIT_L(0); PG8_BAR; PG8_MMA(0, 0, At, B0); PG8_MMA(0, 1, At, B1); PG8_BAR; PG8_SCHED;
            PG8_LDA(At, 1, 1); PG8_STAGE(PG8_SB(1, 0), b3, voffB); PG8_STAGE(PG8_SB(1, 1), b3 + hstepB, voffB); PG8_STAGEA(PG8_SA(1, 0), a3, 0, nx);
            PG8_WAIT_V(8); PG8_WAIT_L(0); PG8_BAR; PG8_MMA(1, 0, At, B0); PG8_MMA(1, 1, At, B1); PG8_BAR; PG8_SCHED;
            } else {
            PG8_LDB(B0, 0, 0); PG8_SCHED; PG8_LDA(At, 0, 0); PG8_STAGE(PG8_SA(1, 1), a1 + hstepA, voffA);
            PG8_WAIT_L(8); PG8_BAR; PG8_WAIT_L(0); PG8_MMA(0, 0, At, B0); PG8_BAR; PG8_SCHED;
            PG8_LDB(B1, 0, 1); PG8_STAGE(PG8_SB(0, 0), b2, voffB);
            PG8_BAR; PG8_WAIT_L(0); PG8_MMA(0, 1, At, B1); PG8_BAR;
            PG8_LDA(At, 0, 1); PG8_STAGE(PG8_SA(0, 0), a2, voffA);
            PG8_BAR; PG8_WAIT_L(0); PG8_MMA(1, 0, At, B0); PG8_BAR; PG8_SCHED;
            PG8_STAGE(PG8_SB(0, 1), b2 + hstepB, voffB);
            PG8_WAIT_V(6); PG8_BAR; PG8_MMA(1, 1, At, B1); PG8_BAR;
            PG8_LDB(B0, 1, 0); PG8_SCHED; PG8_LDA(At, 1, 0); PG8_STAGE(PG8_SA(0, 1), a2 + hstepA, voffA);
            PG8_WAIT_L(8); PG8_BAR; PG8_WAIT_L(0); PG8_MMA(0, 0, At, B0); PG8_BAR; PG8_SCHED;
            PG8_LDB(B1, 1, 1); PG8_STAGE(PG8_SB(1, 0), b3, voffB);
            PG8_BAR; PG8_WAIT_L(0); PG8_MMA(0, 1, At, B1); PG8_BAR;
            PG8_LDA(At, 1, 1); PG8_STAGE(PG8_SA(1, 0), a3, voffA);
            PG8_BAR; PG8_WAIT_L(0); PG8_MMA(1, 0, At, B0); PG8_BAR; PG8_SCHED;
            PG8_STAGE(PG8_SB(1, 1), b3 + hstepB, voffB);
            PG8_WAIT_V(6); PG8_BAR; PG8_MMA(1, 1, At, B1); PG8_BAR;
            }
        }
        if constexpr (FP8) { asm volatile("s_nop 15\n\ts_nop 15" ::: "memory"); PG8_SCHED; }
        if constexpr (ALIGN_EPI) { if (wr == 0) PG8_BAR; }
        if constexpr (!Epi::AFTER_DRAIN) { E(acc, cur, wr, wc, fr, fq); S.done(cur); }
        if (!has_next) break;
#pragma unroll
        for (int a = 0; a < 2; ++a)
#pragma unroll
            for (int b = 0; b < 2; ++b)
#pragma unroll
                for (int m = 0; m < 4; ++m)
#pragma unroll
                    for (int n = 0; n < 2; ++n) acc[a][b][m][n] = (f32x4){0.f, 0.f, 0.f, 0.f};
        cur = nxt; cA = nA; cB = nB; ++ui;
        if constexpr (ALIGN_EPI) { if (wr == 1) PG8_BAR; }
    }
    PG8_WAIT_V(0);
    if constexpr (!ALIGN_EPI) { if (wr == 0) PG8_BAR; }
    PG8_BAR;
#undef PG8_SA
#undef PG8_SB
#undef PG8_STAGE
#undef PG8_STAGEA
#undef PG8_GLD
#undef PG8_LDA
#undef PG8_RD16
#undef PG8_LDB
#undef PG8_MMA
#undef PG8_WAIT_V
#undef PG8_WAIT_L
#undef PG8_BAR
#undef PG8_SCHED
}
}
#define LAS __attribute__((address_space(3)))
#define GAS __attribute__((address_space(1)))
typedef unsigned short bf16_t;
typedef short bf16x8 __attribute__((ext_vector_type(8)));
typedef float f32x4 __attribute__((ext_vector_type(4)));
typedef unsigned u32x4 __attribute__((ext_vector_type(4)));
typedef unsigned u32x2 __attribute__((ext_vector_type(2)));
constexpr int D = 1024, NB = 4, SEQ = 8192, CTXL = 256, LT = SEQ + CTXL, NTOK = NB * LT, DEPTH = 4;
constexpr int RH = 4, RDK = 256, RDV = 512, RIN = 8192;
constexpr int MH = 8, MQL = 384, MKVL = 256, MIN_ = 704, MINP = 768;
constexpr int NE = 32, TOPK = 4;
constexpr int MAXTILES = 560, MAXSLOTS = MAXTILES * 256;
constexpr float EPS = 1e-6f, GN_EPS = 1e-5f;

__device__ __forceinline__ unsigned f2bf(float f) { unsigned u = __builtin_bit_cast(unsigned, f); return (u + 0x7fffu + ((u >> 16) & 1u)) >> 16; }
typedef float pk2_f32x2 __attribute__((ext_vector_type(2)));
typedef __bf16 pk2_bf16x2 __attribute__((ext_vector_type(2)));
__device__ __forceinline__ unsigned pk2(float lo, float hi) { const pk2_f32x2 v = {lo, hi}; return __builtin_bit_cast(unsigned, __builtin_convertvector(v, pk2_bf16x2)); }
__device__ __forceinline__ unsigned pk4_fp8(float a, float b, float c_, float d) { int w = 0; w = __builtin_amdgcn_cvt_pk_fp8_f32(a, b, w, false); w = __builtin_amdgcn_cvt_pk_fp8_f32(c_, d, w, true); return (unsigned)w; }
__device__ __forceinline__ float bf2f(unsigned short b) { return __builtin_bit_cast(float, (unsigned)b << 16); }
__device__ __forceinline__ float bflo(unsigned w) { return __builtin_bit_cast(float, w << 16); }
__device__ __forceinline__ float bfhi(unsigned w) { return __builtin_bit_cast(float, w & 0xffff0000u); }
#define SWZ_XOR(v, k) __builtin_bit_cast(float, __builtin_amdgcn_ds_swizzle(__builtin_bit_cast(int, (v)), ((k) << 10) | 0x1f))
__device__ __forceinline__ float wave_sum(float v) {
    v += SWZ_XOR(v, 1); v += SWZ_XOR(v, 2); v += SWZ_XOR(v, 4); v += SWZ_XOR(v, 8); v += SWZ_XOR(v, 16);
    return __builtin_bit_cast(float, __builtin_amdgcn_readlane(__builtin_bit_cast(int, v), 0)) + __builtin_bit_cast(float, __builtin_amdgcn_readlane(__builtin_bit_cast(int, v), 32));
}
__device__ __forceinline__ void wave_sum2(float a, float b, float& sa, float& sb) {
    unsigned ua = __builtin_bit_cast(unsigned, a), ub = __builtin_bit_cast(unsigned, b);
    asm volatile("s_nop 1\n\tv_permlane32_swap_b32 %0, %1" : "+v"(ua), "+v"(ub));
    float v = __builtin_bit_cast(float, ua) + __builtin_bit_cast(float, ub);
    v += SWZ_XOR(v, 1); v += SWZ_XOR(v, 2); v += SWZ_XOR(v, 4); v += SWZ_XOR(v, 8); v += SWZ_XOR(v, 16);
    sa = __builtin_bit_cast(float, __builtin_amdgcn_readlane(__builtin_bit_cast(int, v), 0)); sb = __builtin_bit_cast(float, __builtin_amdgcn_readlane(__builtin_bit_cast(int, v), 32));
}
__device__ __forceinline__ float wave_sum2v(float a, float b) {
    unsigned ua = __builtin_bit_cast(unsigned, a), ub = __builtin_bit_cast(unsigned, b);
    asm volatile("s_nop 1\n\tv_permlane32_swap_b32 %0, %1" : "+v"(ua), "+v"(ub));
    float v = __builtin_bit_cast(float, ua) + __builtin_bit_cast(float, ub);
    v += SWZ_XOR(v, 1); v += SWZ_XOR(v, 2); v += SWZ_XOR(v, 4); v += SWZ_XOR(v, 8); v += SWZ_XOR(v, 16);
    return v;
}
__device__ __forceinline__ float wave_max(float v) {
    v = fmaxf(v, SWZ_XOR(v, 1)); v = fmaxf(v, SWZ_XOR(v, 2)); v = fmaxf(v, SWZ_XOR(v, 4)); v = fmaxf(v, SWZ_XOR(v, 8)); v = fmaxf(v, SWZ_XOR(v, 16));
    return fmaxf(__builtin_bit_cast(float, __builtin_amdgcn_readlane(__builtin_bit_cast(int, v), 0)), __builtin_bit_cast(float, __builtin_amdgcn_readlane(__builtin_bit_cast(int, v), 32)));
}
__device__ __forceinline__ float silu_f(float x) { return x / (1.0f + __expf(-x)); }
__device__ __forceinline__ void sincos_red(float ang, float& s, float& c) {
    const double a = (double)ang; const double n = rint(a * 0.15915494309189535); const float rf = (float)(a - n * 6.283185307179586);
    s = __sinf(rf); c = __cosf(rf);
}
__device__ __forceinline__ float ret_theta(int d) { return (float)exp2(-(double)d * (13.287712379549449 / 127.0)); }
__device__ __forceinline__ float ax_freq(int i) { return (float)exp2(-(double)i * (13.287712379549449 / 16.0)); }
constexpr size_t al256c(size_t x) { return (x + 255) & ~(size_t)255; }
constexpr size_t WS_CTL = 0, CTL_BYTES = 1 << 20;
constexpr size_t WS_MOD = al256c(WS_CTL + CTL_BYTES);
constexpr size_t WS_COSR = al256c(WS_MOD + (size_t)DEPTH * 5 * 6144 * 4);
constexpr size_t WS_SINR = al256c(WS_COSR + (size_t)SEQ * 128 * 4);
constexpr size_t WS_COSM = al256c(WS_SINR + (size_t)SEQ * 128 * 4);
constexpr size_t WS_SINM = al256c(WS_COSM + (size_t)SEQ * 32 * 4);
constexpr size_t WS_TOKINFO = al256c(WS_SINM + (size_t)SEQ * 32 * 4);
constexpr size_t WS_LIST = al256c(WS_TOKINFO + (size_t)NTOK * 16 * 4);
constexpr size_t WS_PLAN = al256c(WS_LIST + (size_t)NE * NTOK * 4);
constexpr size_t WS_WRI = al256c(WS_PLAN + (size_t)DEPTH * 1024 * 4);
constexpr size_t WS_WRO = al256c(WS_WRI + (size_t)2 * 8192 * 1024 * 2);
constexpr size_t WS_WMI = al256c(WS_WRO + (size_t)2 * 1024 * 2048 * 2);
constexpr size_t WS_WUQ = al256c(WS_WMI + (size_t)2 * MINP * 1024 * 2);
constexpr size_t WS_WUKV = al256c(WS_WUQ + (size_t)2 * 1536 * 384 * 2);
constexpr size_t WS_WMO = al256c(WS_WUKV + (size_t)2 * 2048 * 256 * 2);
constexpr size_t WS_WUP = al256c(WS_WMO + (size_t)2 * 1024 * 1024 * 2);
constexpr size_t WS_WDN = al256c(WS_WUP + (size_t)DEPTH * NE * 2048 * 1024 * 2);
constexpr size_t WS_X = al256c(WS_WDN + (size_t)DEPTH * NE * 1024 * 1024 * 2);
constexpr size_t WS_H = al256c(WS_X + (size_t)NTOK * D * 4);
constexpr size_t WS_RA = al256c(WS_H + (size_t)NTOK * D * 2);
constexpr size_t WS_RB = al256c(WS_RA + (size_t)MAXSLOTS * 2048 * 4);
constexpr size_t WS_RC = al256c(WS_RB + (size_t)1107296256 + 4096);
constexpr size_t WS_END = al256c(WS_RC + (size_t)NTOK * D * 4 + (size_t)MAXSLOTS * D * 4);
constexpr int CW_CNT = 1024, CW_BAR = 4096;
constexpr int LDS_MISC = LDS_MISC_BASE, LDS_BYTES = 159744;
#define XB_TMO      128
#define XB_XCNT(j)  (256  + 64 * (j))
#define XB_XSUB(j)  (1280 + 64 * (j))
#define XB_XGEN(j)  (2304 + 64 * (j))
#define XB_TOP      3328
#define XB_TOPGEN   3392
#define XCD_BAR_WORDS 3456
#define XB_SPIN_CAP (1u << 22)
__device__ __forceinline__ unsigned xb_ld(unsigned* p)              { return __hip_atomic_load(p, __ATOMIC_RELAXED, __HIP_MEMORY_SCOPE_AGENT); }
__device__ __forceinline__ unsigned xb_add(unsigned* p, unsigned v) { return __hip_atomic_fetch_add(p, v, __ATOMIC_RELAXED, __HIP_MEMORY_SCOPE_AGENT); }
__device__ __forceinline__ unsigned xb_xcc_id() { return (unsigned)__builtin_amdgcn_s_getreg((3 << 11) | 20) & 0xFu; }
#define XB_SPIN(cond, bar) do { unsigned _sp = 0; while (cond) { __builtin_amdgcn_s_sleep(1); \
    if ((++_sp & 255u) == 0u) { if (xb_ld(&(bar)[XB_TMO])) break; if (_sp > XB_SPIN_CAP) { atomicAdd(&(bar)[XB_TMO], 1u); break; } } } } while (0)
struct XcdBarrier { unsigned* bar; unsigned x; volatile LAS unsigned* st; };
__device__ __forceinline__ XcdBarrier xcd_barrier_post(unsigned* bar, volatile LAS unsigned* st) {
    XcdBarrier b; b.bar = bar; b.x = xb_xcc_id(); b.st = st;
    if (threadIdx.x == 0) (void)xb_add(&bar[XB_XCNT(b.x)], 1u);
    return b;
}
__device__ __forceinline__ void xcd_barrier_complete(unsigned* bar, unsigned x, unsigned& nloc, unsigned& nx) {
    const unsigned G = gridDim.x * gridDim.y * gridDim.z;
    unsigned sum, cnt, mine, sp = 0u;
    for (;;) {
        sum = 0u; cnt = 0u; mine = 0u;
#pragma unroll
        for (unsigned j = 0; j < 16; ++j) { const unsigned c = xb_ld(&bar[XB_XCNT(j)]); sum += c; cnt += (c > 0u) ? 1u : 0u; mine = (j == x) ? c : mine; }
        if (sum == G) break;
        __builtin_amdgcn_s_sleep(1);
        if ((++sp & 255u) == 0u) { if (xb_ld(&bar[XB_TMO])) break; if (sp > XB_SPIN_CAP) { atomicAdd(&bar[XB_TMO], 1u); break; } }
    }
    nloc = mine > 0u ? mine : 1u; nx = cnt > 0u ? cnt : 1u;
}
__device__ __forceinline__ void xcd_barrier(const XcdBarrier& b0) {
    XcdBarrier b; { unsigned* q = b0.bar; unsigned xx = b0.x; asm volatile("" : "+s"(q), "+s"(xx)); b.bar = q; b.x = xx; b.st = b0.st; }
    asm volatile("s_waitcnt vmcnt(0)" ::: "memory");
    __syncthreads();
    if (threadIdx.x == 0) {
        unsigned* bar = b.bar;
        __builtin_amdgcn_s_waitcnt(0);
        unsigned nloc = b.st[0], nx = b.st[1];
        if (nloc == 0u) { xcd_barrier_complete(bar, b.x, nloc, nx); b.st[0] = nloc; b.st[1] = nx; }
        const unsigned old = xb_add(&bar[XB_XSUB(b.x)], 1u);
        const unsigned gen = old / nloc;
        if (old + 1u == (gen + 1u) * nloc) {
            __builtin_amdgcn_fence(__ATOMIC_RELEASE, "agent");
            asm volatile("s_waitcnt vmcnt(0)" ::: "memory");
            const unsigned og = xb_add(&bar[XB_TOP], 1u);
            const unsigned tg = og / nx;
            if (og + 1u == (tg + 1u) * nx) xb_add(&bar[XB_TOPGEN], 1u);
            else XB_SPIN(xb_ld(&bar[XB_TOPGEN]) == tg, bar);
            __builtin_amdgcn_fence(__ATOMIC_ACQUIRE, "agent");
            xb_add(&bar[XB_XGEN(b.x)], 1u);
            asm volatile("s_waitcnt vmcnt(0)" ::: "memory");
        } else {
            XB_SPIN(xb_ld(&bar[XB_XGEN(b.x)]) == gen, bar);
            __builtin_amdgcn_fence(__ATOMIC_ACQUIRE, "agent");
            asm volatile("s_waitcnt vmcnt(0)" ::: "memory");
        }
    }
    __syncthreads();
}
#define PH_TID ph_tid()
__device__ __forceinline__ void gemm_f32_phase(LAS unsigned char* lds, const bf16_t* A, const bf16_t* Bt, float* C, int M, int N, int K, int lda, int ldb, int ldc) {
    pg8::Gemm g{A, Bt, K, lda, ldb};
    pg8::StaticOrder S; S.init(M, N, (int)gridDim.x, (int)blockIdx.x);
    pg8::EpiF32 E{C, ldc, nullptr, 1 << 30, 0};
    pg8::gemm_phase<pg8::EpiF32, pg8::StaticOrder, true, true>(lds, g, S, E);
}
struct MoeOrder {
    static constexpr bool GATHER = false;
    const int* plan; int nN, G, c;
    __device__ bool next(int i, pg8::Unit& u) const {
        const int T = __builtin_amdgcn_readfirstlane(plan[64]); const long L = (long)i * G + c; const int nwg = T * nN; if (L >= nwg) return false;
        int wgid = (int)L; { const int q = nwg / 8, r = nwg % 8, xcd = wgid % 8, off = wgid / 8; wgid = (xcd < r ? xcd * (q + 1) : r * (q + 1) + (xcd - r) * q) + off; }
        const int nig = 8 * nN, gid = wgid / nig, fm = gid * 8, gsz = (T - fm) < 8 ? (T - fm) : 8;
        const int pm = fm + ((wgid % nig) % gsz), pcl = (wgid % nig) / gsz; const int e = __builtin_amdgcn_readfirstlane(plan[128 + pm]);
        u.pm = pm; u.pn = e * nN + pcl; u.pc = pcl; u.ka = 0u; u.kb = 0u; return true;
    }
    __device__ __forceinline__ void a_ready(const pg8::Unit&) const {}
    __device__ __forceinline__ void done(const pg8::Unit&) const {}
};
__device__ __forceinline__ void moe_gemm_f32_phase(LAS unsigned char* lds, const bf16_t* A, const bf16_t* Bt, float* C, const float* bias, const int* plan, int nN, int K, int ldc, int bstride) {
    pg8::Gemm g{A, Bt, K, K, K};
    MoeOrder S{plan, nN, (int)gridDim.x, (int)blockIdx.x};
    pg8::EpiF32 E{C, ldc, bias, nN, bstride};
    pg8::gemm_phase<pg8::EpiF32, MoeOrder, true, true>(lds, g, S, E);
}
template <int MODE = 0> __device__ __forceinline__ void ph_transpose(LAS unsigned char* lds, const float* src, bf16_t* dst, int K, int N, int ldd, int nbatch, long sstride, long dstride, int bid, int nblk) {
    LAS float* tile = (LAS float*)lds;
    const int tid = PH_TID;
    const int nkb = K / 64, nnb = (N + 127) / 128; const long per = (long)nkb * nnb, ntl = per * nbatch;
    for (long it = bid; it < ntl; it += nblk) {
        const int bt = (int)(it / per), r = (int)(it % per), kb = r / nnb, nb = r % nnb, k0 = kb * 64, n0 = nb * 128;
        const float* s = src + (size_t)bt * sstride; bf16_t* d = dst + (size_t)bt * dstride;
#pragma unroll
        for (int i = 0; i < 16; ++i) { const int kk = i * 4 + (tid >> 7), nn = tid & 127; tile[kk * 129 + nn] = (n0 + nn < N) ? s[(size_t)(k0 + kk) * N + n0 + nn] : 0.f; }
        __syncthreads();
#pragma unroll
        for (int j = 0; j < 2; ++j) { const int nn = (tid >> 3) + 64 * j, c = tid & 7;
            if (MODE == 3 || n0 + nn < N) { u32x4 o; o.x = pk2(tile[(8 * c) * 129 + nn]    , tile[(8 * c + 1) * 129 + nn]); o.y = pk2(tile[(8 * c + 2) * 129 + nn], tile[(8 * c + 3) * 129 + nn]);
                o.z = pk2(tile[(8 * c + 4) * 129 + nn], tile[(8 * c + 5) * 129 + nn]); o.w = pk2(tile[(8 * c + 6) * 129 + nn], tile[(8 * c + 7) * 129 + nn]);
                int rown = n0 + nn; if (MODE == 1) { const int jn = rown & 1023; rown = (jn >> 7) * 256 + (rown >> 10) * 128 + (jn & 127); }
                if (MODE == 2) { const int hd = rown / 192, dd = rown % 192; if (dd < 128) rown = hd * 128 + dd; else { const int rr = dd - 128; rown = 1024 + (hd >> 2) * 256 + (rr >> 5) * 128 + (hd & 3) * 32 + (rr & 31); } }
                *(u32x4*)(d + (size_t)rown * ldd + k0 + 8 * c) = o; } }
        __syncthreads();
    }
}
template <int MODE> __device__ __forceinline__ int tr_rowmap(int rown) {
    if (MODE == 1) { const int jn = rown & 1023; return (jn >> 7) * 256 + (rown >> 10) * 128 + (jn & 127); }
    return rown;
}
template <int MODE = 0> __device__ __forceinline__ void ph_transpose_direct(const float* src, bf16_t* dst, int K, int N, int ldd, int nbatch, long sstride, long dstride, int bid, int nblk) {
    const int tid = PH_TID, n4 = tid & 63, kc = tid >> 6;
    const int nkb = K / 64, nnb = N / 256; const long per = (long)nkb * nnb, ntl = per * nbatch;
    constexpr int NT_ = 4;
    for (long it0 = bid; it0 < ntl; it0 += (long)NT_ * nblk) {
        f32x4 v[NT_][8]; bf16_t* dp[NT_][4]; bool ok[NT_];
#pragma unroll
        for (int u = 0; u < NT_; ++u) { const long it = it0 + (long)u * nblk; ok[u] = it < ntl; const long itc = ok[u] ? it : it0;
            const int bt = (int)(itc / per), r = (int)(itc % per), kb = r / nnb, nb = r % nnb, k0 = kb * 64, n0 = nb * 256;
            const float* sp = src + (size_t)bt * sstride + (size_t)(k0 + 8 * kc) * N + n0 + 4 * n4;
#pragma unroll
            for (int q = 0; q < 4; ++q) dp[u][q] = dst + (size_t)bt * dstride + (size_t)tr_rowmap<MODE>(n0 + 4 * n4 + q) * ldd + k0 + 8 * kc;
#pragma unroll
            for (int i = 0; i < 8; ++i) v[u][i] = *(const f32x4*)(sp + (size_t)i * N); }
#pragma unroll
        for (int u = 0; u < NT_; ++u) if (ok[u]) {
#pragma unroll
            for (int q = 0; q < 4; ++q) { u32x4 o; o.x = pk2(v[u][0][q], v[u][1][q]); o.y = pk2(v[u][2][q], v[u][3][q]); o.z = pk2(v[u][4][q], v[u][5][q]); o.w = pk2(v[u][6][q], v[u][7][q]);
                *(u32x4*)dp[u][q] = o; } }
    }
}
constexpr float W8S = 32.0f, W8I = 1.0f / 32.0f;
template <int MODE = 0> __device__ __forceinline__ void ph_transpose_direct8(const float* src, unsigned char* dst, int K, int N, int ldd, int nbatch, long sstride, long dstride, int bid, int nblk) {
    const int tid = PH_TID, n4 = tid & 63, kc = tid >> 6;
    const int nkb = K / 64, nnb = N / 256; const long per = (long)nkb * nnb, ntl = per * nbatch;
    constexpr int NT_ = 4;
    for (long it0 = bid; it0 < ntl; it0 += (long)NT_ * nblk) {
        f32x4 v[NT_][8]; unsigned char* dp[NT_][4]; bool ok[NT_];
#pragma unroll
        for (int u = 0; u < NT_; ++u) { const long it = it0 + (long)u * nblk; ok[u] = it < ntl; const long itc = ok[u] ? it : it0;
            const int bt = (int)(itc / per), r = (int)(itc % per), kb = r / nnb, nb = r % nnb, k0 = kb * 64, n0 = nb * 256;
            const float* sp = src + (size_t)bt * sstride + (size_t)(k0 + 8 * kc) * N + n0 + 4 * n4;
#pragma unroll
            for (int q = 0; q < 4; ++q) dp[u][q] = dst + (size_t)bt * dstride + (size_t)tr_rowmap<MODE>(n0 + 4 * n4 + q) * ldd + k0 + 8 * kc;
#pragma unroll
            for (int i = 0; i < 8; ++i) v[u][i] = *(const f32x4*)(sp + (size_t)i * N); }
#pragma unroll
        for (int u = 0; u < NT_; ++u) if (ok[u]) {
#pragma unroll
            for (int q = 0; q < 4; ++q) { u32x2 o; o.x = pk4_fp8(v[u][0][q] * W8S, v[u][1][q] * W8S, v[u][2][q] * W8S, v[u][3][q] * W8S); o.y = pk4_fp8(v[u][4][q] * W8S, v[u][5][q] * W8S, v[u][6][q] * W8S, v[u][7][q] * W8S);
                *(u32x2*)dp[u][q] = o; } }
    }
}
constexpr int CT_PER_LAYER = 6144, CT_TOTAL = 3 * CT_PER_LAYER;
constexpr int CT_NSLOT = 10;
constexpr int CT_THR[CT_NSLOT] = {128, 64, 16, 32, 16, 128, 64, 16, 32, 16};
constexpr int CT_TPW[CT_NSLOT] = {10, 12, 16, 4, 8, 10, 12, 16, 4, 8};
constexpr int ct_deadline_after(int s) { return s == 4 ? 1 : (s == 7 ? 2 : (s == 9 ? 3 : 0)); }
constexpr int ct_slot_start(int s) {
    int pos = 0;
    for (int i = 0; i < s; ++i) { pos += (256 - CT_THR[i]) * CT_TPW[i]; const int d = ct_deadline_after(i); if (d && pos < d * CT_PER_LAYER) pos = d * CT_PER_LAYER; }
    return pos;
}
constexpr int ct_drain_start(int layer) {
    const int s = layer == 1 ? 4 : (layer == 2 ? 7 : 9);
    const int pos = ct_slot_start(s) + (256 - CT_THR[s]) * CT_TPW[s];
    return pos < layer * CT_PER_LAYER ? pos : layer * CT_PER_LAYER;
}
__device__ __forceinline__ void ct_convert(const float* exp_w_up, const float* exp_w_down, unsigned char* WUP, unsigned char* WDN, int g0, int n) {
    if (g0 >= CT_TOTAL) return;
    const int tid = PH_TID, n4 = tid & 63, kc = tid >> 6;
    for (int base = 0; base < n; base += 4) {
        f32x4 v[4][8]; unsigned char* dp[4][4]; bool ok[4];
#pragma unroll
        for (int u = 0; u < 4; ++u) { const int g = g0 + base + u; ok[u] = (base + u < n) && g < CT_TOTAL; const int gc = ok[u] ? g : 0;
            const int L = 1 + gc / CT_PER_LAYER, t = gc % CT_PER_LAYER; const bool up = t < 4096; const int tt = up ? t : t - 4096;
            const int e = up ? (tt >> 7) : (tt >> 6), w = up ? (tt & 127) : (tt & 63), kb = up ? (w >> 3) : (w >> 2), nb = up ? (w & 7) : (w & 3), N = up ? 2048 : 1024;
            const float* sp = (up ? exp_w_up + (size_t)(L * NE + e) * 1024 * 2048 : exp_w_down + (size_t)(L * NE + e) * 1024 * 1024) + (size_t)(kb * 64 + 8 * kc) * N + nb * 256 + 4 * n4;
            unsigned char* db = (up ? WUP + (size_t)(L * NE + e) * 2048 * 1024 : WDN + (size_t)(L * NE + e) * 1024 * 1024) + kb * 64 + 8 * kc;
#pragma unroll
            for (int q = 0; q < 4; ++q) { const int col = nb * 256 + 4 * n4 + q; dp[u][q] = db + (size_t)(up ? tr_rowmap<1>(col) : col) * 1024; }
#pragma unroll
            for (int i = 0; i < 8; ++i) v[u][i] = *(const f32x4*)(sp + (size_t)i * N); }
#pragma unroll
        for (int u = 0; u < 4; ++u) if (ok[u]) {
#pragma unroll
            for (int q = 0; q < 4; ++q) { u32x2 o; o.x = pk4_fp8(v[u][0][q] * W8S, v[u][1][q] * W8S, v[u][2][q] * W8S, v[u][3][q] * W8S); o.y = pk4_fp8(v[u][4][q] * W8S, v[u][5][q] * W8S, v[u][6][q] * W8S, v[u][7][q] * W8S);
                *(u32x2*)dp[u][q] = o; } }
    }
}
template <int SLOT> __device__ __forceinline__ void ct_slot(const float* exp_w_up, const float* exp_w_down, unsigned char* WUP, unsigned char* WDN, int bid) {
    constexpr int start = ct_slot_start(SLOT), thr = CT_THR[SLOT], tpw = CT_TPW[SLOT];
    if (start < CT_TOTAL && bid >= thr) ct_convert(exp_w_up, exp_w_down, WUP, WDN, start + (bid - thr) * tpw, tpw);
}
template <int LAYER> __device__ __forceinline__ void ct_drain(const float* exp_w_up, const float* exp_w_down, unsigned char* WUP, unsigned char* WDN, int bid, int nblk) {
    constexpr int a = ct_drain_start(LAYER), b = LAYER * CT_PER_LAYER;
    if constexpr (a < b) { const int per = (b - a + nblk - 1) / nblk; const int g0 = a + bid * per; const int n = g0 + per <= b ? per : (b > g0 ? b - g0 : 0); if (n > 0) ct_convert(exp_w_up, exp_w_down, WUP, WDN, g0, n); }
}
__device__ __forceinline__ void ph_zero16(u32x4* p, long n16, int bid, int nblk) { for (long i = bid * 512L + PH_TID; i < n16; i += nblk * 512L) p[i] = (u32x4){0u, 0u, 0u, 0u}; }
__device__ __forceinline__ void ph_adaln(LAS unsigned char* lds, const float* c, const float* c_ctx, const float* ada_w, const float* ada_b, float* MOD, int bid, int nblk) {
    LAS float* sv = (LAS float*)lds; LAS float* red = sv + 5 * 1024;
    const int tid = PH_TID;
    for (int i = tid; i < 5 * 1024; i += 512) { const int v = i >> 10, k = i & 1023; const float x = v < 4 ? c[v * 1024 + k] : c_ctx[k]; sv[i] = silu_f(x); }
    __syncthreads();
    for (int item = bid; item < DEPTH * 96; item += nblk) {
        const int l = item / 96, n0 = (item % 96) * 64, cc = tid & 63, ks = tid >> 6;
        const float* w = ada_w + (size_t)l * 1024 * 6144 + n0 + cc;
        float a0 = 0, a1 = 0, a2 = 0, a3 = 0, a4 = 0;
        for (int k = ks * 128; k < ks * 128 + 128; ++k) { const float wv = w[(size_t)k * 6144]; a0 += sv[k] * wv; a1 += sv[1024 + k] * wv; a2 += sv[2048 + k] * wv; a3 += sv[3072 + k] * wv; a4 += sv[4096 + k] * wv; }
        red[(ks * 5 + 0) * 64 + cc] = a0; red[(ks * 5 + 1) * 64 + cc] = a1; red[(ks * 5 + 2) * 64 + cc] = a2; red[(ks * 5 + 3) * 64 + cc] = a3; red[(ks * 5 + 4) * 64 + cc] = a4;
        __syncthreads();
        if (tid < 320) { const int v = tid >> 6; float s = 0; for (int q = 0; q < 8; ++q) s += red[(q * 5 + v) * 64 + cc]; MOD[((size_t)l * 5 + v) * 6144 + n0 + cc] = s + ada_b[(size_t)l * 6144 + n0 + cc]; }
        __syncthreads();
    }
}
__device__ __forceinline__ void ph_rot_tables(float* COSR, float* SINR, float* COSM, float* SINM, int bid, int nblk) {
    const long gt = bid * 512L + PH_TID, NG = nblk * 512L;
    for (long i = gt; i < (long)SEQ * 128; i += NG) { const int t = (int)(i >> 7), d = (int)(i & 127); float s, c; sincos_red((float)t * ret_theta(d), s, c); COSR[i] = c; SINR[i] = s; }
    for (long i = gt; i < (long)SEQ * 32; i += NG) { const int t = (int)(i >> 5), j = (int)(i & 31); const int row = t >> 6, col = t & 63;
        const float ang = j < 16 ? (float)row * ax_freq(j) : (float)col * ax_freq(j - 16); float s, c; sincos_red(ang, s, c); COSM[i] = c; SINM[i] = s; }
}

struct EpiSwiGLU {
    static constexpr bool PERM = true, AFTER_DRAIN = false;
    unsigned char* ACT; const float* bias; int nN;
    __device__ __forceinline__ void operator()(const pg8::f32x4 (&acc)[2][2][4][2], const pg8::Unit& u, int wr, int wc, int fr, int fq) const {
        int row0 = u.pm * 256 + wr * 64 + fr, j0 = u.pc * 128 + wc * 32 + 8 * fq; asm volatile("" : "+v"(row0), "+v"(j0));
        const float* bp = bias + (size_t)(u.pn / nN) * 2048 + j0;
        const pg8::f32x4 bg0 = *(const pg8::f32x4*)bp, bg1 = *(const pg8::f32x4*)(bp + 4), bl0 = *(const pg8::f32x4*)(bp + 1024), bl1 = *(const pg8::f32x4*)(bp + 1028);
#pragma unroll
        for (int ai = 0; ai < 2; ++ai)
#pragma unroll
            for (int m = 0; m < 4; ++m) { float o[8];
#pragma unroll
                for (int n = 0; n < 2; ++n)
#pragma unroll
                    for (int e = 0; e < 4; ++e) { const float g = fminf(acc[ai][0][m][n][e] * W8I + (n ? bg1[e] : bg0[e]), 7.0f), l = fminf(fmaxf(acc[ai][1][m][n][e] * W8I + (n ? bl1[e] : bl0[e]), -7.0f), 7.0f);
                        o[n * 4 + e] = g * __builtin_amdgcn_rcpf(1.0f + __expf(-1.702f * g)) * (l + 1.0f); }
                u32x2 w; w.x = pk4_fp8(o[0], o[1], o[2], o[3]); w.y = pk4_fp8(o[4], o[5], o[6], o[7]);
                *(u32x2*)(ACT + (size_t)(row0 + ai * 128 + m * 16) * 1024 + j0) = w; }
    }
};
struct EpiDownBf16 {
    static constexpr bool PERM = true, AFTER_DRAIN = false;
    bf16_t* YD; const float* bias; int nN;
    __device__ __forceinline__ void operator()(const pg8::f32x4 (&acc)[2][2][4][2], const pg8::Unit& u, int wr, int wc, int fr, int fq) const {
        int row0 = u.pm * 256 + wr * 64 + fr, c0 = u.pc * 256 + wc * 32 + 8 * fq; asm volatile("" : "+v"(row0), "+v"(c0));
        const float* bp = bias + (size_t)(u.pn / nN) * 1024 + c0;
        pg8::f32x4 bv[2][2];
#pragma unroll
        for (int bj = 0; bj < 2; ++bj) { bv[bj][0] = *(const pg8::f32x4*)(bp + bj * 128); bv[bj][1] = *(const pg8::f32x4*)(bp + bj * 128 + 4); }
#pragma unroll
        for (int ai = 0; ai < 2; ++ai)
#pragma unroll
            for (int m = 0; m < 4; ++m)
#pragma unroll
                for (int bj = 0; bj < 2; ++bj) { const pg8::f32x4 v0 = acc[ai][bj][m][0] * W8I + bv[bj][0], v1 = acc[ai][bj][m][1] * W8I + bv[bj][1];
                    u32x4 w; w.x = pk2(v0[0], v0[1]); w.y = pk2(v0[2], v0[3]); w.z = pk2(v1[0], v1[1]); w.w = pk2(v1[2], v1[3]);
                    *(u32x4*)(YD + (size_t)(row0 + ai * 128 + m * 16) * 1024 + c0 + bj * 128) = w; }
    }
};
struct MoeOrderG : MoeOrder { static constexpr bool GATHER = true; };
__device__ __forceinline__ void moe_plan_local(LAS unsigned char* lds, const int* cnt, int* plan_g, int bid);
__device__ __forceinline__ void moe_up_phase(LAS unsigned char* lds, const unsigned char* H8, const unsigned char* Wup8, unsigned char* ACT8, const float* b_up, const int* cnt, int* plan_g, const int* list) {
    moe_plan_local(lds, cnt, plan_g, (int)blockIdx.x);
    const int* plan = (const int*)(lds + 151552);
    pg8::Gemm g{(const bf16_t*)H8, (const bf16_t*)Wup8, 512, 512, 512};
    MoeOrderG S; S.plan = plan; S.nN = 8; S.G = (int)gridDim.x; S.c = (int)blockIdx.x; EpiSwiGLU E{ACT8, b_up, 8};
    { const int tid = ph_tid(); LAS unsigned* tab = (LAS unsigned*)(lds + LDS_GTAB);
      int tk[20], pmv[20]; bool okv[20];
#pragma unroll
      for (int ui = 0; ui < 20; ++ui) { pg8::Unit u; okv[ui] = S.next(ui, u); pmv[ui] = u.pm; }
      const LAS int* lp = (const LAS int*)(lds + 151552);
#pragma unroll
      for (int ui = 0; ui < 20; ++ui) { tk[ui] = 0;
          if (okv[ui] && tid < 256) { const int r = pmv[ui] * 256 + tid, e = lp[128 + pmv[ui]], pos = r - lp[e]; if (pos < lp[32 + e]) tk[ui] = ((const GAS int*)list)[(size_t)e * NTOK + pos]; } }
#pragma unroll
      for (int ui = 0; ui < 20; ++ui) if (okv[ui] && tid < 256) tab[ui * 256 + tid] = (unsigned)tk[ui] * 1024u;
      __syncthreads(); }
    pg8::gemm_phase<EpiSwiGLU, MoeOrderG, true, true, true>(lds, g, S, E);
}
__device__ __forceinline__ void moe_down_phase(LAS unsigned char* lds, const unsigned char* ACT8, const unsigned char* Wdn8, bf16_t* YD, const float* b_down, const int* plan) {
    pg8::Gemm g{(const bf16_t*)ACT8, (const bf16_t*)Wdn8, 512, 512, 512}; MoeOrder S{plan, 4, (int)gridDim.x, (int)blockIdx.x}; EpiDownBf16 E{YD, b_down, 4};
    pg8::gemm_phase<EpiDownBf16, MoeOrder, true, true, true>(lds, g, S, E);
}
__device__ __forceinline__ u32x4 pk8(const pg8::f32x4& a, const pg8::f32x4& b) { u32x4 w; w.x = pk2(a[0], a[1]); w.y = pk2(a[2], a[3]); w.z = pk2(b[0], b[1]); w.w = pk2(b[2], b[3]); return w; }
struct EpiMlaQ {
    static constexpr bool PERM = true, AFTER_DRAIN = false;
    unsigned char* Q8; const float* COSM; const float* SINM;
    __device__ __forceinline__ void operator()(const pg8::f32x4 (&acc)[2][2][4][2], const pg8::Unit& u, int wr, int wc, int fr, int fq) const {
        const int t2 = ph_tid(), wd2 = t2 >> 6, ln2 = t2 & 63; wc = wd2 & 3;
        const int row0 = u.pm * 256 + (wd2 >> 2) * 64 + (ln2 & 15), c8 = wc * 32 + 8 * (ln2 >> 4);
        if (u.pc < 4) {
#pragma unroll
            for (int ai = 0; ai < 2; ++ai)
#pragma unroll
                for (int m = 0; m < 4; ++m) { const unsigned qo = (unsigned)(row0 + ai * 128 + m * 16) * 1536u + (unsigned)c8;
#pragma unroll
                    for (int bj = 0; bj < 2; ++bj) { const pg8::f32x4 a = acc[ai][bj][m][0], b = acc[ai][bj][m][1]; u32x2 w; w.x = pk4_fp8(a[0], a[1], a[2], a[3]); w.y = pk4_fp8(b[0], b[1], b[2], b[3]);
                        *(u32x2*)(Q8 + (qo + (unsigned)((u.pc * 2 + bj) * 192))) = w; } }
        } else {
            const int hd = (u.pc - 4) * 4 + wc, i0 = c8 - wc * 32;
#pragma unroll
            for (int ai = 0; ai < 2; ++ai)
#pragma unroll
                for (int m = 0; m < 4; ++m) { const int tok = row0 + ai * 128 + m * 16, s = tok % LT; const bool lat = s >= CTXL;
                    const unsigned ro = lat ? (unsigned)(s - CTXL) * 128u + (unsigned)i0 * 4u : 0u;
                    const unsigned qo = (unsigned)tok * 1536u + (unsigned)(hd * 192 + 128 + i0); u32x2 w1, w2;
#pragma unroll
                    for (int n = 0; n < 2; ++n) { pg8::f32x4 c = *(const pg8::f32x4*)((const char*)COSM + ro + 16 * n), sn = *(const pg8::f32x4*)((const char*)SINM + ro + 16 * n);
                        if (!lat) { c = (pg8::f32x4){1.f, 1.f, 1.f, 1.f}; sn = (pg8::f32x4){0.f, 0.f, 0.f, 0.f}; }
                        const pg8::f32x4 x1 = acc[ai][0][m][n], x2 = acc[ai][1][m][n], o1 = x1 * c - x2 * sn, o2 = x1 * sn + x2 * c;
                        const unsigned p1 = pk4_fp8(o1[0], o1[1], o1[2], o1[3]), p2 = pk4_fp8(o2[0], o2[1], o2[2], o2[3]);
                        if (n == 0) { w1.x = p1; w2.x = p2; } else { w1.y = p1; w2.y = p2; } }
                    *(u32x2*)(Q8 + qo) = w1; *(u32x2*)(Q8 + (qo + 32u)) = w2; }
        }
    }
};
struct EpiMlaKV {
    static constexpr bool PERM = true, AFTER_DRAIN = false;
    unsigned char* K8; bf16_t* Vh;
    __device__ __forceinline__ void operator()(const pg8::f32x4 (&acc)[2][2][4][2], const pg8::Unit& u, int wr, int wc, int fr, int fq) const {
        const int t2 = ph_tid(), wd2 = t2 >> 6, ln2 = t2 & 63;
        const int row0 = u.pm * 256 + (wd2 >> 2) * 64 + (ln2 & 15), c8 = (wd2 & 3) * 32 + 8 * (ln2 >> 4);
#pragma unroll
        for (int ai = 0; ai < 2; ++ai)
#pragma unroll
            for (int m = 0; m < 4; ++m) { const unsigned tok = (unsigned)(row0 + ai * 128 + m * 16);
                const pg8::f32x4 a = acc[ai][0][m][0], b = acc[ai][0][m][1]; u32x2 w; w.x = pk4_fp8(a[0], a[1], a[2], a[3]); w.y = pk4_fp8(b[0], b[1], b[2], b[3]);
                *(u32x2*)(K8 + (tok * 1536u + (unsigned)(u.pc * 192 + c8))) = w;
                *(u32x4*)((unsigned char*)Vh + (tok * 2048u + (unsigned)(u.pc * 128 + c8) * 2u)) = pk8(acc[ai][1][m][0], acc[ai][1][m][1]); }
    }
};
__device__ __forceinline__ void mla_q_phase(LAS unsigned char* lds, const bf16_t* CQ, const bf16_t* Wuq, unsigned char* Qh, const float* COSM, const float* SINM) {
    pg8::Gemm g{CQ, Wuq, 384, 384, 384}; pg8::StaticOrder S; S.init(NTOK, 1536, (int)gridDim.x, (int)blockIdx.x); EpiMlaQ E{Qh, COSM, SINM};
    pg8::gemm_phase<EpiMlaQ, pg8::StaticOrder, true, true>(lds, g, S, E);
}
__device__ __forceinline__ void mla_kv_phase(LAS unsigned char* lds, const bf16_t* CKV, const bf16_t* Wukv, unsigned char* Kh, bf16_t* Vh) {
    pg8::Gemm g{CKV, Wukv, 256, 256, 256}; pg8::StaticOrder S; S.init(NTOK, 2048, (int)gridDim.x, (int)blockIdx.x); EpiMlaKV E{Kh, Vh};
    pg8::gemm_phase<EpiMlaKV, pg8::StaticOrder, true, true>(lds, g, S, E);
}

struct EpiResid {
    static constexpr bool PERM = false, AFTER_DRAIN = false;
    float* X; const float* gvec;
    __device__ __forceinline__ void operator()(const pg8::f32x4 (&acc)[2][2][4][2], const pg8::Unit& u, int wr, int wc, int fr, int fq) const {
        const int t2 = ph_tid(), wd2 = t2 >> 6, ln2 = t2 & 63;
        const int row0 = u.pm * 256 + (wd2 >> 2) * 64 + (ln2 & 15), col0 = u.pc * 256 + (wd2 & 3) * 32 + 4 * (ln2 >> 4);
#pragma unroll
        for (int ai = 0; ai < 2; ++ai)
#pragma unroll
            for (int m = 0; m < 4; ++m) { const int tok = row0 + ai * 128 + m * 16, b = tok / LT, v = (tok - b * LT) < CTXL ? 4 : b;
                float* xr = X + (size_t)tok * D + col0; const float* gr = gvec + (size_t)v * 6144 + col0;
#pragma unroll
                for (int bj = 0; bj < 2; ++bj)
#pragma unroll
                    for (int n = 0; n < 2; ++n) { const pg8::f32x4 g = *(const pg8::f32x4*)(gr + bj * 128 + n * 16); pg8::f32x4 x = *(const pg8::f32x4*)(xr + bj * 128 + n * 16);
                        x += g * acc[ai][bj][m][n]; *(pg8::f32x4*)(xr + bj * 128 + n * 16) = x; } }
    }
};
__device__ __forceinline__ void resid_gemm_phase(LAS unsigned char* lds, const bf16_t* A, const bf16_t* Wt, int K, float* X, const float* gvec) {
    pg8::Gemm g{A, Wt, K, K, K}; pg8::StaticOrder S; S.init(NTOK, 1024, (int)gridDim.x, (int)blockIdx.x); EpiResid E{X, gvec};
    pg8::gemm_phase<EpiResid, pg8::StaticOrder, true, true>(lds, g, S, E);
}
struct RowP {
    const float* x_in; const float* ctx_in;
    float* X; bf16_t* H; float* out;
    const float* Z;
    const bf16_t* YD; const int* tokinfo; const int* planprev;
    const float* gvec;
    const float* normw; const float* shiftv; const float* scalev;
    const float* router_w; const float* router_b;
    int* cnt; int* tokinfo_out; int* list;
    int skip_ctx;
};
#ifndef EXPERIMENT_MOE_SCALE
#define EXPERIMENT_MOE_SCALE 1.0f
#endif
enum { RP_FIRST = 1, RP_ADD_DENSE = 2, RP_ADD_MOE = 4, RP_ROUTER = 8, RP_FINAL = 16 };
template <int F> __device__ __forceinline__ void ph_rowphase(LAS unsigned char* lds, const RowP& p, int bid, int nblk) {
    LAS float* rw = (LAS float*)lds;
    LAS int* hist = (LAS int*)(lds + 131072); LAS int* base = hist + 32; LAS int* rec = (LAS int*)(lds + 131072 + 256);
    const int tid = PH_TID, lane = tid & 63, wave = tid >> 6;
    if (F & RP_ROUTER) {
        for (int i4 = tid; i4 < 1024 * 8; i4 += 512) { const int d = i4 >> 3, ec = i4 & 7; const int ln = (d & 255) >> 2, ii = d & 3, j = d >> 8;
            *(LAS f32x4*)(rw + (((j * 4 + ii) * 8 + ec) * 64 + ln) * 4) = *(const f32x4*)(p.router_w + (size_t)i4 * 4); }
        if (tid < 32) hist[tid] = 0;
        __syncthreads();
    }
    const int gw = bid * 8 + wave, NGW = nblk * 8; int nrec = 0;
    const float rbias = p.router_b[lane & 31];
#define RP_SRC(t_) ((F & RP_FIRST) ? (((t_) % LT) < CTXL ? p.ctx_in + ((size_t)((t_) / LT) * CTXL + ((t_) % LT)) * D : p.x_in + ((size_t)((t_) / LT) * SEQ + (((t_) % LT) - CTXL)) * D) : p.X + (size_t)(t_) * D)
    f32x4 nx[4];
    if (gw < NTOK) { const float* s0 = RP_SRC(gw);
#pragma unroll
        for (int j = 0; j < 4; ++j) nx[j] = *(const f32x4*)(s0 + 4 * lane + 256 * j); }
    for (int tok = gw; tok < NTOK; tok += NGW) {
        const int b = tok / LT, s = tok % LT; const bool isctx = s < CTXL; const int v = isctx ? 4 : b;
        f32x4 xv[4];
#pragma unroll
        for (int j = 0; j < 4; ++j) xv[j] = nx[j];
        if (tok + NGW < NTOK) { const float* s1 = RP_SRC(tok + NGW);
#pragma unroll
            for (int j = 0; j < 4; ++j) nx[j] = *(const f32x4*)(s1 + 4 * lane + 256 * j); }
        if ((F & RP_FINAL) && isctx) continue;
        if (F & RP_ADD_DENSE) {
#pragma unroll
            for (int j = 0; j < 4; ++j) { const f32x4 g = *(const f32x4*)(p.gvec + (size_t)v * 6144 + 4 * lane + 256 * j); const f32x4 z = *(const f32x4*)(p.Z + (size_t)tok * D + 4 * lane + 256 * j); xv[j] += g * z; }
        }
        if (F & RP_ADD_MOE) {
            if (!(p.skip_ctx && isctx)) {
            f32x4 a[4] = {{0,0,0,0},{0,0,0,0},{0,0,0,0},{0,0,0,0}};
            for (int k = 0; k < 4; ++k) { const int e = p.tokinfo[(tok * 4 + k) * 4], pos = p.tokinfo[(tok * 4 + k) * 4 + 1]; const float gt = __builtin_bit_cast(float, p.tokinfo[(tok * 4 + k) * 4 + 2]);
                const bf16_t* yr = p.YD + (size_t)(p.planprev[e] + pos) * D;
#pragma unroll
                for (int j = 0; j < 4; ++j) { const u32x2 w = *(const u32x2*)(yr + 4 * lane + 256 * j); a[j] += gt * (f32x4){bflo(w.x), bfhi(w.x), bflo(w.y), bfhi(w.y)}; } }
#pragma unroll
            for (int j = 0; j < 4; ++j) { const f32x4 g = *(const f32x4*)(p.gvec + (size_t)v * 6144 + 4 * lane + 256 * j); xv[j] += g * a[j] * EXPERIMENT_MOE_SCALE; }
            }
        }
        if (F & (RP_FIRST | RP_ADD_DENSE | RP_ADD_MOE)) {
            if (!(F & RP_FINAL)) {
#pragma unroll
            for (int j = 0; j < 4; ++j) *(f32x4*)(p.X + (size_t)tok * D + 4 * lane + 256 * j) = xv[j]; }
        }
        float ss = 0.f;
#pragma unroll
        for (int j = 0; j < 4; ++j) ss += (xv[j].x * xv[j].x + xv[j].y * xv[j].y) + (xv[j].z * xv[j].z + xv[j].w * xv[j].w);
        const float r = rsqrtf(wave_sum(ss) * (1.0f / D) + EPS);
        if (F & RP_FINAL) {
#pragma unroll
            for (int j = 0; j < 4; ++j) { const f32x4 nw = *(const f32x4*)(p.normw + 4 * lane + 256 * j); *(f32x4*)(p.out + ((size_t)b * SEQ + (s - CTXL)) * D + 4 * lane + 256 * j) = xv[j] * r * nw; }
            continue;
        }
        f32x4 h[4];
#pragma unroll
        for (int j = 0; j < 4; ++j) { const int col = 4 * lane + 256 * j; const f32x4 nw = *(const f32x4*)(p.normw + col), sh = *(const f32x4*)(p.shiftv + (size_t)v * 6144 + col), sc = *(const f32x4*)(p.scalev + (size_t)v * 6144 + col);
            h[j] = (xv[j] * r * nw) * (1.0f + sc) + sh;
            u32x2 w; w.x = pk2(h[j].x, h[j].y); w.y = pk2(h[j].z, h[j].w); *(u32x2*)(p.H + (size_t)tok * D + col) = w; }
        if (F & RP_ROUTER) {
            if (p.skip_ctx && isctx) continue;
            float lg[32];
#pragma unroll
            for (int e = 0; e < 32; ++e) lg[e] = 0.f;
#pragma unroll
            for (int j = 0; j < 4; ++j)
#pragma unroll
                for (int ii = 0; ii < 4; ++ii) { const float hv = h[j][ii];
#pragma unroll
                    for (int ec = 0; ec < 8; ++ec) { const f32x4 w = *(const LAS f32x4*)(rw + (((j * 4 + ii) * 8 + ec) * 64 + lane) * 4);
                        lg[ec * 4 + 0] += hv * w.x; lg[ec * 4 + 1] += hv * w.y; lg[ec * 4 + 2] += hv * w.z; lg[ec * 4 + 3] += hv * w.w; } }
#pragma unroll
            for (int e = 0; e < 32; ++e) lg[e] = wave_sum(lg[e]) + p.router_b[e];
            float v0 = -3.0e38f, v1 = -3.0e38f, v2 = -3.0e38f, v3 = -3.0e38f; int i0 = 0, i1 = 0, i2 = 0, i3 = 0;
#pragma unroll
            for (int e = 0; e < 32; ++e) { const float xx = lg[e]; const bool g0 = xx > v0, g1 = xx > v1, g2 = xx > v2, g3 = xx > v3;
                v3 = g2 ? v2 : (g3 ? xx : v3); i3 = g2 ? i2 : (g3 ? e : i3);
                v2 = g1 ? v1 : (g2 ? xx : v2); i2 = g1 ? i1 : (g2 ? e : i2);
                v1 = g0 ? v0 : (g1 ? xx : v1); i1 = g0 ? i0 : (g1 ? e : i1);
                v0 = g0 ? xx : v0; i0 = g0 ? e : i0; }
            const float pe0 = 1.0f, pe1 = __expf(v1 - v0), pe2 = __expf(v2 - v0), pe3 = __expf(v3 - v0); const float ps = (pe0 + pe1) + (pe2 + pe3);
            if (lane < 4) { int e = i0; float g = pe0;
                if (lane == 1) { e = i1; g = pe1; } if (lane == 2) { e = i2; g = pe2; } if (lane == 3) { e = i3; g = pe3; }
                g = g / ps;
                const int lpos = __hip_atomic_fetch_add(&hist[e], 1, __ATOMIC_RELAXED, __HIP_MEMORY_SCOPE_WORKGROUP);
                LAS int* rc = rec + ((wave * 17 + nrec) * 4 + lane) * 4; rc[0] = tok; rc[1] = e; rc[2] = lpos; rc[3] = __builtin_bit_cast(int, g); }
            ++nrec;
        }
    }
#undef RP_SRC
    if (F & RP_ROUTER) {
        __syncthreads();
        if (tid < 32) base[tid] = atomicAdd(&p.cnt[tid], hist[tid]);
        __syncthreads();
        for (int i = lane; i < nrec * 4; i += 64) { const LAS int* rc = rec + (wave * 17 * 4 + i) * 4; const int tok = rc[0], e = rc[1], pos = base[e] + rc[2]; const int k = i & 3;
            int* ti = p.tokinfo_out + (tok * 4 + k) * 4; ti[0] = e; ti[1] = pos; ti[2] = rc[3]; ti[3] = 0;
            p.list[(size_t)e * NTOK + pos] = tok; }
    }
}

#define RR_ROW(HX, TOK, DOSTORE) do { const int tok_ = (TOK); const int b_ = tok_ / LT, s_ = tok_ % LT; const int v_ = s_ < CTXL ? 4 : b_; \
        f32x4 xv_[4]; float ss_ = 0.f; \
        _Pragma("unroll") for (int j = 0; j < 4; ++j) { xv_[j] = *(const f32x4*)(p.X + (size_t)tok_ * D + 4 * lane + 256 * j); ss_ += (xv_[j].x * xv_[j].x + xv_[j].y * xv_[j].y) + (xv_[j].z * xv_[j].z + xv_[j].w * xv_[j].w); } \
        const float r_ = rsqrtf(wave_sum(ss_) * (1.0f / D) + EPS); \
        _Pragma("unroll") for (int j = 0; j < 4; ++j) { const int col = 4 * lane + 256 * j; const f32x4 nw = *(const f32x4*)(p.normw + col), sh = *(const f32x4*)(p.shiftv + (size_t)v_ * 6144 + col), sc = *(const f32x4*)(p.scalev + (size_t)v_ * 6144 + col); \
            HX[j] = (xv_[j] * r_ * nw) * (1.0f + sc) + sh; \
            if (DOSTORE) { *(unsigned*)((unsigned char*)p.H + (size_t)tok_ * D + col) = pk4_fp8(HX[j].x, HX[j].y, HX[j].z, HX[j].w); } } } while (0)
#define RR_FINISH(LG, TOK) do { \
        _Pragma("unroll") for (int e = 0; e < 32; ++e) LG[e] = LG[e] + p.router_b[e]; \
        float v0 = -3.0e38f, v1 = -3.0e38f, v2 = -3.0e38f, v3 = -3.0e38f; int i0 = 0, i1 = 0, i2 = 0, i3 = 0; \
        _Pragma("unroll") for (int e = 0; e < 32; ++e) { const float xx = LG[e]; const bool g0 = xx > v0, g1 = xx > v1, g2 = xx > v2, g3 = xx > v3; \
            v3 = g2 ? v2 : (g3 ? xx : v3); i3 = g2 ? i2 : (g3 ? e : i3); \
            v2 = g1 ? v1 : (g2 ? xx : v2); i2 = g1 ? i1 : (g2 ? e : i2); \
            v1 = g0 ? v0 : (g1 ? xx : v1); i1 = g0 ? i0 : (g1 ? e : i1); \
            v0 = g0 ? xx : v0; i0 = g0 ? e : i0; } \
        const float pe1 = __expf(v1 - v0), pe2 = __expf(v2 - v0), pe3 = __expf(v3 - v0); const float ps = (1.0f + pe1) + (pe2 + pe3); \
        if (lane < 4) { int e = i0; float g = 1.0f; \
            if (lane == 1) { e = i1; g = pe1; } if (lane == 2) { e = i2; g = pe2; } if (lane == 3) { e = i3; g = pe3; } \
            g = g / ps; \
            const int lpos = __hip_atomic_fetch_add(&hist[e], 1, __ATOMIC_RELAXED, __HIP_MEMORY_SCOPE_WORKGROUP); \
            LAS int* rc = rec + ((wave * 17 + nrec) * 4 + lane) * 4; rc[0] = (TOK); rc[1] = e; rc[2] = lpos; rc[3] = __builtin_bit_cast(int, g); } \
        ++nrec; } while (0)
__device__ __forceinline__ void ph_rowrouter(LAS unsigned char* lds, const RowP& p, int bid, int nblk) {
    LAS float* rw = (LAS float*)lds;
    LAS int* hist = (LAS int*)(lds + 131072); LAS int* base = hist + 32; LAS int* rec = (LAS int*)(lds + 131072 + 256);
    const int tid = PH_TID, lane = tid & 63, wave = tid >> 6;
    for (int i4 = tid; i4 < 1024 * 8; i4 += 512) { const int d = i4 >> 3, ec = i4 & 7; const int ln = (d & 255) >> 2, ii = d & 3, j = d >> 8;
        *(LAS f32x4*)(rw + (((j * 4 + ii) * 8 + ec) * 64 + ln) * 4) = *(const f32x4*)(p.router_w + (size_t)i4 * 4); }
    if (tid < 32) hist[tid] = 0;
    __syncthreads();
    const int gw = bid * 8 + wave, NGW = nblk * 8; int nrec = 0;
    const float rbias = p.router_b[lane & 31];
    for (int tokA = gw; tokA < NTOK; tokA += 2 * NGW) {
        const int tokB = tokA + NGW; const bool hasB = tokB < NTOK; const int tokBc = hasB ? tokB : tokA;
        f32x4 hA[4], hB[4];
        RR_ROW(hA, tokA, true);
        RR_ROW(hB, tokBc, hasB);
        const bool routeA = !(p.skip_ctx && (tokA % LT) < CTXL), routeB = hasB && !(p.skip_ctx && (tokBc % LT) < CTXL);
        if (!(routeA || routeB)) continue;
        const int le = lane & 31; float L = 0.f;
#pragma unroll
        for (int half = 0; half < 2; ++half) {
            typedef float f32x2 __attribute__((ext_vector_type(2)));
            f32x2 aA[8], aB[8];
#pragma unroll
            for (int e = 0; e < 8; ++e) { aA[e] = (f32x2){0.f, 0.f}; aB[e] = (f32x2){0.f, 0.f}; }
#pragma unroll
            for (int j = 0; j < 4; ++j)
#pragma unroll
                for (int ii = 0; ii < 4; ++ii) { const f32x2 ha = {hA[j][ii], hA[j][ii]}, hb = {hB[j][ii], hB[j][ii]};
#pragma unroll
                    for (int ec = 0; ec < 4; ++ec) { const f32x4 w = *(const LAS f32x4*)(rw + (((j * 4 + ii) * 8 + half * 4 + ec) * 64 + lane) * 4);
                        const f32x2 w01 = {w.x, w.y}, w23 = {w.z, w.w};
                        aA[ec * 2 + 0] = __builtin_elementwise_fma(ha, w01, aA[ec * 2 + 0]); aA[ec * 2 + 1] = __builtin_elementwise_fma(ha, w23, aA[ec * 2 + 1]);
                        aB[ec * 2 + 0] = __builtin_elementwise_fma(hb, w01, aB[ec * 2 + 0]); aB[ec * 2 + 1] = __builtin_elementwise_fma(hb, w23, aB[ec * 2 + 1]); } }
#pragma unroll
            for (int e = 0; e < 8; ++e) { const float s0 = wave_sum2v(aA[e].x, aB[e].x), s1 = wave_sum2v(aA[e].y, aB[e].y);
                L = le == half * 16 + 2 * e ? s0 : L; L = le == half * 16 + 2 * e + 1 ? s1 : L; }
        }
        L += rbias;
        float vk[4]; int iA[4], iB[4]; float wv = L;
#pragma unroll
        for (int k = 0; k < 4; ++k) { float m = wv; m = fmaxf(m, SWZ_XOR(m, 1)); m = fmaxf(m, SWZ_XOR(m, 2)); m = fmaxf(m, SWZ_XOR(m, 4)); m = fmaxf(m, SWZ_XOR(m, 8)); m = fmaxf(m, SWZ_XOR(m, 16));
            const unsigned long long bal = __builtin_amdgcn_ballot_w64(wv == m);
            iA[k] = __builtin_ctz((unsigned)bal); iB[k] = __builtin_ctz((unsigned)(bal >> 32)); vk[k] = m;
            wv = le == (lane < 32 ? iA[k] : iB[k]) ? -3.0e38f : wv; }
        const float pe1 = __expf(vk[1] - vk[0]), pe2 = __expf(vk[2] - vk[0]), pe3 = __expf(vk[3] - vk[0]); const float ps = (1.0f + pe1) + (pe2 + pe3);
        { const bool hiB = lane >= 32; const bool mine = hiB ? routeB : routeA; const int myrec = nrec + ((hiB && routeA) ? 1 : 0);
          if (le < 4 && mine) { int e = hiB ? iB[0] : iA[0]; float g = 1.0f;
              if (le == 1) { e = hiB ? iB[1] : iA[1]; g = pe1; } if (le == 2) { e = hiB ? iB[2] : iA[2]; g = pe2; } if (le == 3) { e = hiB ? iB[3] : iA[3]; g = pe3; }
              g = g / ps;
              const int lpos = __hip_atomic_fetch_add(&hist[e], 1, __ATOMIC_RELAXED, __HIP_MEMORY_SCOPE_WORKGROUP);
              LAS int* rc = rec + ((wave * 17 + myrec) * 4 + le) * 4; rc[0] = hiB ? tokB : tokA; rc[1] = e; rc[2] = lpos; rc[3] = __builtin_bit_cast(int, g); }
          nrec += (routeA ? 1 : 0) + (routeB ? 1 : 0); }
    }
    __syncthreads();
    if (tid < 32) base[tid] = atomicAdd(&p.cnt[tid], hist[tid]);
    __syncthreads();
    for (int i = lane; i < nrec * 4; i += 64) { const LAS int* rc = rec + (wave * 17 * 4 + i) * 4; const int tok = rc[0], e = rc[1], pos = base[e] + rc[2]; const int k = i & 3;
        int* ti = p.tokinfo_out + (tok * 4 + k) * 4; ti[0] = e; ti[1] = pos; ti[2] = rc[3]; ti[3] = 0;
        p.list[(size_t)e * NTOK + pos] = tok; }
}
#undef RR_ROW
#undef RR_FINISH
struct RetPostP { const float* P; const float* COSR; const float* SINR; bf16_t* Q; bf16_t* Kb; bf16_t* VT; bf16_t* GF; bf16_t* GB; };
__device__ __forceinline__ void ph_ret_post(const RetPostP& p, int bid, int nblk) {
    const int tid_ = PH_TID, lane = tid_ & 63, gw = bid * 8 + (tid_ >> 6), NGW = nblk * 8;
    for (int grp = gw; grp < NTOK / 8; grp += NGW) {
        const int tok0 = grp * 8, b = tok0 / LT, s0 = tok0 % LT; const bool isctx = s0 < CTXL;
        for (int i = 0; i < 8; ++i) {
            const int tok = tok0 + i; const float* pr = p.P + (size_t)tok * RIN; const int t = s0 + i - CTXL;
#pragma unroll
            for (int qk = 0; qk < 2; ++qk) {
                const float sc = qk ? 0.0625f : 1.0f; bf16_t* dst = (qk ? p.Kb : p.Q) + (size_t)tok * 1024;
#pragma unroll
                for (int h = 0; h < 4; ++h)
#pragma unroll
                    for (int jj = 0; jj < 2; ++jj) { const int d = lane + 64 * jj; const float x1 = pr[qk * 1024 + h * 256 + d] * sc, x2 = pr[qk * 1024 + h * 256 + 128 + d] * sc; float o1 = x1, o2 = x2;
                        if (!isctx) { const float c = p.COSR[(size_t)t * 128 + d], sn = p.SINR[(size_t)t * 128 + d]; o1 = x1 * c - x2 * sn; o2 = x1 * sn + x2 * c; }
                        dst[h * 256 + d] = (bf16_t)f2bf(o1); dst[h * 256 + 128 + d] = (bf16_t)f2bf(o2); }
            }
#pragma unroll
            for (int jj = 0; jj < 8; ++jj) { const int c4 = (lane + 64 * jj) * 4; const f32x4 gf = *(const f32x4*)(pr + 4096 + c4), gb = *(const f32x4*)(pr + 6144 + c4);
                u32x2 w; w.x = pk2(silu_f(gf.x), silu_f(gf.y)); w.y = pk2(silu_f(gf.z), silu_f(gf.w)); *(u32x2*)(p.GF + (size_t)tok * 2048 + c4) = w;
                w.x = pk2(silu_f(gb.x), silu_f(gb.y)); w.y = pk2(silu_f(gb.z), silu_f(gb.w)); *(u32x2*)(p.GB + (size_t)tok * 2048 + c4) = w; }
        }
        for (int jj = 0; jj < 32; ++jj) { const int col = lane + 64 * jj;
            float vv[8];
#pragma unroll
            for (int i = 0; i < 8; ++i) vv[i] = p.P[(size_t)(tok0 + i) * RIN + 2048 + col];
            u32x4 o; o.x = pk2(vv[0], vv[1]); o.y = pk2(vv[2], vv[3]); o.z = pk2(vv[4], vv[5]); o.w = pk2(vv[6], vv[7]);
            *(u32x4*)(p.VT + ((size_t)b * 2048 + col) * LT + s0) = o; }
    }
}
struct RetDecayP { const float* S; bf16_t* PF; bf16_t* PB; const float* logit; int h; };
__device__ __forceinline__ void ph_ret_decay(const RetDecayP& p, int bid, int nblk) {
    const float lf = -log1pf(expf(-p.logit[p.h])) * 1.4426950408889634f, lb = -log1pf(expf(-p.logit[4 + p.h])) * 1.4426950408889634f;
    const long n8 = (long)LT * (LT / 8);
    for (long i8 = bid * 512L + PH_TID; i8 < n8; i8 += nblk * 512L) {
        const int i = (int)(i8 / (LT / 8)), j0 = (int)(i8 % (LT / 8)) * 8; const int ibi = i < CTXL ? 255 - i : 8703 - i;
        const f32x4 s0 = *(const f32x4*)(p.S + (size_t)i * LT + j0), s1 = *(const f32x4*)(p.S + (size_t)i * LT + j0 + 4);
        float sv[8] = {s0.x, s0.y, s0.z, s0.w, s1.x, s1.y, s1.z, s1.w}; float f[8], bk[8];
#pragma unroll
        for (int q = 0; q < 8; ++q) { const int j = j0 + q; const int ibj = j < CTXL ? 255 - j : 8703 - j;
            f[q] = i >= j ? sv[q] * exp2f((float)(i - j) * lf) : 0.f; bk[q] = ibi >= ibj ? sv[q] * exp2f((float)(ibi - ibj) * lb) : 0.f; }
        u32x4 o; o.x = pk2(f[0], f[1]); o.y = pk2(f[2], f[3]); o.z = pk2(f[4], f[5]); o.w = pk2(f[6], f[7]); *(u32x4*)(p.PF + (size_t)i * LT + j0) = o;
        o.x = pk2(bk[0], bk[1]); o.y = pk2(bk[2], bk[3]); o.z = pk2(bk[4], bk[5]); o.w = pk2(bk[6], bk[7]); *(u32x4*)(p.PB + (size_t)i * LT + j0) = o;
    }
}
struct RetGateP { const float* OF; const float* OB; const bf16_t* GF; const bf16_t* GB; const float* gn; bf16_t* Y; };
__device__ __forceinline__ void ph_ret_gate(const RetGateP& p, int bid, int nblk) {
    const int tid_ = PH_TID, lane = tid_ & 63, gw = bid * 8 + (tid_ >> 6), NGW = nblk * 8;
    for (int tok = gw; tok < NTOK; tok += NGW) {
#pragma unroll
        for (int h = 0; h < 4; ++h) {
            const int c0 = h * 512 + lane * 8; float yo[8];
#pragma unroll
            for (int dir = 0; dir < 2; ++dir) {
                const float* o = (dir ? p.OB : p.OF) + (size_t)tok * 2048 + c0; const f32x4 a = *(const f32x4*)o, bq = *(const f32x4*)(o + 4);
                float v[8] = {a.x, a.y, a.z, a.w, bq.x, bq.y, bq.z, bq.w}; float sm = 0.f;
#pragma unroll
                for (int q = 0; q < 8; ++q) sm += v[q];
                const float mu = wave_sum(sm) * (1.0f / 512.0f); float sq = 0.f;
#pragma unroll
                for (int q = 0; q < 8; ++q) { v[q] -= mu; sq += v[q] * v[q]; }
                const float rstd = rsqrtf(wave_sum(sq) * (1.0f / 512.0f) + GN_EPS);
                const u32x4 gw4 = *(const u32x4*)((dir ? p.GB : p.GF) + (size_t)tok * 2048 + c0);
                const float g[8] = {bflo(gw4.x), bfhi(gw4.x), bflo(gw4.y), bfhi(gw4.y), bflo(gw4.z), bfhi(gw4.z), bflo(gw4.w), bfhi(gw4.w)};
                const float* gnp = p.gn + dir * 2048 + c0;
#pragma unroll
                for (int q = 0; q < 8; ++q) { const float t = g[q] * (v[q] * rstd * gnp[q]); yo[q] = dir ? yo[q] + t : t; }
            }
            u32x4 o; o.x = pk2(yo[0], yo[1]); o.y = pk2(yo[2], yo[3]); o.z = pk2(yo[4], yo[5]); o.w = pk2(yo[6], yo[7]);
            *(u32x4*)(p.Y + (size_t)tok * 2048 + c0) = o;
        }
    }
}
struct MlaPostP { const float* P; const float* qn; const float* kvn; const float* COSM; const float* SINM; bf16_t* CQ; bf16_t* CKV; float* KR; };
__device__ __forceinline__ void ph_mla_post(const MlaPostP& p, int bid, int nblk) {
    const int tid_ = PH_TID, lane = tid_ & 63, gw = bid * 8 + (tid_ >> 6), NGW = nblk * 8;
    for (int tok = gw; tok < NTOK; tok += NGW) {
        const float* pr = p.P + (size_t)tok * MINP; const int s = tok % LT; const bool isctx = s < CTXL; const int t = s - CTXL;
        float q[6], ss = 0.f;
#pragma unroll
        for (int i = 0; i < 6; ++i) { q[i] = pr[lane + 64 * i]; ss += q[i] * q[i]; }
        float r = rsqrtf(wave_sum(ss) * (1.0f / 384.0f) + EPS);
#pragma unroll
        for (int i = 0; i < 6; ++i) p.CQ[(size_t)tok * 384 + lane + 64 * i] = (bf16_t)f2bf(q[i] * r * p.qn[lane + 64 * i]);
        float kv[4]; ss = 0.f;
#pragma unroll
        for (int i = 0; i < 4; ++i) { kv[i] = pr[384 + lane + 64 * i]; ss += kv[i] * kv[i]; }
        r = rsqrtf(wave_sum(ss) * (1.0f / 256.0f) + EPS);
#pragma unroll
        for (int i = 0; i < 4; ++i) p.CKV[(size_t)tok * 256 + lane + 64 * i] = (bf16_t)f2bf(kv[i] * r * p.kvn[lane + 64 * i]);
        if (lane < 32) { const float x1 = pr[640 + lane], x2 = pr[672 + lane]; float o1 = x1, o2 = x2;
            if (!isctx) { const float c = p.COSM[(size_t)t * 32 + lane], sn = p.SINM[(size_t)t * 32 + lane]; o1 = x1 * c - x2 * sn; o2 = x1 * sn + x2 * c; }
            p.KR[(size_t)tok * 64 + lane] = o1; p.KR[(size_t)tok * 64 + 32 + lane] = o2; }
    }
}
struct MlaBuildP { const float* QF; const float* KVF; const float* KR; const float* COSM; const float* SINM; bf16_t* Qp; bf16_t* Kp; bf16_t* VT; };
__device__ __forceinline__ void ph_mla_build(const MlaBuildP& p, int bid, int nblk) {
    const int tid_ = PH_TID, lane = tid_ & 63, gw = bid * 8 + (tid_ >> 6), NGW = nblk * 8;
    for (int grp = gw; grp < NTOK / 8; grp += NGW) {
        const int tok0 = grp * 8, b = tok0 / LT, s0 = tok0 % LT; const bool isctx = s0 < CTXL;
        for (int i = 0; i < 8; ++i) {
            const int tok = tok0 + i, t = s0 + i - CTXL; const float* qf = p.QF + (size_t)tok * 1536; const float* kvf = p.KVF + (size_t)tok * 2048; const float* kr = p.KR + (size_t)tok * 64;
#pragma unroll
            for (int h = 0; h < 8; ++h) {
                bf16_t* qd = p.Qp + (size_t)tok * 2048 + h * 256; bf16_t* kd = p.Kp + (size_t)tok * 2048 + h * 256;
                qd[lane] = (bf16_t)f2bf(qf[h * 192 + lane]); qd[64 + lane] = (bf16_t)f2bf(qf[h * 192 + 64 + lane]);
                { const int ii = lane & 31; const float x1 = qf[h * 192 + 128 + ii], x2 = qf[h * 192 + 160 + ii]; float o1 = x1, o2 = x2;
                  if (!isctx) { const float c = p.COSM[(size_t)t * 32 + ii], sn = p.SINM[(size_t)t * 32 + ii]; o1 = x1 * c - x2 * sn; o2 = x1 * sn + x2 * c; }
                  qd[128 + lane] = (bf16_t)f2bf(lane < 32 ? o1 : o2); }
                qd[192 + lane] = 0;
                kd[lane] = (bf16_t)f2bf(kvf[h * 256 + lane]); kd[64 + lane] = (bf16_t)f2bf(kvf[h * 256 + 64 + lane]);
                kd[128 + lane] = (bf16_t)f2bf(kr[lane]); kd[192 + lane] = 0;
            }
        }
        for (int jj = 0; jj < 16; ++jj) { const int col = lane + 64 * jj; const int h = col >> 7, dv = col & 127;
            float vv[8];
#pragma unroll
            for (int i = 0; i < 8; ++i) vv[i] = p.KVF[(size_t)(tok0 + i) * 2048 + h * 256 + 128 + dv];
            u32x4 o; o.x = pk2(vv[0], vv[1]); o.y = pk2(vv[2], vv[3]); o.z = pk2(vv[4], vv[5]); o.w = pk2(vv[6], vv[7]);
            *(u32x4*)(p.VT + (((size_t)b * 8 + h) * 256 + dv) * LT + s0) = o; }
    }
}
__device__ __forceinline__ void ph_softmax(const float* S, bf16_t* P, int M, int N, int ldsm, int ldp, float scale, int bid, int nblk) {
    const int tid_ = PH_TID, lane = tid_ & 63, gw = bid * 8 + (tid_ >> 6), NGW = nblk * 8;
    const float c = scale * 1.4426950408889634f;
    for (int r = gw; r < M; r += NGW) {
        const float* sr = S + (size_t)r * ldsm; float mx = -3.0e38f;
        for (int j = lane * 4; j < N; j += 256) { const f32x4 v = *(const f32x4*)(sr + j); mx = fmaxf(fmaxf(mx, fmaxf(v.x, v.y)), fmaxf(v.z, v.w)); }
        mx = wave_max(mx); float sm = 0.f;
        for (int j = lane * 4; j < N; j += 256) { const f32x4 v = *(const f32x4*)(sr + j); sm += exp2f((v.x - mx) * c) + exp2f((v.y - mx) * c) + exp2f((v.z - mx) * c) + exp2f((v.w - mx) * c); }
        const float inv = 1.0f / wave_sum(sm);
        for (int j = lane * 4; j < N; j += 256) { const f32x4 v = *(const f32x4*)(sr + j); u32x2 w; w.x = pk2(exp2f((v.x - mx) * c) * inv, exp2f((v.y - mx) * c) * inv); w.y = pk2(exp2f((v.z - mx) * c) * inv, exp2f((v.w - mx) * c) * inv);
            *(u32x2*)(P + (size_t)r * ldp + j) = w; }
    }
}
__device__ __forceinline__ void ph_mla_opack(const float* OFm, bf16_t* O, int bid, int nblk) {
    for (long i = bid * 512L + PH_TID; i < (long)NTOK * 256; i += nblk * 512L) { const long tok = i >> 8; const int c4 = (int)(i & 255) * 4; const int h = c4 >> 7, dv = c4 & 127;
        const f32x4 v = *(const f32x4*)(OFm + tok * 2048 + h * 256 + dv); u32x2 w; w.x = pk2(v.x, v.y); w.y = pk2(v.z, v.w); *(u32x2*)(O + tok * 1024 + c4) = w; }
}
__device__ __forceinline__ void ph_moe_plan(const int* cnt, int* plan, int bid, int nblk) {
    if (PH_TID == 0 && bid == 0) { int off = 0, nt = 0;
        for (int e = 0; e < NE; ++e) { const int c = cnt[e]; plan[e] = off; plan[32 + e] = c; const int tl = (c + 255) / 256; for (int q = 0; q < tl; ++q) plan[128 + nt + q] = e; nt += tl; off += tl * 256; }
        plan[64] = nt; }
}
__device__ __forceinline__ void ph_moe_gather(const bf16_t* H, const int* plan, const int* list, bf16_t* AP, int bid, int nblk) {
    const int tid_ = PH_TID, lane = tid_ & 63, gw = bid * 8 + (tid_ >> 6), NGW = nblk * 8; const int nrows = plan[64] * 256;
    for (int r = gw; r < nrows; r += NGW) { const int e = plan[128 + (r >> 8)], pos = r - plan[e]; u32x4 a = {0, 0, 0, 0}, bq = {0, 0, 0, 0};
        if (pos < plan[32 + e]) { const int tok = list[(size_t)e * NTOK + pos]; a = *(const u32x4*)(H + (size_t)tok * D + lane * 8); bq = *(const u32x4*)(H + (size_t)tok * D + 512 + lane * 8); }
        *(u32x4*)(AP + (size_t)r * D + lane * 8) = a; *(u32x4*)(AP + (size_t)r * D + 512 + lane * 8) = bq; }
}
__device__ __forceinline__ void ph_moe_act(const float* U, const int* plan, bf16_t* ACT, int bid, int nblk) {
    const long n = (long)plan[64] * 256 * 256;
    for (long i = bid * 512L + PH_TID; i < n; i += nblk * 512L) { const long r = i >> 8; const int c4 = (int)(i & 255) * 4;
        const f32x4 g = *(const f32x4*)(U + r * 2048 + c4), l = *(const f32x4*)(U + r * 2048 + 1024 + c4); float o[4];
#pragma unroll
        for (int q = 0; q < 4; ++q) { const float gl = fminf(g[q], 7.0f), ln = fminf(fmaxf(l[q], -7.0f), 7.0f); o[q] = gl / (1.0f + __expf(-1.702f * gl)) * (ln + 1.0f); }
        u32x2 w; w.x = pk2(o[0], o[1]); w.y = pk2(o[2], o[3]); *(u32x2*)(ACT + r * 1024 + c4) = w; }
}

struct MlaBuild2P { const float* QF; const float* KVF; const float* KR; const float* COSM; const float* SINM; bf16_t* Qh; bf16_t* Kh; bf16_t* Vh; };
__device__ __forceinline__ void ph_mla_build2(const MlaBuild2P& p, int bid, int nblk) {
    const int tid_ = PH_TID, lane = tid_ & 63, gw = bid * 8 + (tid_ >> 6), NGW = nblk * 8;
    for (int tok = gw; tok < NTOK; tok += NGW) {
        const int s = tok % LT; const bool isctx = s < CTXL; const int t = s - CTXL;
        const float* qf = p.QF + (size_t)tok * 1536; const float* kvf = p.KVF + (size_t)tok * 2048; const float* kr = p.KR + (size_t)tok * 64;
#pragma unroll
        for (int h = 0; h < 8; ++h) {
            bf16_t* qd = p.Qh + (size_t)tok * 1536 + h * 192; bf16_t* kd = p.Kh + (size_t)tok * 1536 + h * 192; bf16_t* vd = p.Vh + (size_t)tok * 1024 + h * 128;
            qd[lane] = (bf16_t)f2bf(qf[h * 192 + lane]); qd[64 + lane] = (bf16_t)f2bf(qf[h * 192 + 64 + lane]);
            { const int ii = lane & 31; const float x1 = qf[h * 192 + 128 + ii], x2 = qf[h * 192 + 160 + ii]; float o1 = x1, o2 = x2;
              if (!isctx) { const float c = p.COSM[(size_t)t * 32 + ii], sn = p.SINM[(size_t)t * 32 + ii]; o1 = x1 * c - x2 * sn; o2 = x1 * sn + x2 * c; }
              qd[128 + lane] = (bf16_t)f2bf(lane < 32 ? o1 : o2); }
            kd[lane] = (bf16_t)f2bf(kvf[h * 256 + lane]); kd[64 + lane] = (bf16_t)f2bf(kvf[h * 256 + 64 + lane]); kd[128 + lane] = (bf16_t)f2bf(kr[lane]);
            vd[lane] = (bf16_t)f2bf(kvf[h * 256 + 128 + lane]); vd[64 + lane] = (bf16_t)f2bf(kvf[h * 256 + 192 + lane]);
        }
    }
}

struct MlaPost2P { const float* P; const float* qn; const float* kvn; const float* COSM; const float* SINM; bf16_t* CQ; bf16_t* CKV; unsigned char* Kh; };
__device__ __forceinline__ void ph_mla_post2(const MlaPost2P& p, int bid, int nblk) {
    const int tid_ = PH_TID, lane = tid_ & 63, gw = bid * 8 + (tid_ >> 6), NGW = nblk * 8;
    const bool lo32 = lane < 32; const int g = lane & 15, hq = lane >> 4, idx0 = 4 * (g & 7); const bool first = g < 8;
    const f32x4 qnA = *(const f32x4*)(p.qn + 4 * lane), qnB = lo32 ? *(const f32x4*)(p.qn + 256 + 4 * lane) : (f32x4){0.f, 0.f, 0.f, 0.f}, kvnA = *(const f32x4*)(p.kvn + 4 * lane);
    for (int tok = gw; tok < NTOK; tok += NGW) {
        const float* pr = p.P + (size_t)tok * MINP; const int s = tok % LT; const bool isctx = s < CTXL; const int t = s - CTXL;
        const f32x4 qa = *(const f32x4*)(pr + 4 * lane), qb = lo32 ? *(const f32x4*)(pr + 256 + 4 * lane) : (f32x4){0.f, 0.f, 0.f, 0.f}, ka = *(const f32x4*)(pr + 384 + 4 * lane);
        const f32x4 x1v = *(const f32x4*)(pr + 640 + idx0), x2v = *(const f32x4*)(pr + 672 + idx0);
        f32x4 cv = {1.f, 1.f, 1.f, 1.f}, sv = {0.f, 0.f, 0.f, 0.f};
        if (!isctx) { cv = *(const f32x4*)(p.COSM + (size_t)t * 32 + idx0); sv = *(const f32x4*)(p.SINM + (size_t)t * 32 + idx0); }
        const float ssq = ((qa.x * qa.x + qa.y * qa.y) + (qa.z * qa.z + qa.w * qa.w)) + ((qb.x * qb.x + qb.y * qb.y) + (qb.z * qb.z + qb.w * qb.w));
        const float ssk = (ka.x * ka.x + ka.y * ka.y) + (ka.z * ka.z + ka.w * ka.w);
        float tq, tk; wave_sum2(ssq, ssk, tq, tk);
        const float rq = rsqrtf(tq * (1.0f / 384.0f) + EPS), rk = rsqrtf(tk * (1.0f / 256.0f) + EPS);
        { const f32x4 o = qa * rq * qnA; u32x2 w; w.x = pk2(o.x, o.y); w.y = pk2(o.z, o.w); *(u32x2*)(p.CQ + (size_t)tok * 384 + 4 * lane) = w; }
        if (lo32) { const f32x4 o = qb * rq * qnB; u32x2 w; w.x = pk2(o.x, o.y); w.y = pk2(o.z, o.w); *(u32x2*)(p.CQ + (size_t)tok * 384 + 256 + 4 * lane) = w; }
        { const f32x4 o = ka * rk * kvnA; u32x2 w; w.x = pk2(o.x, o.y); w.y = pk2(o.z, o.w); *(u32x2*)(p.CKV + (size_t)tok * 256 + 4 * lane) = w; }
        { const f32x4 o = first ? x1v * cv - x2v * sv : x1v * sv + x2v * cv; const unsigned w = pk4_fp8(o.x, o.y, o.z, o.w);
          unsigned char* kb = p.Kh + (size_t)tok * 1536 + 128 + 4 * g;
          *(unsigned*)(kb + hq * 192) = w; *(unsigned*)(kb + (hq + 4) * 192) = w; }
    }
}

__device__ __forceinline__ void ph_moe_plan_gather(LAS unsigned char* lds, const int* cnt, int* plan_g, const bf16_t* H, const int* list, bf16_t* AP, int bid, int nblk) {
    LAS int* pl = (LAS int*)lds;
    const int tid_ = PH_TID, lane = tid_ & 63, gw = bid * 8 + (tid_ >> 6), NGW = nblk * 8;
    if (tid_ == 0) { int off = 0, nt = 0;
        for (int e = 0; e < NE; ++e) { const int c = cnt[e]; pl[e] = off; pl[32 + e] = c; const int tl = (c + 255) / 256; for (int q = 0; q < tl; ++q) pl[128 + nt + q] = e; nt += tl; off += tl * 256; }
        pl[64] = nt; }
    __syncthreads();
    if (bid == 0) for (int i = tid_; i < 128 + MAXTILES; i += 512) plan_g[i] = pl[i];
    const int nrows = pl[64] * 256;
    for (int r = gw; r < nrows; r += NGW) { const int e = pl[128 + (r >> 8)], pos = r - pl[e]; u32x4 a = {0, 0, 0, 0}, bq = {0, 0, 0, 0};
        if (pos < pl[32 + e]) { const int tok = list[(size_t)e * NTOK + pos]; a = *(const u32x4*)(H + (size_t)tok * D + lane * 8); bq = *(const u32x4*)(H + (size_t)tok * D + 512 + lane * 8); }
        *(u32x4*)(AP + (size_t)r * D + lane * 8) = a; *(u32x4*)(AP + (size_t)r * D + 512 + lane * 8) = bq; }
    __syncthreads();
}

constexpr int LDS_PLAN = 151552;
__device__ __forceinline__ void moe_plan_local(LAS unsigned char* lds, const int* cnt, int* plan_g, int bid) {
    LAS int* pl = (LAS int*)(lds + LDS_PLAN); LAS int* ts = pl + 704;
    const int tid = PH_TID;
    if (tid < 32) pl[32 + tid] = cnt[tid];
    __syncthreads();
    if (tid == 0) { int nt = 0; for (int e = 0; e < NE; ++e) { ts[e] = nt; nt += (pl[32 + e] + 255) / 256; } ts[32] = nt; pl[64] = nt; }
    __syncthreads();
    if (tid < 32) pl[tid] = ts[tid] * 256;
    for (int t = tid; t < ts[32]; t += 512) { int e = 0;
#pragma unroll
        for (int q = 1; q < 32; ++q) e += (ts[q] <= t) ? 1 : 0;
        pl[128 + t] = e; }
    __syncthreads();
    if (bid == 0) for (int i = tid; i < 128 + MAXTILES; i += 512) plan_g[i] = pl[i];
}
namespace att {
typedef short s16x4 __attribute__((ext_vector_type(4)));
typedef float f32x16 __attribute__((ext_vector_type(16)));
constexpr int QBLK = 32, KVBLK = 64, NW = 8, DQK = 192, DV = 128;
constexpr int LDQ = 8 * DQK, LDK = 8 * DQK, LDV = 8 * DV, LDO = 8 * DV;
constexpr float SCALE = 0.07216878364870322f, THR = 8.f;
constexpr int SHM_V = KVBLK * DV * 2, SHM_K = KVBLK * DQK, NRING = 4, LDS_K = 0, LDS_V = NRING * SHM_K, LDS_WS = LDS_V + NRING * SHM_V, LDS_ATT = LDS_WS + NW * 64 * 4;
#define KSWZ8(row, ch8) ((row) * 192 + ((((ch8)) ^ (((row) >> 2) & 7)) << 3))
#define SBAR() __builtin_amdgcn_sched_barrier(0)
__device__ __forceinline__ int crow(int r, int hi) { return (r & 3) + 8 * (r >> 2) + 4 * hi; }
__device__ __forceinline__ unsigned cvtpk(float lo, float hi) { unsigned r; asm volatile("v_cvt_pk_bf16_f32 %0, %1, %2" : "=v"(r) : "v"(lo), "v"(hi)); return r; }
__device__ __forceinline__ void partialSM(f32x16& p0, f32x16& p1, float& m_reg, float& mn, float& alpha) {
  constexpr float C = SCALE * 1.4426950408889634f;
  float pmax = p0[0];
#pragma unroll
  for (int r = 1; r < 16; ++r) pmax = fmaxf(pmax, p0[r]);
#pragma unroll
  for (int r = 0; r < 16; ++r) pmax = fmaxf(pmax, p1[r]);
  { unsigned y_ = __float_as_uint(pmax); asm volatile("" : "+v"(y_)); auto rr = __builtin_amdgcn_permlane32_swap(__float_as_uint(pmax), y_, false, false); pmax = fmaxf(__uint_as_float(rr[0]), __uint_as_float(rr[1])); }
  if (__builtin_expect(__all(pmax - m_reg <= THR / SCALE), 1)) { mn = m_reg; alpha = 1.f; }
  else { mn = fmaxf(m_reg, pmax); alpha = __builtin_amdgcn_exp2f((m_reg - mn) * C); m_reg = mn; }
  const float mnC = -mn * C;
#pragma unroll
  for (int r = 0; r < 16; ++r) p0[r] = fmaf(p0[r], C, mnC);
#pragma unroll
  for (int r = 0; r < 16; ++r) p1[r] = fmaf(p1[r], C, mnC);
#pragma unroll
  for (int r = 0; r < 16; ++r) p0[r] = __builtin_amdgcn_exp2f(p0[r]);
}
__device__ __forceinline__ void finishSM(f32x16& p0, f32x16& p1, float alpha, float& l_reg, bf16x8& pa0, bf16x8& pa1, bf16x8& pa2, bf16x8& pa3) {
#pragma unroll
  for (int r = 0; r < 16; ++r) p1[r] = __builtin_amdgcn_exp2f(p1[r]);
  float ps = 0;
#pragma unroll
  for (int r = 0; r < 16; ++r) ps += p0[r];
#pragma unroll
  for (int r = 0; r < 16; ++r) ps += p1[r];
  { unsigned y_ = __float_as_uint(ps); asm volatile("" : "+v"(y_)); auto rr = __builtin_amdgcn_permlane32_swap(__float_as_uint(ps), y_, false, false); ps = __uint_as_float(rr[0]) + __uint_as_float(rr[1]); }
  l_reg = l_reg * alpha + ps;
#define PK4(P, BASE, OUT) do { unsigned a0 = cvtpk(P[BASE + 0], P[BASE + 1]), a1 = cvtpk(P[BASE + 2], P[BASE + 3]);   \
    unsigned b0 = cvtpk(P[BASE + 4], P[BASE + 5]), b1 = cvtpk(P[BASE + 6], P[BASE + 7]);                              \
    auto r0 = __builtin_amdgcn_permlane32_swap(a0, b0, false, false); auto r1 = __builtin_amdgcn_permlane32_swap(a1, b1, false, false); \
    u32x4 w = {r0[0], r1[0], r0[1], r1[1]}; OUT = __builtin_bit_cast(bf16x8, w); } while (0)
  PK4(p0, 0, pa0); PK4(p0, 8, pa1); PK4(p1, 0, pa2); PK4(p1, 8, pa3);
#undef PK4
}
typedef int i32x2 __attribute__((ext_vector_type(2)));
template <int OFF> __device__ __forceinline__ i32x2 k_read(int addr) { i32x2 r; asm volatile("ds_read_b64 %0, %1 offset:%2" : "=v"(r) : "v"(addr), "i"(OFF)); return r; }
#define KQ_WAIT(n, A, B) asm volatile("s_waitcnt lgkmcnt(" #n ")" : "+v"(A[0]), "+v"(A[1]), "+v"(A[2]), "+v"(A[3]), "+v"(B[0]), "+v"(B[1]), "+v"(B[2]), "+v"(B[3]))
template <int KB> __device__ __forceinline__ void qkt(f32x16& p0, f32x16& p1, const int* kad, const pg8::i32x8* qr) {
  p0 = f32x16{}; p1 = f32x16{};
  i32x2 a[2][4], b[2][4];
#define KQ_RD(bf, i) do { _Pragma("unroll") for (int d = 0; d < 4; ++d) { a[bf][d] = k_read<KB * SHM_K>(kad[(i) * 4 + d]); b[bf][d] = k_read<KB * SHM_K + 32 * 192>(kad[(i) * 4 + d]); } } while (0)
#define KQ_MM(bf, i) do { const pg8::i32x8 a0 = {a[bf][0].x, a[bf][0].y, a[bf][1].x, a[bf][1].y, a[bf][2].x, a[bf][2].y, a[bf][3].x, a[bf][3].y}, a1 = {b[bf][0].x, b[bf][0].y, b[bf][1].x, b[bf][1].y, b[bf][2].x, b[bf][2].y, b[bf][3].x, b[bf][3].y}; \
    p0 = __builtin_amdgcn_mfma_scale_f32_32x32x64_f8f6f4(a0, qr[i], p0, 0, 0, 0, 0, 0, 0); p1 = __builtin_amdgcn_mfma_scale_f32_32x32x64_f8f6f4(a1, qr[i], p1, 0, 0, 0, 0, 0, 0); } while (0)
  KQ_RD(0, 0); KQ_RD(1, 1);
  KQ_WAIT(8, a[0], b[0]); KQ_MM(0, 0);
  KQ_RD(0, 2);
  KQ_WAIT(8, a[1], b[1]); KQ_MM(1, 1);
  KQ_WAIT(0, a[0], b[0]); KQ_MM(0, 2);
#undef KQ_RD
#undef KQ_MM
}
#undef KQ_WAIT
__device__ __forceinline__ int v_st(int k, int c) { const int kk = (k & ~0xC) | ((k & 4) << 1) | ((k & 8) >> 1); return ((kk >> 3) * 4 + (c >> 5)) * 512 + ((kk & 7) * 32 + (c & 31)) * 2; }
__device__ __forceinline__ int v_rd_base(int lane) { return ((lane & 3) << 3) | (((lane >> 2) & 3) << 6) | (((lane >> 4) & 1) << 5) | (((lane >> 5) & 1) << 8); }
constexpr int v_rd_off(int d0, int ks, int half) { return d0 * 512 + ks * 4096 + half * 2048; }
template <int OFF> __device__ __forceinline__ s16x4 tr_read(int vb) { s16x4 r; asm volatile("ds_read_b64_tr_b16 %0, %1 offset:%2" : "=&v"(r) : "v"(vb), "i"(OFF) : "memory"); return r; }
template <int D0, int VB> __device__ __forceinline__ void pv_one(f32x16& od, int vb, bf16x8 pa0, bf16x8 pa1, bf16x8 pa2, bf16x8 pa3) {
  constexpr int B = VB * SHM_V;
  const s16x4 l0 = tr_read<B + v_rd_off(D0, 0, 0)>(vb), h0 = tr_read<B + v_rd_off(D0, 0, 1)>(vb), l1 = tr_read<B + v_rd_off(D0, 1, 0)>(vb), h1 = tr_read<B + v_rd_off(D0, 1, 1)>(vb);
  const s16x4 l2 = tr_read<B + v_rd_off(D0, 2, 0)>(vb), h2 = tr_read<B + v_rd_off(D0, 2, 1)>(vb), l3 = tr_read<B + v_rd_off(D0, 3, 0)>(vb), h3 = tr_read<B + v_rd_off(D0, 3, 1)>(vb);
  asm volatile("s_waitcnt lgkmcnt(0)" ::: "memory"); SBAR();
#define PK(L, H) (bf16x8){L[0], L[1], L[2], L[3], H[0], H[1], H[2], H[3]}
  od = __builtin_amdgcn_mfma_f32_32x32x16_bf16(PK(l0, h0), pa0, od, 0, 0, 0);
  od = __builtin_amdgcn_mfma_f32_32x32x16_bf16(PK(l1, h1), pa1, od, 0, 0, 0);
  od = __builtin_amdgcn_mfma_f32_32x32x16_bf16(PK(l2, h2), pa2, od, 0, 0, 0);
  od = __builtin_amdgcn_mfma_f32_32x32x16_bf16(PK(l3, h3), pa3, od, 0, 0, 0);
#undef PK
}
template <int VB> __device__ __forceinline__ void pv_d0(f32x16* o, int vb, bf16x8 pa0, bf16x8 pa1, bf16x8 pa2, bf16x8 pa3) {
  pv_one<0, VB>(o[0], vb, pa0, pa1, pa2, pa3); pv_one<1, VB>(o[1], vb, pa0, pa1, pa2, pa3); pv_one<2, VB>(o[2], vb, pa0, pa1, pa2, pa3); pv_one<3, VB>(o[3], vb, pa0, pa1, pa2, pa3);
}
__device__ __forceinline__ void attn_unit(const unsigned char* __restrict__ Qb, const unsigned char* __restrict__ Kh, const bf16_t* __restrict__ Vh, bf16_t* __restrict__ Ob, int seq, LAS unsigned char* lds) {
  const int tid = ph_tid(), wid = tid >> 6, lane = tid & 63, r32 = lane & 31, hi = lane >> 5;
  LAS unsigned char* V_lds = lds + LDS_V; LAS unsigned char* K_lds = lds + LDS_K;
  LAS float* wsf = (LAS float*)(lds + LDS_WS) + wid * 64; LAS float* li_l = wsf; LAS float* al_l = wsf + 32;
  float m_reg = -1e30f, l_reg = 0; f32x16 o[4] = {}; pg8::i32x8 qr[3];
  const unsigned char* Qw = Qb + (long)(wid * QBLK + r32) * LDQ + hi * 8;
#pragma unroll
  for (int i = 0; i < 3; ++i) { typedef int i32x2 __attribute__((ext_vector_type(2))); i32x2 q[4];
#pragma unroll
    for (int d = 0; d < 4; ++d) q[d] = *(const GAS i32x2*)(Qw + (i * 4 + d) * 16);
    qr[i] = (pg8::i32x8){q[0].x, q[0].y, q[1].x, q[1].y, q[2].x, q[2].y, q[3].x, q[3].y}; }
  const int sr = tid >> 4, sc = (tid & 15) * 8, vst0 = v_st(sr, sc);
  const int kr0 = tid / 12, kc0 = tid % 12, kr1 = (tid + 512) / 12, kc1 = (tid + 512) % 12; const bool k2 = tid < 256;
  const int kg0 = kr0 * LDK + kc0 * 16, kg1 = kr1 * LDK + kc1 * 16;
  const int kw0a = KSWZ8(kr0, 2 * kc0), kw0b = KSWZ8(kr0, 2 * kc0 + 1), kw1a = KSWZ8(kr1, 2 * kc1), kw1b = KSWZ8(kr1, 2 * kc1 + 1);
  const int vb0 = (int)(unsigned long long)V_lds + v_rd_base(lane);
  int kad[12];
#pragma unroll
  for (int j = 0; j < 12; ++j) kad[j] = (int)(unsigned long long)K_lds + KSWZ8(r32, j * 2 + hi);
  LAS unsigned char* Vw = V_lds + vst0; LAS unsigned char* Kwa0 = K_lds + kw0a; LAS unsigned char* Kwb0 = K_lds + kw0b; LAS unsigned char* Kwa1 = K_lds + kw1a; LAS unsigned char* Kwb1 = K_lds + kw1b;
  asm volatile("" : "+v"(Vw), "+v"(Kwa0), "+v"(Kwb0), "+v"(Kwa1), "+v"(Kwb1));
  const int kg1c = k2 ? kg1 : kg0;
  bf16x8 vs0E, vs1E, vs0O, vs1O; u32x4 ks0E, ks1E, ks0O, ks1O;
#define SLOAD(S, k0) do { vs0##S = *(const GAS bf16x8*)(&Vh[(long)((k0) + sr) * LDV + sc]); vs1##S = *(const GAS bf16x8*)(&Vh[(long)((k0) + 32 + sr) * LDV + sc]); \
    ks0##S = *(const GAS u32x4*)(Kh + (long)(k0) * LDK + kg0); ks1##S = *(const GAS u32x4*)(Kh + (long)(k0) * LDK + kg1c); } while (0)
#define SWRITE(b, S) do { *(LAS bf16x8*)(Vw + (b) * SHM_V) = vs0##S; *(LAS bf16x8*)(Vw + (b) * SHM_V + 8192) = vs1##S; \
    *(LAS u32x2*)(Kwa0 + (b) * SHM_K) = (u32x2){ks0##S.x, ks0##S.y}; *(LAS u32x2*)(Kwb0 + (b) * SHM_K) = (u32x2){ks0##S.z, ks0##S.w}; \
    if (k2) { *(LAS u32x2*)(Kwa1 + (b) * SHM_K) = (u32x2){ks1##S.x, ks1##S.y}; *(LAS u32x2*)(Kwb1 + (b) * SHM_K) = (u32x2){ks1##S.z, ks1##S.w}; } } while (0)
#define SWAIT() asm volatile("s_waitcnt vmcnt(4)" ::: "memory")
#define RESC(a) do { if (__any((a) < 1.f)) { \
    _Pragma("unroll") for (int d = 0; d < 4; ++d) _Pragma("unroll") for (int r = 0; r < 16; ++r) o[d][r] *= (a); } } while (0)
  f32x16 pA0, pA1, pB0, pB1; float mnA, mnB, alA, alB; bf16x8 pa0, pa1, pa2, pa3; const int NT = seq / KVBLK;
  if (__builtin_amdgcn_readfirstlane(wid) >= 4) __builtin_amdgcn_s_setprio(1);
#define TSTEP(PX0, PX1, MNX, ALX, PY0, PY1, ALY, KB, VB, WB, SL, SW, jj, LD, WR) do { \
    SBAR(); qkt<KB>(PX0, PX1, kad, qr); \
    finishSM(PY0, PY1, ALY, l_reg, pa0, pa1, pa2, pa3); SBAR(); \
    if (LD) SLOAD(SL, ((jj) + 3) * KVBLK); SBAR(); \
    pv_d0<VB>(o, vb0, pa0, pa1, pa2, pa3); partialSM(PX0, PX1, m_reg, MNX, ALX); \
    if (WR) { if (LD) SWAIT(); SWRITE(WB, SW); } \
    RESC(ALX); } while (0)
#define TODD(KB, VB, WB, jj, LD, WR) TSTEP(pB0, pB1, mnB, alB, pA0, pA1, alA, KB, VB, WB, E, O, jj, LD, WR)
#define TEVEN(KB, VB, WB, jj, LD, WR) TSTEP(pA0, pA1, mnA, alA, pB0, pB1, alB, KB, VB, WB, O, E, jj, LD, WR)
  SLOAD(E, 0); asm volatile("s_waitcnt vmcnt(0)" ::: "memory"); SWRITE(0, E);
  SLOAD(O, KVBLK); SLOAD(E, 2 * KVBLK);
  SWAIT(); SWRITE(1, O); __syncthreads();
  qkt<0>(pA0, pA1, kad, qr); partialSM(pA0, pA1, m_reg, mnA, alA);
  SLOAD(O, 3 * KVBLK);
  SWAIT(); SWRITE(2, E); __syncthreads();
  int j = 1;
  for (; j + 4 < NT; j += 4) {
    TODD(1, 0, 3, j, true, true); __syncthreads();
    TEVEN(2, 1, 0, j + 1, true, true); __syncthreads();
    TODD(3, 2, 1, j + 2, true, true); __syncthreads();
    TEVEN(0, 3, 2, j + 3, true, true); __syncthreads();
  }
  TODD(1, 0, 3, j, false, true); __syncthreads();
  TEVEN(2, 1, 0, j + 1, false, false); __syncthreads();
  SBAR(); qkt<3>(pB0, pB1, kad, qr);
  finishSM(pA0, pA1, alA, l_reg, pa0, pa1, pa2, pa3); SBAR();
  pv_d0<2>(o, vb0, pa0, pa1, pa2, pa3); partialSM(pB0, pB1, m_reg, mnB, alB);
  RESC(alB);
  finishSM(pB0, pB1, alB, l_reg, pa0, pa1, pa2, pa3); SBAR();
  pv_d0<3>(o, vb0, pa0, pa1, pa2, pa3);
#undef TSTEP
#undef TODD
#undef TEVEN
  __builtin_amdgcn_s_setprio(0);
  { const int te = ph_tid(), wide = te >> 6, r32e = te & 31, hie = (te >> 5) & 1; const float rl = __builtin_amdgcn_rcpf(l_reg);
    bf16_t* Ow = Ob + (long)(wide * QBLK + r32e) * LDO + 8 * hie;
#pragma unroll
    for (int d0 = 0; d0 < 4; ++d0)
#pragma unroll
      for (int gp = 0; gp < 2; ++gp) { const int r0 = gp * 8;
        unsigned a0 = cvtpk(o[d0][r0 + 0] * rl, o[d0][r0 + 1] * rl), a1 = cvtpk(o[d0][r0 + 2] * rl, o[d0][r0 + 3] * rl);
        unsigned b0 = cvtpk(o[d0][r0 + 4] * rl, o[d0][r0 + 5] * rl), b1 = cvtpk(o[d0][r0 + 6] * rl, o[d0][r0 + 7] * rl);
        auto s0 = __builtin_amdgcn_permlane32_swap(a0, b0, false, false); auto s1 = __builtin_amdgcn_permlane32_swap(a1, b1, false, false);
        const u32x4 w = {s0[0], s1[0], s0[1], s1[1]};
        *(GAS u32x4*)(Ow + d0 * 32 + gp * 16) = w; } }
#undef SLOAD
#undef SWRITE
#undef SWAIT
#undef RESC
}
#undef KSWZ8
#undef SBAR
__device__ __forceinline__ void attn_phase(LAS unsigned char* lds, const unsigned char* Qh, const unsigned char* Kh, const bf16_t* Vh, bf16_t* O, int bid, int nblk) {
  const int vcu = (nblk % 8 == 0) ? (bid % 8) * (nblk / 8) + bid / 8 : bid;
  for (int u = vcu; u < 1056; u += nblk) {
    const bool isctx = u >= 1024; const int bh = isctx ? u - 1024 : (u >> 5), qb = isctx ? 0 : (u & 31), b = bh >> 3, h = bh & 7;
    const long tokq = (long)b * LT + (isctx ? 0 : CTXL + qb * 256), tokk = (long)b * LT;
    attn_unit(Qh + tokq * LDQ + h * DQK, Kh + tokk * LDK + h * DQK, Vh + tokk * LDV + h * DV, O + tokq * LDO + h * DV, isctx ? CTXL : LT, lds);
    __syncthreads();
  }
}
}
namespace ret {
constexpr int NCH = LT / 128;
__device__ __forceinline__ float lg2_decay(const float* logit, int dir, int h) { return -log1pf(expf(-logit[dir * 4 + h])) * 1.4426950408889634f; }
struct PostP { const float* P; const float* COSR; const float* SINR; const float* logit; bf16_t* Q; bf16_t* Kb; bf16_t* KT; bf16_t* VT; bf16_t* GF; bf16_t* GB; };
__device__ __forceinline__ void ph_post(const PostP& p, int bid, int nblk) {
    const int tid_ = PH_TID, lane = tid_ & 63, gw = bid * 8 + (tid_ >> 6), NGW = nblk * 8;
    for (int grp = gw; grp < NTOK / 8; grp += NGW) {
        const int tok0 = grp * 8, b = tok0 / LT, s0 = tok0 % LT; const bool isctx = s0 < CTXL; const int p0 = s0 & 127;
        for (int i = 0; i < 8; ++i) {
            const int tok = tok0 + i; const float* pr = p.P + (size_t)tok * RIN; const int t = s0 + i - CTXL;
#pragma unroll
            for (int h = 0; h < 4; ++h)
#pragma unroll
                for (int jj = 0; jj < 2; ++jj) { const int d = lane + 64 * jj; const float x1 = pr[h * 256 + d], x2 = pr[h * 256 + 128 + d]; float o1 = x1, o2 = x2;
                    if (!isctx) { const float c = p.COSR[(size_t)t * 128 + d], sn = p.SINR[(size_t)t * 128 + d]; o1 = x1 * c - x2 * sn; o2 = x1 * sn + x2 * c; }
                    p.Q[(size_t)tok * 1024 + h * 256 + d] = (bf16_t)f2bf(o1); p.Q[(size_t)tok * 1024 + h * 256 + 128 + d] = (bf16_t)f2bf(o2); }
#pragma unroll
            for (int jj = 0; jj < 8; ++jj) { const int c4 = (lane + 64 * jj) * 4; const f32x4 gf = *(const f32x4*)(pr + 4096 + c4), gb = *(const f32x4*)(pr + 6144 + c4);
                u32x2 w; w.x = pk2(silu_f(gf.x), silu_f(gf.y)); w.y = pk2(silu_f(gf.z), silu_f(gf.w)); *(u32x2*)(p.GF + (size_t)tok * 2048 + c4) = w;
                w.x = pk2(silu_f(gb.x), silu_f(gb.y)); w.y = pk2(silu_f(gb.z), silu_f(gb.w)); *(u32x2*)(p.GB + (size_t)tok * 2048 + c4) = w; }
        }
#pragma unroll 1
        for (int h = 0; h < 4; ++h) {
            const float lf = lg2_decay(p.logit, 0, h), lb = lg2_decay(p.logit, 1, h);
#pragma unroll
            for (int jj = 0; jj < 2; ++jj) { const int d = lane + 64 * jj; float o1[8], o2[8];
#pragma unroll
                for (int i = 0; i < 8; ++i) { const float* pr = p.P + (size_t)(tok0 + i) * RIN + 1024 + h * 256; const float x1 = pr[d] * 0.0625f, x2 = pr[128 + d] * 0.0625f; o1[i] = x1; o2[i] = x2;
                    if (!isctx) { const int t = s0 + i - CTXL; const float c = p.COSR[(size_t)t * 128 + d], sn = p.SINR[(size_t)t * 128 + d]; o1[i] = x1 * c - x2 * sn; o2[i] = x1 * sn + x2 * c; }
                    p.Kb[(size_t)(tok0 + i) * 1024 + h * 256 + d] = (bf16_t)f2bf(o1[i]); p.Kb[(size_t)(tok0 + i) * 1024 + h * 256 + 128 + d] = (bf16_t)f2bf(o2[i]); }
#pragma unroll
                for (int dir = 0; dir < 2; ++dir) { float f[8];
#pragma unroll
                    for (int i = 0; i < 8; ++i) f[i] = dir ? exp2f((float)(p0 + i) * lb) : exp2f((float)(127 - p0 - i) * lf);
                    bf16_t* kt = p.KT + (((size_t)dir * 16 + b * 4 + h) * 256) * LT + s0;
                    u32x4 o; o.x = pk2(o1[0] * f[0], o1[1] * f[1]); o.y = pk2(o1[2] * f[2], o1[3] * f[3]); o.z = pk2(o1[4] * f[4], o1[5] * f[5]); o.w = pk2(o1[6] * f[6], o1[7] * f[7]);
                    *(u32x4*)(kt + (size_t)d * LT) = o;
                    o.x = pk2(o2[0] * f[0], o2[1] * f[1]); o.y = pk2(o2[2] * f[2], o2[3] * f[3]); o.z = pk2(o2[4] * f[4], o2[5] * f[5]); o.w = pk2(o2[6] * f[6], o2[7] * f[7]);
                    *(u32x4*)(kt + (size_t)(128 + d) * LT) = o; }
            }
        }
        for (int jj = 0; jj < 32; ++jj) { const int col = lane + 64 * jj; float vv[8];
#pragma unroll
            for (int i = 0; i < 8; ++i) vv[i] = p.P[(size_t)(tok0 + i) * RIN + 2048 + col];
            u32x4 o; o.x = pk2(vv[0], vv[1]); o.y = pk2(vv[2], vv[3]); o.z = pk2(vv[4], vv[5]); o.w = pk2(vv[6], vv[7]);
            *(u32x4*)(p.VT + ((size_t)b * 2048 + col) * LT + s0) = o; }
    }
}

struct EpiRetIn {
    static constexpr bool PERM = true, AFTER_DRAIN = false;
    bf16_t* Q; bf16_t* Kb; bf16_t* Vr; bf16_t* GF; bf16_t* GB; const float* COSR; const float* SINR;
    __device__ __forceinline__ void operator()(const pg8::f32x4 (&acc)[2][2][4][2], const pg8::Unit& u, int wr, int wc, int fr, int fq) const {
        const int t2 = ph_tid(), wd2 = t2 >> 6, ln2 = t2 & 63;
        const int row0 = u.pm * 256 + (wd2 >> 2) * 64 + (ln2 & 15), c8 = (wd2 & 3) * 32 + 8 * (ln2 >> 4);
        if (u.pc < 8) {
            const float sc = u.pc < 4 ? 1.0f : 0.0625f; bf16_t* dst = (u.pc < 4 ? Q : Kb) + (u.pc & 3) * 256 + c8;
#pragma unroll
            for (int ai = 0; ai < 2; ++ai)
#pragma unroll
                for (int m = 0; m < 4; ++m) { const int tok = row0 + ai * 128 + m * 16, s = tok % LT; const bool lat = s >= CTXL;
                    const unsigned ro = lat ? (unsigned)(s - CTXL) * 512u + (unsigned)c8 * 4u : 0u;
                    bf16_t* qd = dst + (size_t)tok * 1024;
#pragma unroll
                    for (int n = 0; n < 2; ++n) { pg8::f32x4 c = *(const pg8::f32x4*)((const char*)COSR + ro + 16 * n), sn = *(const pg8::f32x4*)((const char*)SINR + ro + 16 * n);
                        if (!lat) { c = (pg8::f32x4){1.f, 1.f, 1.f, 1.f}; sn = (pg8::f32x4){0.f, 0.f, 0.f, 0.f}; }
                        const pg8::f32x4 x1 = acc[ai][0][m][n] * sc, x2 = acc[ai][1][m][n] * sc, o1 = x1 * c - x2 * sn, o2 = x1 * sn + x2 * c;
                        u32x2 w; w.x = pk2(o1[0], o1[1]); w.y = pk2(o1[2], o1[3]); *(u32x2*)(qd + 4 * n) = w;
                        w.x = pk2(o2[0], o2[1]); w.y = pk2(o2[2], o2[3]); *(u32x2*)(qd + 128 + 4 * n) = w; } }
        } else if (u.pc < 16) {
            bf16_t* dst = Vr + (u.pc - 8) * 256 + c8;
#pragma unroll
            for (int ai = 0; ai < 2; ++ai)
#pragma unroll
                for (int m = 0; m < 4; ++m)
#pragma unroll
                    for (int bj = 0; bj < 2; ++bj) *(u32x4*)(dst + (size_t)(row0 + ai * 128 + m * 16) * 2048 + bj * 128) = pk8(acc[ai][bj][m][0], acc[ai][bj][m][1]);
        } else {
            bf16_t* dst = (u.pc < 24 ? GF : GB) + (u.pc & 7) * 256 + c8;
#pragma unroll
            for (int ai = 0; ai < 2; ++ai)
#pragma unroll
                for (int m = 0; m < 4; ++m)
#pragma unroll
                    for (int bj = 0; bj < 2; ++bj) { pg8::f32x4 a = acc[ai][bj][m][0], b = acc[ai][bj][m][1];
#pragma unroll
                        for (int e = 0; e < 4; ++e) { a[e] = a[e] * __builtin_amdgcn_rcpf(1.0f + __expf(-a[e])); b[e] = b[e] * __builtin_amdgcn_rcpf(1.0f + __expf(-b[e])); }
                        *(u32x4*)(dst + (size_t)(row0 + ai * 128 + m * 16) * 2048 + bj * 128) = pk8(a, b); }
        }
    }
};
__device__ __forceinline__ void in_phase(LAS unsigned char* lds, const bf16_t* H, const bf16_t* Wri, bf16_t* Q, bf16_t* Kb, bf16_t* Vr, bf16_t* GF, bf16_t* GB, const float* COSR, const float* SINR) {
    pg8::Gemm g{H, Wri, 1024, 1024, 1024}; pg8::StaticOrder S; S.init(NTOK, 8192, (int)gridDim.x, (int)blockIdx.x); EpiRetIn E{Q, Kb, Vr, GF, GB, COSR, SINR};
    pg8::gemm_phase<EpiRetIn, pg8::StaticOrder, true, true>(lds, g, S, E);
}
__device__ __forceinline__ void ph_tr(LAS unsigned char* lds, const bf16_t* Kb, const bf16_t* Vr, bf16_t* KT, bf16_t* VT, const float* logit, int bid, int nblk) {
    constexpr int PITCH = 520;
    const int tid = PH_TID, r = tid >> 3, c8 = tid & 7;
#define TR_SRC(it_, q_) (((it_) % 12 < 4 ? Kb + ((size_t)((it_) / (12 * 132)) * LT + (((it_) / 12) % 132) * 64) * 1024 + ((it_) % 12) * 256 + (size_t)r * 1024 \
                                        : Vr + ((size_t)((it_) / (12 * 132)) * LT + (((it_) / 12) % 132) * 64) * 2048 + ((it_) % 12 - 4) * 256 + (size_t)r * 2048) + (c8 + 8 * (q_)) * 8)
    u32x4 nxt[4];
    if (bid < NB * 132 * 12) {
#pragma unroll
        for (int q = 0; q < 4; ++q) nxt[q] = *(const u32x4*)TR_SRC(bid, q); }
    for (int it = bid; it < NB * 132 * 12; it += nblk) {
        const int cb = it % 12, tg = (it / 12) % 132, b = it / (12 * 132); const int s0 = tg * 64;
        const bool isk = cb < 4;
#pragma unroll
        for (int q = 0; q < 4; ++q) *(LAS u32x4*)(lds + r * PITCH + (c8 + 8 * q) * 16) = nxt[q];
        __syncthreads();
        if (it + nblk < NB * 132 * 12) {
#pragma unroll
            for (int q = 0; q < 4; ++q) nxt[q] = *(const u32x4*)TR_SRC(it + nblk, q); }
        const int g = tid & 7, sg = s0 + 8 * g;
        float ff[8], fb[8];
        if (isk) { const float lf = lg2_decay(logit, 0, cb), lb = lg2_decay(logit, 1, cb); const int p0 = sg & 127;
#pragma unroll
            for (int i = 0; i < 8; ++i) { ff[i] = exp2f((float)(127 - p0 - i) * lf); fb[i] = exp2f((float)(p0 + i) * lb); } }
#pragma unroll
        for (int q = 0; q < 4; ++q) { const int c = (tid >> 3) + 64 * q; float v[8];
#pragma unroll
            for (int i = 0; i < 8; ++i) v[i] = bf2f(*(const LAS unsigned short*)(lds + (8 * g + i) * PITCH + c * 2));
            if (isk) {
                u32x4 o; o.x = pk2(v[0] * ff[0], v[1] * ff[1]); o.y = pk2(v[2] * ff[2], v[3] * ff[3]); o.z = pk2(v[4] * ff[4], v[5] * ff[5]); o.w = pk2(v[6] * ff[6], v[7] * ff[7]);
                *(u32x4*)(KT + (((size_t)(b * 4 + cb)) * 256 + c) * LT + sg) = o;
                o.x = pk2(v[0] * fb[0], v[1] * fb[1]); o.y = pk2(v[2] * fb[2], v[3] * fb[3]); o.z = pk2(v[4] * fb[4], v[5] * fb[5]); o.w = pk2(v[6] * fb[6], v[7] * fb[7]);
                *(u32x4*)(KT + (((size_t)(16 + b * 4 + cb)) * 256 + c) * LT + sg) = o;
            } else {
                u32x4 o; o.x = pk2(v[0], v[1]); o.y = pk2(v[2], v[3]); o.z = pk2(v[4], v[5]); o.w = pk2(v[6], v[7]);
                *(u32x4*)(VT + ((size_t)b * 2048 + (cb - 4) * 256 + c) * LT + sg) = o;
            }
        }
        __syncthreads();
    }
}
#undef TR_SRC
struct StateOrder {      static constexpr bool GATHER = false;
    int G, c0;
    __device__ bool next(int i, pg8::Unit& u) const {
        const int L = i * G + c0; if (L >= 2 * NCH * 32) return false;
        const int mt = L & 1, q = L >> 1, c = q % NCH, bhd = q / NCH, bh = bhd >> 1, dir = bhd & 1;
        u.pm = bh * 2 + mt; u.pn = dir * 16 + bh; u.pc = L; u.ka = (unsigned)(c * 256); u.kb = (unsigned)(c * 256); return true;
    }
    __device__ __forceinline__ void a_ready(const pg8::Unit&) const {}
    __device__ __forceinline__ void done(const pg8::Unit&) const {}
};
struct EpiUT {
    static constexpr bool PERM = true, AFTER_DRAIN = false;
    unsigned char* UT;
    __device__ __forceinline__ void operator()(const pg8::f32x4 (&acc)[2][2][4][2], const pg8::Unit& u, int wr, int wc, int fr, int fq) const {
        const int L = u.pc, mt = L & 1, q = L >> 1;
        unsigned char* base = UT + ((size_t)q * 512 + mt * 256) * 256;
        const int odd = fq & 1;
        unsigned lo = (unsigned)((wr * 64 + fr) * 256 + wc * 32 + 8 * (fq & ~1)); asm volatile("" : "+v"(lo));
#pragma unroll
        for (int ai = 0; ai < 2; ++ai)
#pragma unroll
            for (int mp = 0; mp < 2; ++mp)
#pragma unroll
                for (int bj = 0; bj < 2; ++bj) { const int m0 = 2 * mp, m1 = 2 * mp + 1;
                    const pg8::f32x4 a0 = acc[ai][bj][m0][0], a1 = acc[ai][bj][m0][1], b0 = acc[ai][bj][m1][0], b1 = acc[ai][bj][m1][1];
                    unsigned x0 = pk4_fp8(a0[0], a0[1], a0[2], a0[3]), x1 = pk4_fp8(a1[0], a1[1], a1[2], a1[3]), y0 = pk4_fp8(b0[0], b0[1], b0[2], b0[3]), y1 = pk4_fp8(b1[0], b1[1], b1[2], b1[3]);
                    asm volatile("s_nop 1\n\tv_permlane16_swap_b32 %0, %1\n\tv_permlane16_swap_b32 %2, %3" : "+v"(x0), "+v"(y0), "+v"(x1), "+v"(y1));
                    const u32x4 w = {x0, x1, y0, y1};
                    *(u32x4*)(base + (lo + (unsigned)((ai * 128 + (odd ? m1 : m0) * 16) * 256 + bj * 128))) = w; }
    }
};
__device__ __forceinline__ void state_phase(LAS unsigned char* lds, const bf16_t* VT, const bf16_t* KT, unsigned char* UT) {
    pg8::Gemm g{VT, KT, 128, LT, LT};
    StateOrder S{(int)gridDim.x, (int)blockIdx.x};
    EpiUT E{UT};
    pg8::gemm_phase<EpiUT, StateOrder, true, true>(lds, g, S, E);
}
__device__ __forceinline__ int scan_chunk(int dir, int k) { return dir == 0 ? k : (k < 2 ? 1 - k : NCH + 1 - k); }
__device__ __forceinline__ void ph_scan(const unsigned char* U8, bf16_t* ST, const float* logit, int bid, int nblk) {
    const long gt = bid * 512L + PH_TID, NG = nblk * 512L;
    for (long it = gt; it < 32L * 8192; it += NG) {
        const int bhd = (int)(it >> 13), e16 = (int)(it & 8191), dir = bhd & 1, h = (bhd >> 1) & 3;
        const float cd = exp2f(128.0f * lg2_decay(logit, dir, h));
        const unsigned char* ub = U8 + (size_t)bhd * NCH * 131072 + (size_t)e16 * 16; bf16_t* sb = ST + (size_t)bhd * NCH * 131072 + (size_t)e16 * 16;
        float run[16];
#pragma unroll
        for (int q = 0; q < 16; ++q) run[q] = 0.f;
        constexpr int PF = 6; u32x4 w[PF];
#pragma unroll
        for (int q = 0; q < PF; ++q) w[q] = *(const u32x4*)(ub + (size_t)scan_chunk(dir, q) * 131072);
#pragma unroll 1
        for (int k0 = 0; k0 < NCH; k0 += PF) {
#pragma unroll
            for (int q = 0; q < PF; ++q) { const int k = k0 + q; const int c = scan_chunk(dir, k); u32x4* ptr = (u32x4*)(sb + (size_t)c * 131072); const u32x4 ww = w[q];
                if (k + PF < NCH) w[q] = *(const u32x4*)(ub + (size_t)scan_chunk(dir, k + PF) * 131072);
                u32x4 o; o.x = pk2(run[0], run[1]); o.y = pk2(run[2], run[3]); o.z = pk2(run[4], run[5]); o.w = pk2(run[6], run[7]); ptr[0] = o;
                o.x = pk2(run[8], run[9]); o.y = pk2(run[10], run[11]); o.z = pk2(run[12], run[13]); o.w = pk2(run[14], run[15]); ptr[1] = o;
#pragma unroll
                for (int d = 0; d < 4; ++d) { const unsigned wd = d == 0 ? ww.x : (d == 1 ? ww.y : (d == 2 ? ww.z : ww.w)); const auto lo2 = __builtin_amdgcn_cvt_pk_f32_fp8(wd, false), hi2 = __builtin_amdgcn_cvt_pk_f32_fp8(wd, true);
                    run[4 * d + 0] = run[4 * d + 0] * cd + lo2[0]; run[4 * d + 1] = run[4 * d + 1] * cd + lo2[1]; run[4 * d + 2] = run[4 * d + 2] * cd + hi2[0]; run[4 * d + 3] = run[4 * d + 3] * cd + hi2[1]; } }
        }
    }
}
typedef float f32x16 __attribute__((ext_vector_type(16)));
constexpr int QROW = 528, PROW = 272, LDS_Q = 0, LDS_K = 128 * QROW, LDS_P = LDS_K, LDS_RET = 2 * 128 * QROW;
__device__ __forceinline__ int crow(int r, int hi) { return (r & 3) + 8 * (r >> 2) + 4 * hi; }
__device__ __forceinline__ void out_unit(LAS unsigned char* lds, const bf16_t* Qc, const bf16_t* Kc, const bf16_t* VTc, const bf16_t* STc, bf16_t* Oc, int dir, float lg) {
    const int tid = ph_tid(), wid = tid >> 6, lane = tid & 63, r32 = lane & 31, hi = lane >> 5;
    const GAS bf16_t* sa = (const GAS bf16_t*)(STc + (size_t)(wid * 64 + r32) * 256 + hi * 8);
    const GAS bf16_t* va = (const GAS bf16_t*)(VTc + (size_t)(wid * 64 + r32) * LT + hi * 8);
    bf16x8 A0[4], A1[4], N0[4], N1[4];
#define RO_LOAD(D0, D1, blk) do { _Pragma("unroll") for (int q = 0; q < 4; ++q) { if ((blk) < 4) { D0[q] = *(const GAS bf16x8*)(sa + ((blk) * 4 + q) * 16); D1[q] = *(const GAS bf16x8*)(sa + 32 * 256 + ((blk) * 4 + q) * 16); } \
        else { D0[q] = *(const GAS bf16x8*)(va + (((blk) - 4) * 4 + q) * 16); D1[q] = *(const GAS bf16x8*)(va + (size_t)32 * LT + (((blk) - 4) * 4 + q) * 16); } } } while (0)
    RO_LOAD(A0, A1, 0);
#pragma unroll
    for (int i = 0; i < 8; ++i) { const int id = tid + 512 * i, row = id >> 5, c16 = id & 31;
        *(LAS u32x4*)(lds + LDS_Q + row * QROW + c16 * 16) = *(const GAS u32x4*)(Qc + (size_t)row * 1024 + c16 * 8);
        *(LAS u32x4*)(lds + LDS_K + row * QROW + c16 * 16) = *(const GAS u32x4*)(Kc + (size_t)row * 1024 + c16 * 8); }
    __syncthreads();
    const int mtS = wid >> 1, nt0 = (wid & 1) * 2;
    f32x16 s0 = {}, s1 = {};
#pragma unroll
    for (int ks = 0; ks < 16; ++ks) { const int cb = (ks * 16 + hi * 8) * 2;
        const bf16x8 a = *(const LAS bf16x8*)(lds + LDS_K + (mtS * 32 + r32) * QROW + cb);
        const bf16x8 b0 = *(const LAS bf16x8*)(lds + LDS_Q + (nt0 * 32 + r32) * QROW + cb), b1 = *(const LAS bf16x8*)(lds + LDS_Q + (nt0 * 32 + 32 + r32) * QROW + cb);
        s0 = __builtin_amdgcn_mfma_f32_32x32x16_bf16(a, b0, s0, 0, 0, 0); s1 = __builtin_amdgcn_mfma_f32_32x32x16_bf16(a, b1, s1, 0, 0, 0); }
    __syncthreads();
#pragma unroll
    for (int t2 = 0; t2 < 2; ++t2) { const int i = (nt0 + t2) * 32 + r32;
#pragma unroll
        for (int rg = 0; rg < 4; ++rg) { float pv[4];
#pragma unroll
            for (int q = 0; q < 4; ++q) { const int r = rg * 4 + q, j = mtS * 32 + crow(r, hi); const float sv = t2 ? s1[r] : s0[r]; const int dist = dir ? j - i : i - j;
                pv[q] = dist >= 0 ? sv * exp2f((float)dist * lg) : 0.f; }
            u32x2 w; w.x = pk2(pv[0], pv[1]); w.y = pk2(pv[2], pv[3]);
            *(LAS u32x2*)(lds + LDS_P + i * PROW + (mtS * 32 + crow(rg * 4, hi)) * 2) = w; } }
    __syncthreads();
    f32x16 acc[2][4];
#pragma unroll
    for (int mt = 0; mt < 2; ++mt)
#pragma unroll
        for (int nt = 0; nt < 4; ++nt) acc[mt][nt] = f32x16{};
#pragma unroll
    for (int blk = 0; blk < 6; ++blk) {
        if (blk + 1 < 6) RO_LOAD(N0, N1, blk + 1);
        if (blk == 4) {
#pragma unroll
            for (int nt = 0; nt < 4; ++nt) { const int i = nt * 32 + r32; const float qd = exp2f((float)(dir ? 128 - i : i + 1) * lg);
#pragma unroll
                for (int mt = 0; mt < 2; ++mt)
#pragma unroll
                    for (int rr = 0; rr < 16; ++rr) acc[mt][nt][rr] *= qd; } }
#pragma unroll
        for (int q = 0; q < 4; ++q) {
#pragma unroll
            for (int nt = 0; nt < 4; ++nt) { const bf16x8 bq = blk < 4 ? *(const LAS bf16x8*)(lds + LDS_Q + (nt * 32 + r32) * QROW + ((blk * 4 + q) * 16 + hi * 8) * 2)
                                                                   : *(const LAS bf16x8*)(lds + LDS_P + (nt * 32 + r32) * PROW + (((blk - 4) * 4 + q) * 16 + hi * 8) * 2);
                acc[0][nt] = __builtin_amdgcn_mfma_f32_32x32x16_bf16(A0[q], bq, acc[0][nt], 0, 0, 0); acc[1][nt] = __builtin_amdgcn_mfma_f32_32x32x16_bf16(A1[q], bq, acc[1][nt], 0, 0, 0); } }
#pragma unroll
        for (int q = 0; q < 4; ++q) { A0[q] = N0[q]; A1[q] = N1[q]; }
    }
#undef RO_LOAD
#pragma unroll
    for (int nt = 0; nt < 4; ++nt) { bf16_t* orow = Oc + (size_t)(nt * 32 + r32) * 2048 + wid * 64;
#pragma unroll
        for (int mt = 0; mt < 2; ++mt)
#pragma unroll
            for (int rg = 0; rg < 4; ++rg) { u32x2 w; w.x = pk2(acc[mt][nt][rg * 4], acc[mt][nt][rg * 4 + 1]); w.y = pk2(acc[mt][nt][rg * 4 + 2], acc[mt][nt][rg * 4 + 3]);
                *(GAS u32x2*)(orow + mt * 32 + crow(rg * 4, hi)) = w; } }
    __syncthreads();
}
__device__ __forceinline__ void out_phase(LAS unsigned char* lds, const bf16_t* Q, const bf16_t* Kb, const bf16_t* VT, const bf16_t* ST, bf16_t* OFb, bf16_t* OBb, const float* logit, int bid, int nblk) {
    for (int u = bid; u < 32 * NCH; u += nblk) {
        const int c = u % NCH, bhd = u / NCH, dir = bhd & 1, bh = bhd >> 1, b = bh >> 2, h = bh & 3;
        const size_t tok0 = (size_t)b * LT + c * 128;
        out_unit(lds, Q + tok0 * 1024 + h * 256, Kb + tok0 * 1024 + h * 256, VT + ((size_t)b * 2048 + h * 512) * LT + c * 128, ST + ((size_t)bhd * NCH + c) * 131072,
                 (dir ? OBb : OFb) + tok0 * 2048 + h * 512, dir, lg2_decay(logit, dir, h));
    }
}
struct GateP { const bf16_t* OF; const bf16_t* OB; const bf16_t* GF; const bf16_t* GB; const float* gn; bf16_t* Y; };
__device__ __forceinline__ void ph_gate(const GateP& p, int bid, int nblk) {
    const int tid_ = PH_TID, lane = tid_ & 63, gw = bid * 8 + (tid_ >> 6), NGW = nblk * 8;
    for (int tok = gw; tok < NTOK; tok += NGW) {
#pragma unroll
        for (int h = 0; h < 4; ++h) {
            const int c0 = h * 512 + lane * 8; float yo[8];
#pragma unroll
            for (int dir = 0; dir < 2; ++dir) {
                const u32x4 ow = *(const u32x4*)((dir ? p.OB : p.OF) + (size_t)tok * 2048 + c0);
                float v[8] = {bflo(ow.x), bfhi(ow.x), bflo(ow.y), bfhi(ow.y), bflo(ow.z), bfhi(ow.z), bflo(ow.w), bfhi(ow.w)}; float sm = 0.f;
#pragma unroll
                for (int q = 0; q < 8; ++q) sm += v[q];
                const float mu = wave_sum(sm) * (1.0f / 512.0f); float sq = 0.f;
#pragma unroll
                for (int q = 0; q < 8; ++q) { v[q] -= mu; sq += v[q] * v[q]; }
                const float rstd = rsqrtf(wave_sum(sq) * (1.0f / 512.0f) + GN_EPS);
                const u32x4 gw4 = *(const u32x4*)((dir ? p.GB : p.GF) + (size_t)tok * 2048 + c0);
                const float g[8] = {bflo(gw4.x), bfhi(gw4.x), bflo(gw4.y), bfhi(gw4.y), bflo(gw4.z), bfhi(gw4.z), bflo(gw4.w), bfhi(gw4.w)};
                const float* gnp = p.gn + dir * 2048 + c0;
#pragma unroll
                for (int q = 0; q < 8; ++q) { const float t = g[q] * (v[q] * rstd * gnp[q]); yo[q] = dir ? yo[q] + t : t; }
            }
            u32x4 o; o.x = pk2(yo[0], yo[1]); o.y = pk2(yo[2], yo[3]); o.z = pk2(yo[4], yo[5]); o.w = pk2(yo[6], yo[7]);
            *(u32x4*)(p.Y + (size_t)tok * 2048 + c0) = o;
        }
    }
}
}
__device__ __forceinline__ int opq(int v) { asm volatile("" : "+s"(v)); return v; }
template <int OFF> __device__ __forceinline__ const void* lds_ptr() { unsigned a; asm volatile("v_mov_b32 %0, %1" : "=v"(a) : "i"(OFF)); volatile LAS unsigned* p = (volatile LAS unsigned*)(unsigned long long)a; unsigned lo = p[0], hi = p[1]; lo = __builtin_amdgcn_readfirstlane(lo); hi = __builtin_amdgcn_readfirstlane(hi); return (const void*)(((unsigned long long)hi << 32) | lo); }
__device__ __forceinline__ unsigned char* ws_ptr(unsigned char* ws, size_t off) { unsigned char* b = ws; asm volatile("" : "+s"(b)); return b + off; }
#define GRID_BAR() xcd_barrier(bar)
#define INP(i) ((const float*)lds_ptr<LDS_MISC + 256 + 8 * (i)>())
#define WSP(T, off) ((T*)ws_ptr(ws, (off)))
#define I_x INP(0)
#define I_c INP(1)
#define I_ctx INP(2)
#define I_c_ctx INP(3)
#define I_ret_w_in INP(4)
#define I_ret_decay INP(5)
#define I_ret_gn INP(6)
#define I_ret_w_out INP(7)
#define I_mla_w_in INP(8)
#define I_mla_qn INP(9)
#define I_mla_kvn INP(10)
#define I_mla_w_uq INP(11)
#define I_mla_w_ukv INP(12)
#define I_mla_w_out INP(13)
#define I_ada_w INP(14)
#define I_ada_b INP(15)
#define I_norm_mix INP(16)
#define I_norm_ffn INP(17)
#define I_router_w INP(18)
#define I_router_b INP(19)
#define I_exp_w_up INP(20)
#define I_exp_b_up INP(21)
#define I_exp_w_down INP(22)
#define I_exp_b_down INP(23)
#define I_final_norm INP(24)
#define W_MOD WSP(float, WS_MOD)
#define W_COSR WSP(float, WS_COSR)
#define W_SINR WSP(float, WS_SINR)
#define W_COSM WSP(float, WS_COSM)
#define W_SINM WSP(float, WS_SINM)
#define W_TOKINFO WSP(int, WS_TOKINFO)
#define W_LIST WSP(int, WS_LIST)
#define W_PLAN WSP(int, WS_PLAN)
#define W_WRI WSP(bf16_t, WS_WRI)
#define W_WRO WSP(bf16_t, WS_WRO)
#define W_WMI WSP(bf16_t, WS_WMI)
#define W_WUQ WSP(bf16_t, WS_WUQ)
#define W_WUKV WSP(bf16_t, WS_WUKV)
#define W_WMO WSP(bf16_t, WS_WMO)
#define W_WUP WSP(bf16_t, WS_WUP)
#define W_WDN WSP(bf16_t, WS_WDN)
#define W_X WSP(float, WS_X)
#define W_H WSP(bf16_t, WS_H)
#define W_RA WSP(unsigned char, WS_RA)
#define W_RB WSP(unsigned char, WS_RB)
#define W_RC WSP(unsigned char, WS_RC)
#define W_Z WSP(float, WS_RC)
#define W_YD WSP(bf16_t, WS_RC + (size_t)NTOK * D * 4)
#define W_CNT (WSP(int, WS_CTL) + CW_CNT)
template <int LAYER> __device__ __forceinline__ void layer_body(LAS unsigned char* lds, unsigned char* ws, const XcdBarrier& bar, int bid, int nblk) {
        constexpr int layer = LAYER; constexpr int j = layer >> 1; constexpr bool last = layer == DEPTH - 1;
        const float* modl = W_MOD + (size_t)layer * 5 * 6144;
        { RowP p{}; p.x_in = I_x; p.ctx_in = I_ctx; p.X = W_X; p.H = W_H; p.normw = I_norm_mix + layer * D; p.shiftv = modl + 0 * 1024; p.scalev = modl + 1 * 1024;
          if constexpr (layer == 0) ph_rowphase<RP_FIRST>(lds, p, opq(bid), opq(nblk));
          else { p.YD = W_YD; p.tokinfo = W_TOKINFO; p.planprev = W_PLAN + (layer - 1) * 1024; p.gvec = W_MOD + (size_t)(layer - 1) * 5 * 6144 + 5 * 1024; p.skip_ctx = 0;
                 ph_rowphase<RP_ADD_MOE>(lds, p, opq(bid), opq(nblk)); } }
        GRID_BAR();
        if constexpr ((layer & 1) == 0) {
            bf16_t* Q = (bf16_t*)W_RB; bf16_t* Kb = Q + (size_t)NTOK * 1024; bf16_t* VT = Kb + (size_t)NTOK * 1024; bf16_t* GF = VT + (size_t)NTOK * 2048; bf16_t* GB = GF + (size_t)NTOK * 2048;
            bf16_t* KT = GB + (size_t)NTOK * 2048; bf16_t* OFb = KT + (size_t)NTOK * 2048; bf16_t* OBb = OFb + (size_t)NTOK * 2048; bf16_t* Y = Q; bf16_t* UT = (bf16_t*)W_RA;
            bf16_t* Vr = OFb;
            ret::in_phase(lds, W_H, W_WRI + (size_t)j * 8192 * 1024, Q, Kb, Vr, GF, GB, W_COSR, W_SINR);
            ct_slot<(layer == 0 ? 0 : 5)>(I_exp_w_up, I_exp_w_down, (unsigned char*)W_WUP, (unsigned char*)W_WDN, bid);
            GRID_BAR();
            ret::ph_tr(lds, Kb, Vr, KT, VT, I_ret_decay + j * 8, opq(bid), opq(nblk));
            GRID_BAR();
            unsigned char* U8 = (unsigned char*)(UT + (size_t)32 * ret::NCH * 131072);
            ret::state_phase(lds, VT, KT, U8);
            GRID_BAR();
            ret::ph_scan(U8, UT, I_ret_decay + j * 8, opq(bid), opq(nblk));
            GRID_BAR();
            ret::out_phase(lds, Q, Kb, VT, UT, OFb, OBb, I_ret_decay + j * 8, opq(bid), opq(nblk));
            ct_slot<(layer == 0 ? 1 : 6)>(I_exp_w_up, I_exp_w_down, (unsigned char*)W_WUP, (unsigned char*)W_WDN, bid);
            GRID_BAR();
            { ret::GateP p{OFb, OBb, GF, GB, I_ret_gn + (size_t)j * 2 * 2048, Y}; ret::ph_gate(p, opq(bid), opq(nblk)); }
            GRID_BAR();
            resid_gemm_phase(lds, Y, W_WRO + (size_t)j * 1024 * 2048, 2048, W_X, modl + 2 * 1024);
            ct_slot<(layer == 0 ? 2 : 7)>(I_exp_w_up, I_exp_w_down, (unsigned char*)W_WUP, (unsigned char*)W_WDN, bid);
            GRID_BAR();
        } else {
            float* Pm = (float*)W_RA; float* QF = Pm + (size_t)NTOK * MINP; float* KVF = QF + (size_t)NTOK * 1536; float* S = KVF + (size_t)NTOK * 2048; bf16_t* Pa = (bf16_t*)(S + (size_t)SEQ * LT);
            bf16_t* CQ = (bf16_t*)W_RB; bf16_t* CKV = CQ + (size_t)NTOK * 384; float* KR = (float*)(CKV + (size_t)NTOK * 256); bf16_t* Qp = (bf16_t*)(KR + (size_t)NTOK * 64);
            bf16_t* Kp = Qp + (size_t)NTOK * 2048; bf16_t* VT = Kp + (size_t)NTOK * 2048; float* OFm = (float*)(VT + (size_t)NTOK * 2048); bf16_t* O = (bf16_t*)(OFm + (size_t)NTOK * 2048);
            gemm_f32_phase(lds, W_H, W_WMI + (size_t)j * MINP * 1024, Pm, NTOK, MINP, 1024, 1024, 1024, MINP);
            GRID_BAR();
            { MlaPost2P p{Pm, I_mla_qn + j * 384, I_mla_kvn + j * 256, W_COSM, W_SINM, CQ, CKV, (unsigned char*)Kp}; ph_mla_post2(p, opq(bid), opq(nblk)); }
            GRID_BAR();
            mla_q_phase(lds, CQ, W_WUQ + (size_t)j * 1536 * 384, (unsigned char*)Qp, W_COSM, W_SINM);
            mla_kv_phase(lds, CKV, W_WUKV + (size_t)j * 2048 * 256, (unsigned char*)Kp, VT);
            ct_slot<(layer == 1 ? 3 : 8)>(I_exp_w_up, I_exp_w_down, (unsigned char*)W_WUP, (unsigned char*)W_WDN, bid);
            GRID_BAR();
            att::attn_phase(lds, (const unsigned char*)Qp, (const unsigned char*)Kp, VT, O, opq(bid), opq(nblk));
            GRID_BAR();
            resid_gemm_phase(lds, O, W_WMO + (size_t)j * 1024 * 1024, 1024, W_X, modl + 2 * 1024);
            ct_slot<(layer == 1 ? 4 : 9)>(I_exp_w_up, I_exp_w_down, (unsigned char*)W_WUP, (unsigned char*)W_WDN, bid);
            GRID_BAR();
        }
        { RowP p{}; p.X = W_X; p.H = W_H; p.normw = I_norm_ffn + layer * D; p.shiftv = modl + 3 * 1024; p.scalev = modl + 4 * 1024;
          p.router_w = I_router_w + (size_t)layer * 1024 * 32; p.router_b = I_router_b + layer * 32; p.cnt = W_CNT + layer * 32; p.tokinfo_out = W_TOKINFO; p.list = W_LIST; p.skip_ctx = last ? 1 : 0;
          ph_rowrouter(lds, p, opq(bid), opq(nblk)); }
        if constexpr (layer > 0) ct_drain<layer>(I_exp_w_up, I_exp_w_down, (unsigned char*)W_WUP, (unsigned char*)W_WDN, opq(bid), opq(nblk));
        GRID_BAR();
        int* plan = W_PLAN + layer * 1024;
        unsigned char* ACT = (unsigned char*)W_RB;
        moe_up_phase(lds, (const unsigned char*)W_H, (const unsigned char*)W_WUP + (size_t)layer * NE * 2048 * 1024, ACT, I_exp_b_up + (size_t)layer * NE * 2048, W_CNT + layer * 32, plan, W_LIST);
        GRID_BAR();
        moe_down_phase(lds, ACT, (const unsigned char*)W_WDN + (size_t)layer * NE * 1024 * 1024, W_YD, I_exp_b_down + (size_t)layer * NE * 1024, plan);
        GRID_BAR();
}
struct Params { const float* in[25]; float* out; unsigned char* ws; };
__global__ void __launch_bounds__(512, 2) mega_fwd(Params P) {
    extern __shared__ __attribute__((aligned(16))) unsigned char lds_raw[];
    LAS unsigned char* lds = (LAS unsigned char*)lds_raw;
    const int bid = (int)blockIdx.x, nblk = (int)gridDim.x;
    volatile LAS unsigned* MISC = (volatile LAS unsigned*)(lds + LDS_MISC);
    { const int t0 = (int)threadIdx.x; if (t0 < 64) MISC[t0] = 0u; if ((t0 & 63) == 0) *(volatile LAS unsigned*)(lds + LDS_WVTAB + hw_wave_slot() * 4u) = (unsigned)(t0 >> 6); }
    __syncthreads();
    const int tid = PH_TID;
    unsigned char* ws = P.ws;
    unsigned* CTL = (unsigned*)(ws + WS_CTL);
    XcdBarrier bar = xcd_barrier_post(CTL + CW_BAR, MISC + 8);
    volatile LAS unsigned* INL = MISC + 64;
    if (tid == 0) {
#define ST_IN(i) { const unsigned long long v = (unsigned long long)P.in[i]; INL[2 * (i)] = (unsigned)v; INL[2 * (i) + 1] = (unsigned)(v >> 32); }
        ST_IN(0) ST_IN(1) ST_IN(2) ST_IN(3) ST_IN(4) ST_IN(5) ST_IN(6) ST_IN(7) ST_IN(8) ST_IN(9) ST_IN(10) ST_IN(11) ST_IN(12)
        ST_IN(13) ST_IN(14) ST_IN(15) ST_IN(16) ST_IN(17) ST_IN(18) ST_IN(19) ST_IN(20) ST_IN(21) ST_IN(22) ST_IN(23) ST_IN(24)
#undef ST_IN
        { const unsigned long long v = (unsigned long long)P.out; INL[50] = (unsigned)v; INL[51] = (unsigned)(v >> 32); }
    }
    __syncthreads();
    ph_transpose_direct<0>(I_ret_w_in, W_WRI, 1024, 8192, 1024, 2, (long)1024 * 8192, (long)8192 * 1024, opq(bid), opq(nblk));
    ph_transpose(lds, I_ret_w_out, W_WRO, 2048, 1024, 2048, 2, (long)2048 * 1024, (long)1024 * 2048, opq(bid), opq(nblk));
    ph_transpose<2>(lds, I_mla_w_uq, W_WUQ, 384, 1536, 384, 2, (long)384 * 1536, (long)1536 * 384, opq(bid), opq(nblk));
    ph_transpose(lds, I_mla_w_ukv, W_WUKV, 256, 2048, 256, 2, (long)256 * 2048, (long)2048 * 256, opq(bid), opq(nblk));
    ph_transpose(lds, I_mla_w_out, W_WMO, 1024, 1024, 1024, 2, (long)1024 * 1024, (long)1024 * 1024, opq(bid), opq(nblk));
    ph_transpose_direct8<1>(I_exp_w_up, (unsigned char*)W_WUP, 1024, 2048, 1024, NE, (long)1024 * 2048, (long)2048 * 1024, opq(bid), opq(nblk));
    ph_transpose_direct8<0>(I_exp_w_down, (unsigned char*)W_WDN, 1024, 1024, 1024, NE, (long)1024 * 1024, (long)1024 * 1024, opq(bid), opq(nblk));
    ph_adaln(lds, I_c, I_c_ctx, I_ada_w, I_ada_b, W_MOD, opq(bid), opq(nblk));
    ph_rot_tables(W_COSR, W_SINR, W_COSM, W_SINM, opq(bid), opq(nblk));
    __syncthreads();
    ph_transpose<3>(lds, I_mla_w_in, W_WMI, 1024, MIN_, 1024, 2, (long)1024 * MIN_, (long)MINP * 1024, opq(bid), opq(nblk));
    GRID_BAR();
    layer_body<0>(lds, ws, bar, bid, nblk);
    layer_body<1>(lds, ws, bar, bid, nblk);
    layer_body<2>(lds, ws, bar, bid, nblk);
    layer_body<3>(lds, ws, bar, bid, nblk);
    { RowP p{}; p.X = W_X; p.out = (float*)lds_ptr<LDS_MISC + 256 + 8 * 25>(); p.YD = W_YD; p.tokinfo = W_TOKINFO; p.planprev = W_PLAN + (DEPTH - 1) * 1024; p.gvec = W_MOD + (size_t)(DEPTH - 1) * 5 * 6144 + 5 * 1024; p.normw = I_final_norm; p.skip_ctx = 1;
      ph_rowphase<RP_ADD_MOE | RP_FINAL>(lds, p, opq(bid), opq(nblk)); }
#undef GRID_BAR
}
#undef I_x
#undef I_c
#undef I_ctx
#undef I_c_ctx
#undef I_ret_w_in
#undef I_ret_decay
#undef I_ret_gn
#undef I_ret_w_out
#undef I_mla_w_in
#undef I_mla_qn
#undef I_mla_kvn
#undef I_mla_w_uq
#undef I_mla_w_ukv
#undef I_mla_w_out
#undef I_ada_w
#undef I_ada_b
#undef I_norm_mix
#undef I_norm_ffn
#undef I_router_w
#undef I_router_b
#undef I_exp_w_up
#undef I_exp_b_up
#undef I_exp_w_down
#undef I_exp_b_down
#undef I_final_norm
#undef W_MOD
#undef W_COSR
#undef W_SINR
#undef W_COSM
#undef W_SINM
#undef W_TOKINFO
#undef W_LIST
#undef W_PLAN
#undef W_WRI
#undef W_WRO
#undef W_WMI
#undef W_WUQ
#undef W_WUKV
#undef W_WMO
#undef W_WUP
#undef W_WDN
#undef W_X
#undef W_H
#undef W_RA
#undef W_RB
#undef W_RC
#undef W_Z
#undef W_YD
#undef W_CNT
#undef INP
#undef WSP

extern "C" void kernel_launch(void* const* d_in, const int* in_sizes, int n_in, void* d_out, int out_size, void* d_ws, size_t ws_size, hipStream_t stream) {
    static int ok = 0;
    if (ok == 0) {
        if (n_in != 25 || ws_size < WS_END) { fprintf(stderr, "kernel_launch: bad shapes n_in %d ws %zu need %zu\n", n_in, ws_size, (size_t)WS_END); ok = -1; return; }
        if (hipFuncSetAttribute((const void*)mega_fwd, hipFuncAttributeMaxDynamicSharedMemorySize, LDS_BYTES) != hipSuccess) { fprintf(stderr, "kernel_launch: hipFuncSetAttribute failed\n"); ok = -1; return; }
        ok = 1;
    }
    if (ok < 0) return;
    (void)hipMemsetAsync((char*)d_ws + WS_CTL, 0, CTL_BYTES, stream);
    Params p{};
    for (int i = 0; i < 25; ++i) p.in[i] = (const float*)d_in[i];
    p.out = (float*)d_out; p.ws = (unsigned char*)d_ws;
    hipLaunchKernelGGL(mega_fwd, dim3(256), dim3(512), LDS_BYTES, stream, p);
}
```

```cpp
#include <hip/hip_runtime.h>
#include <cstdio>
#include <cstdint>
#include <cmath>
constexpr int LDS_GTAB = 131072, LDS_MISC_BASE = 155648, LDS_WVTAB = LDS_MISC_BASE + 512;
__device__ __forceinline__ unsigned hw_wave_slot() { return (unsigned)__builtin_amdgcn_s_getreg((5 << 11) | 4) & 0x3fu; }
__device__ __forceinline__ int ph_tid() {
    const unsigned a = (unsigned)LDS_WVTAB + hw_wave_slot() * 4u;
    const unsigned wv = (unsigned)__builtin_amdgcn_readfirstlane((int)*(volatile __attribute__((address_space(3))) unsigned*)(unsigned long long)a);
    unsigned m = ~0u; asm volatile("" : "+s"(m));
    const unsigned lane = __builtin_amdgcn_mbcnt_hi(m, __builtin_amdgcn_mbcnt_lo(m, 0u));
    return (int)(wv * 64u + lane);
}
namespace pg8 {
#define PG8_LAS __attribute__((address_space(3)))
typedef unsigned short bf16_t;
typedef short bf16x8 __attribute__((ext_vector_type(8)));
typedef float f32x4 __attribute__((ext_vector_type(4)));
typedef unsigned u32x4 __attribute__((ext_vector_type(4)));
typedef unsigned u32x2 __attribute__((ext_vector_type(2)));
typedef long i64x2 __attribute__((ext_vector_type(2)));
typedef int i32x4 __attribute__((ext_vector_type(4)));
typedef int i32x8 __attribute__((ext_vector_type(8)));
constexpr int BM = 256, BK = 64, HALF = 128, HTB = HALF * BK * 2, STAGE_BYTES = 8 * HTB, NXCD = 8, WGM = 8;
__host__ __device__ __forceinline__ int lds_byte(int r, int c) { const int st = (r >> 4) * 2 + (c >> 5), rr = r & 15, cc = c & 31, ob = rr * 64 + cc * 2; return st * 1024 + (ob ^ (((ob >> 9) & 1) << 5)); }
__host__ __device__ __forceinline__ void stage_rc(int b, int& R, int& C) { const int st = b / 1024, sb = b % 1024, swz = sb ^ (((sb >> 9) & 1) << 5); R = (st >> 1) * 16 + swz / 64; C = (st & 1) * 32 + (swz % 64) / 2; }
__host__ __device__ __forceinline__ int perm32(int rho) { const int n = rho >> 4, i = rho & 15; return 8 * (i >> 2) + 4 * n + (i & 3); }
struct Unit { int pm, pn, pc; unsigned ka, kb; };
struct Gemm { const bf16_t* A; const bf16_t* Bt; int K, lda, ldb; };
struct StaticOrder {
    static constexpr bool GATHER = false;
    int nM, nN, nwg, G, c;
    __host__ __device__ void init(int M, int N, int G_, int c_) { nM = M / BM; nN = N / BM; nwg = nM * nN; G = G_; c = c_; }
    __host__ __device__ bool next(int i, Unit& u) const {
        const long L = (long)i * G + c; if (L >= nwg) return false;
        int wgid = (int)L; { const int q = nwg / NXCD, r = nwg % NXCD, xcd = wgid % NXCD, off = wgid / NXCD; wgid = (xcd < r ? xcd * (q + 1) : r * (q + 1) + (xcd - r) * q) + off; }
        const int nig = WGM * nN, gid = wgid / nig, fm = gid * WGM, gsz = (nM - fm) < WGM ? (nM - fm) : WGM;
        u.pm = fm + ((wgid % nig) % gsz); u.pn = (wgid % nig) / gsz; u.pc = u.pn; u.ka = 0u; u.kb = 0u; return true;
    }
    __device__ __forceinline__ void a_ready(const Unit&) const {}
    __device__ __forceinline__ void done(const Unit&) const {}
};
__device__ __forceinline__ unsigned cvt_pk_bf16(float lo, float hi) { unsigned r; asm volatile("v_cvt_pk_bf16_f32 %0, %1, %2" : "=v"(r) : "v"(lo), "v"(hi)); return r; }

struct EpiF32 {
    static constexpr bool PERM = false, AFTER_DRAIN = false;
    float* C; int ldc; const float* bias; int npg; int bstride;
    __device__ __forceinline__ void operator()(const f32x4 (&acc)[2][2][4][2], const Unit& u, int wr, int wc, int fr, int fq) const {
        int row0 = u.pm * BM + wr * 64 + fr, col0 = u.pc * BM + wc * 32 + 4 * fq; asm volatile("" : "+v"(row0), "+v"(col0));
        const float* bp = bias ? bias + (size_t)(u.pn / npg) * bstride : nullptr;
        f32x4 bv[2][2];
#pragma unroll
        for (int bj = 0; bj < 2; ++bj)
#pragma unroll
            for (int n = 0; n < 2; ++n) bv[bj][n] = bp ? *(const f32x4*)(bp + col0 + bj * HALF + n * 16) : (f32x4){0.f, 0.f, 0.f, 0.f};
#pragma unroll
        for (int ai = 0; ai < 2; ++ai)
#pragma unroll
            for (int m = 0; m < 4; ++m) { float* rowp = C + (size_t)(row0 + ai * HALF + m * 16) * ldc + col0;
#pragma unroll
                for (int bj = 0; bj < 2; ++bj)
#pragma unroll
                    for (int n = 0; n < 2; ++n) *(f32x4*)(rowp + bj * HALF + n * 16) = acc[ai][bj][m][n] + bv[bj][n]; }
    }
};

template <class Epi, class Sched, bool ALIGN_EPI = false, bool SP2 = false, bool FP8 = false>
__device__ __forceinline__ void gemm_phase(PG8_LAS unsigned char* lds, const Gemm g, const Sched& S, const Epi& E) {
    const int tid = ph_tid(), wid = __builtin_amdgcn_readfirstlane(tid >> 6), lane = tid & 63, wr = wid >> 2, wc = wid & 3, fr = lane & 15, fq = lane >> 4;
    const int K = g.K, nt = K / BK;
    unsigned voffA[2], voffB[2];
    unsigned gaddr[2];
#pragma unroll
    for (int i = 0; i < 2; ++i) { int R, C; stage_rc(tid * 16 + i * 8192, R, C); const int Rb = Epi::PERM ? ((R & ~31) + perm32(R & 31)) : R;
        voffA[i] = Sched::GATHER ? (unsigned)C * 2u : (unsigned)(R * g.lda + C) * 2u; voffB[i] = (unsigned)(Rb * g.ldb + C) * 2u; gaddr[i] = (unsigned)LDS_GTAB + (unsigned)R * 4u; }
#define PG8_GLD(dst, ui_, h_) do { _Pragma("unroll") for (int _i = 0; _i < 2; ++_i) (dst)[_i] = *(const PG8_LAS unsigned*)(unsigned long long)(gaddr[_i] + (unsigned)(ui_) * 1024u + (unsigned)(h_) * 512u) + voffA[_i]; } while (0)
#define PG8_STAGEA(bufoff, kbase, h_, nx_) do { if constexpr (Sched::GATHER) { unsigned _vn[2]; PG8_GLD(_vn, (nx_) ? ui + 1 : ui, h_); PG8_STAGE(bufoff, kbase, _vn); } \
        else PG8_STAGE(bufoff, (kbase) + (h_) * hstepA, voffA); } while (0)
    const size_t kstep = (size_t)(BK * 2);
    const size_t hstepA = (size_t)HALF * g.lda * 2, hstepB = (size_t)HALF * g.ldb * 2;
    const size_t tstepA = Sched::GATHER ? 0 : 2 * hstepA, tstepB = 2 * hstepB;
    const unsigned ldsw = (unsigned)wid * 1024u;
    const int aoff = lds_byte(wr * 64 + fr, fq * 8), boff = lds_byte(wc * 32 + fr, fq * 8);
#define PG8_SA(b, h) (((b) * 2 + (h)) * HTB)
#define PG8_SB(b, h) ((4 + (b) * 2 + (h)) * HTB)
#define PG8_STAGE(bufoff, gbase, voff) do { _Pragma("unroll") for (int _i = 0; _i < 2; ++_i) \
        __builtin_amdgcn_global_load_lds((const unsigned*)((const char*)(gbase) + (voff)[_i]), (PG8_LAS unsigned*)(lds + (bufoff) + ldsw + _i * 8192), 16, 0, 0); } while (0)
#define PG8_RD16(off) (*(const PG8_LAS i32x4*)(lds + (off)))
#define PG8_LDA(dst, b, h) do { _Pragma("unroll") for (int m = 0; m < 4; ++m) { if constexpr (FP8) dst##8[m] = __builtin_shufflevector(PG8_RD16(PG8_SA(b, h) + aoff + m * 2048), PG8_RD16(PG8_SA(b, h) + aoff + m * 2048 + 1024), 0, 1, 2, 3, 4, 5, 6, 7); \
        else { _Pragma("unroll") for (int k = 0; k < 2; ++k) dst[m][k] = *(const PG8_LAS bf16x8*)(lds + PG8_SA(b, h) + aoff + m * 2048 + k * 1024); } } } while (0)
#define PG8_LDB(dst, b, h) do { _Pragma("unroll") for (int n = 0; n < 2; ++n) { if constexpr (FP8) dst##8[n] = __builtin_shufflevector(PG8_RD16(PG8_SB(b, h) + boff + n * 2048), PG8_RD16(PG8_SB(b, h) + boff + n * 2048 + 1024), 0, 1, 2, 3, 4, 5, 6, 7); \
        else { _Pragma("unroll") for (int k = 0; k < 2; ++k) dst[n][k] = *(const PG8_LAS bf16x8*)(lds + PG8_SB(b, h) + boff + n * 2048 + k * 1024); } } } while (0)
#define PG8_MMA(ai, bj, At, Bt) do { __builtin_amdgcn_s_setprio(1); _Pragma("unroll") for (int m = 0; m < 4; ++m) _Pragma("unroll") for (int n = 0; n < 2; ++n) { \
        if constexpr (FP8) asm volatile("v_mfma_f32_16x16x128_f8f6f4 %0, %1, %2, %0" : "+v"(acc[ai][bj][m][n]) : "v"(Bt##8[n]), "v"(At##8[m])); \
        else { _Pragma("unroll") for (int k = 0; k < 2; ++k) acc[ai][bj][m][n] = __builtin_amdgcn_mfma_f32_16x16x32_bf16(Bt[n][k], At[m][k], acc[ai][bj][m][n], 0, 0, 0); } } __builtin_amdgcn_s_setprio(0); } while (0)
#define PG8_WAIT_V(n) asm volatile("s_waitcnt vmcnt(" #n ")" ::: "memory")
#define PG8_WAIT_L(n) asm volatile("s_waitcnt lgkmcnt(" #n ")" ::: "memory")
#define PG8_BAR __builtin_amdgcn_s_barrier()
#define PG8_SCHED __builtin_amdgcn_sched_barrier(0)
    Unit cur, nxt; int ui = 0;
    if (!S.next(0, cur)) return;
    f32x4 acc[2][2][4][2];
#pragma unroll
    for (int a = 0; a < 2; ++a)
#pragma unroll
        for (int b = 0; b < 2; ++b)
#pragma unroll
            for (int m = 0; m < 4; ++m)
#pragma unroll
                for (int n = 0; n < 2; ++n) acc[a][b][m][n] = (f32x4){0.f, 0.f, 0.f, 0.f};
    bf16x8 At[4][2], B0[2][2], B1[2][2]; i32x8 At8[4], B08[2], B18[2];
    const char* cA = (const char*)g.A + (size_t)cur.pm * tstepA + cur.ka; const char* cB = (const char*)g.Bt + (size_t)cur.pn * tstepB + cur.kb;
    S.a_ready(cur);
    if constexpr (Sched::GATHER) { static_assert(!Sched::GATHER || SP2, "gather: SP2 loop only"); }
    if constexpr (SP2) {
        PG8_STAGE(PG8_SB(0, 0), cB, voffB); PG8_STAGE(PG8_SB(0, 1), cB + hstepB, voffB); PG8_STAGEA(PG8_SA(0, 0), cA, 0, false); PG8_STAGEA(PG8_SA(0, 1), cA, 1, false);
        if (wr == 1) PG8_BAR;
        PG8_WAIT_V(2); PG8_BAR;
        PG8_STAGE(PG8_SB(1, 0), cB + kstep, voffB); PG8_STAGEA(PG8_SA(1, 0), cA + kstep, 0, false); PG8_STAGE(PG8_SB(1, 1), cB + hstepB + kstep, voffB);
        PG8_WAIT_V(6); PG8_BAR;
    } else {
        PG8_STAGE(PG8_SB(0, 0), cB, voffB); PG8_STAGE(PG8_SA(0, 0), cA, voffA); PG8_STAGE(PG8_SB(0, 1), cB + hstepB, voffB); PG8_STAGE(PG8_SA(0, 1), cA + hstepA, voffA);
        if (wr == 1) PG8_BAR;
        PG8_WAIT_V(4); PG8_BAR;
        PG8_STAGE(PG8_SB(1, 0), cB + kstep, voffB); PG8_STAGE(PG8_SA(1, 0), cA + kstep, voffA); PG8_STAGE(PG8_SB(1, 1), cB + hstepB + kstep, voffB);
        PG8_WAIT_V(6); PG8_BAR;
    }
    for (;;) {
        const bool has_next = S.next(ui + 1, nxt);
        const char* nA = has_next ? (const char*)g.A + (size_t)nxt.pm * tstepA + nxt.ka : cA; const char* nB = has_next ? (const char*)g.Bt + (size_t)nxt.pn * tstepB + nxt.kb : cB;
#pragma unroll 1
        for (int t = 0; t < nt; t += 2) {
            const bool last = (t == nt - 2);
            const char* a1 = cA + (size_t)(t + 1) * kstep;
            const char* a2 = last ? nA : cA + (size_t)(t + 2) * kstep; const char* b2 = last ? nB : cB + (size_t)(t + 2) * kstep;
            const char* a3 = a2 + kstep; const char* b3 = b2 + kstep;
            if (last && has_next) S.a_ready(nxt);
            const bool nx = last && has_next;
            if constexpr (SP2) {
            PG8_LDB(B0, 0, 0); PG8_LDB(B1, 0, 1); PG8_SCHED; PG8_LDA(At, 0, 0); PG8_STAGEA(PG8_SA(1, 1), a1, 1, false);
            PG8_WAIT_V(8); PG8_WAIT_L(0); PG8_BAR; PG8_MMA(0, 0, At, B0); PG8_MMA(0, 1, At, B1); PG8_BAR; PG8_SCHED;
            PG8_LDA(At, 0, 1); PG8_STAGE(PG8_SB(0, 0), b2, voffB); PG8_STAGE(PG8_SB(0, 1), b2 + hstepB, voffB); PG8_STAGEA(PG8_SA(0, 0), a2, 0, nx);
            PG8_WAIT_V(8); PG8_WAIT_L(0); PG8_BAR; PG8_MMA(1, 0, At, B0); PG8_MMA(1, 1, At, B1); PG8_BAR; PG8_SCHED;
            PG8_LDB(B0, 1, 0); PG8_LDB(B1, 1, 1); PG8_SCHED; PG8_LDA(At, 1, 0); PG8_STAGEA(PG8_SA(0, 1), a2, 1, nx);
            PG8_WAIT_V(8); PG8_WAIT_L(0); PG8_BAR; PG8_MMA(0, 0, At, B0); PG8_MMA(0, 1, At, B1); PG8_BAR; PG8_SCHED;
            PG8_LDA(At, 1, 1); PG8_STAGE(PG8_SB(1, 0), b3, voffB); PG8_STAGE(PG8_SB(1, 1), b3 + hstepB, voffB); PG8_STAGEA(PG8_SA(1, 0), a3, 0, nx);
            PG8_WAIT_V(8); PG8_WAIT_L(0); PG8_BAR; PG8_MMA(1, 0, At, B0); PG8_MMA(1, 1, At, B1); PG8_BAR; PG8_SCHED;
            } else {
            PG8_LDB(B0, 0, 0); PG8_SCHED; PG8_LDA(At, 0, 0); PG8_STAGE(PG8_SA(1, 1), a1 + hstepA, voffA);
            PG8_WAIT_L(8); PG8_BAR; PG8_WAIT_L(0); PG8_MMA(0, 0, At, B0); PG8_BAR; PG8_SCHED;
            PG8_LDB(B1, 0, 1); PG8_STAGE(PG8_SB(0, 0), b2, voffB);
            PG8_BAR; PG8_WAIT_L(0); PG8_MMA(0, 1, At, B1); PG8_BAR;
            PG8_LDA(At, 0, 1); PG8_STAGE(PG8_SA(0, 0), a2, voffA);
            PG8_BAR; PG8_WAIT_L(0); PG8_MMA(1, 0, At, B0); PG8_BAR; PG8_SCHED;
            PG8_STAGE(PG8_SB(0, 1), b2 + hstepB, voffB);
            PG8_WAIT_V(6); PG8_BAR; PG8_MMA(1, 1, At, B1); PG8_BAR;
            PG8_LDB(B0, 1, 0); PG8_SCHED; PG8_LDA(At, 1, 0); PG8_STAGE(PG8_SA(0, 1), a2 + hstepA, voffA);
            PG8_WAIT_L(8); PG8_BAR; PG8_WAIT_L(0); PG8_MMA(0, 0, At, B0); PG8_BAR; PG8_SCHED;
            PG8_LDB(B1, 1, 1); PG8_STAGE(PG8_SB(1, 0), b3, voffB);
            PG8_BAR; PG8_WAIT_L(0); PG8_MMA(0, 1, At, B1); PG8_BAR;
            PG8_LDA(At, 1, 1); PG8_STAGE(PG8_SA(1, 0), a3, voffA);
            PG8_BAR; PG8_WAIT_L(0); PG8_MMA(1, 0, At, B0); PG8_BAR; PG8_SCHED;
            PG8_STAGE(PG8_SB(1, 1), b3 + hstepB, voffB);
            PG8_WAIT_V(6); PG8_BAR; PG8_MMA(1, 1, At, B1); PG8_BAR;
            }
        }
        if constexpr (FP8) { asm volatile("s_nop 15\n\ts_nop 15" ::: "memory"); PG8_SCHED; }
        if constexpr (ALIGN_EPI) { if (wr == 0) PG8_BAR; }
        if constexpr (!Epi::AFTER_DRAIN) { E(acc, cur, wr, wc, fr, fq); S.done(cur); }
        if (!has_next) break;
#pragma unroll
        for (int a = 0; a < 2; ++a)
#pragma unroll
            for (int b = 0; b < 2; ++b)
#pragma unroll
                for (int m = 0; m < 4; ++m)
#pragma unroll
                    for (int n = 0; n < 2; ++n) acc[a][b][m][n] = (f32x4){0.f, 0.f, 0.f, 0.f};
        cur = nxt; cA = nA; cB = nB; ++ui;
        if constexpr (ALIGN_EPI) { if (wr == 1) PG8_BAR; }
    }
    PG8_WAIT_V(0);
    if constexpr (!ALIGN_EPI) { if (wr == 0) PG8_BAR; }
    PG8_BAR;
#undef PG8_SA
#undef PG8_SB
#undef PG8_STAGE
#undef PG8_STAGEA
#undef PG8_GLD
#undef PG8_LDA
#undef PG8_RD16
#undef PG8_LDB
#undef PG8_MMA
#undef PG8_WAIT_V
#undef PG8_WAIT_L
#undef PG8_BAR
#undef PG8_SCHED
}
}
#define LAS __attribute__((address_space(3)))
#define GAS __attribute__((address_space(1)))
typedef unsigned short bf16_t;
typedef short bf16x8 __attribute__((ext_vector_type(8)));
typedef float f32x4 __attribute__((ext_vector_type(4)));
typedef unsigned u32x4 __attribute__((ext_vector_type(4)));
typedef unsigned u32x2 __attribute__((ext_vector_type(2)));
constexpr int D = 1024, NB = 4, SEQ = 8192, CTXL = 256, LT = SEQ + CTXL, NTOK = NB * LT, DEPTH = 4;
constexpr int RH = 4, RDK = 256, RDV = 512, RIN = 8192;
constexpr int MH = 8, MQL = 384, MKVL = 256, MIN_ = 704, MINP = 768;
constexpr int NE = 32, TOPK = 4;
constexpr int MAXTILES = 560, MAXSLOTS = MAXTILES * 256;
constexpr float EPS = 1e-6f, GN_EPS = 1e-5f;

__device__ __forceinline__ unsigned f2bf(float f) { unsigned u = __builtin_bit_cast(unsigned, f); return (u + 0x7fffu + ((u >> 16) & 1u)) >> 16; }
typedef float pk2_f32x2 __attribute__((ext_vector_type(2)));
typedef __bf16 pk2_bf16x2 __attribute__((ext_vector_type(2)));
__device__ __forceinline__ unsigned pk2(float lo, float hi) { const pk2_f32x2 v = {lo, hi}; return __builtin_bit_cast(unsigned, __builtin_convertvector(v, pk2_bf16x2)); }
__device__ __forceinline__ unsigned pk4_fp8(float a, float b, float c_, float d) { int w = 0; w = __builtin_amdgcn_cvt_pk_fp8_f32(a, b, w, false); w = __builtin_amdgcn_cvt_pk_fp8_f32(c_, d, w, true); return (unsigned)w; }
__device__ __forceinline__ float bf2f(unsigned short b) { return __builtin_bit_cast(float, (unsigned)b << 16); }
__device__ __forceinline__ float bflo(unsigned w) { return __builtin_bit_cast(float, w << 16); }
__device__ __forceinline__ float bfhi(unsigned w) { return __builtin_bit_cast(float, w & 0xffff0000u); }
#define SWZ_XOR(v, k) __builtin_bit_cast(float, __builtin_amdgcn_ds_swizzle(__builtin_bit_cast(int, (v)), ((k) << 10) | 0x1f))
__device__ __forceinline__ float wave_sum(float v) {
    v += SWZ_XOR(v, 1); v += SWZ_XOR(v, 2); v += SWZ_XOR(v, 4); v += SWZ_XOR(v, 8); v += SWZ_XOR(v, 16);
    return __builtin_bit_cast(float, __builtin_amdgcn_readlane(__builtin_bit_cast(int, v), 0)) + __builtin_bit_cast(float, __builtin_amdgcn_readlane(__builtin_bit_cast(int, v), 32));
}
__device__ __forceinline__ void wave_sum2(float a, float b, float& sa, float& sb) {
    unsigned ua = __builtin_bit_cast(unsigned, a), ub = __builtin_bit_cast(unsigned, b);
    asm volatile("s_nop 1\n\tv_permlane32_swap_b32 %0, %1" : "+v"(ua), "+v"(ub));
    float v = __builtin_bit_cast(float, ua) + __builtin_bit_cast(float, ub);
    v += SWZ_XOR(v, 1); v += SWZ_XOR(v, 2); v += SWZ_XOR(v, 4); v += SWZ_XOR(v, 8); v += SWZ_XOR(v, 16);
    sa = __builtin_bit_cast(float, __builtin_amdgcn_readlane(__builtin_bit_cast(int, v), 0)); sb = __builtin_bit_cast(float, __builtin_amdgcn_readlane(__builtin_bit_cast(int, v), 32));
}
__device__ __forceinline__ float wave_sum2v(float a, float b) {
    unsigned ua = __builtin_bit_cast(unsigned, a), ub = __builtin_bit_cast(unsigned, b);
    asm volatile("s_nop 1\n\tv_permlane32_swap_b32 %0, %1" : "+v"(ua), "+v"(ub));
    float v = __builtin_bit_cast(float, ua) + __builtin_bit_cast(float, ub);
    v += SWZ_XOR(v, 1); v += SWZ_XOR(v, 2); v += SWZ_XOR(v, 4); v += SWZ_XOR(v, 8); v += SWZ_XOR(v, 16);
    return v;
}
__device__ __forceinline__ float wave_max(float v) {
    v = fmaxf(v, SWZ_XOR(v, 1)); v = fmaxf(v, SWZ_XOR(v, 2)); v = fmaxf(v, SWZ_XOR(v, 4)); v = fmaxf(v, SWZ_XOR(v, 8)); v = fmaxf(v, SWZ_XOR(v, 16));
    return fmaxf(__builtin_bit_cast(float, __builtin_amdgcn_readlane(__builtin_bit_cast(int, v), 0)), __builtin_bit_cast(float, __builtin_amdgcn_readlane(__builtin_bit_cast(int, v), 32)));
}
__device__ __forceinline__ float silu_f(float x) { return x / (1.0f + __expf(-x)); }
__device__ __forceinline__ void sincos_red(float ang, float& s, float& c) {
    const double a = (double)ang; const double n = rint(a * 0.15915494309189535); const float rf = (float)(a - n * 6.283185307179586);
    s = __sinf(rf); c = __cosf(rf);
}
__device__ __forceinline__ float ret_theta(int d) { return (float)exp2(-(double)d * (13.287712379549449 / 127.0)); }
__device__ __forceinline__ float ax_freq(int i) { return (float)exp2(-(double)i * (13.287712379549449 / 16.0)); }
constexpr size_t al256c(size_t x) { return (x + 255) & ~(size_t)255; }
constexpr size_t WS_CTL = 0, CTL_BYTES = 1 << 20;
constexpr size_t WS_MOD = al256c(WS_CTL + CTL_BYTES);
constexpr size_t WS_COSR = al256c(WS_MOD + (size_t)DEPTH * 5 * 6144 * 4);
constexpr size_t WS_SINR = al256c(WS_COSR + (size_t)SEQ * 128 * 4);
constexpr size_t WS_COSM = al256c(WS_SINR + (size_t)SEQ * 128 * 4);
constexpr size_t WS_SINM = al256c(WS_COSM + (size_t)SEQ * 32 * 4);
constexpr size_t WS_TOKINFO = al256c(WS_SINM + (size_t)SEQ * 32 * 4);
constexpr size_t WS_LIST = al256c(WS_TOKINFO + (size_t)NTOK * 16 * 4);
constexpr size_t WS_PLAN = al256c(WS_LIST + (size_t)NE * NTOK * 4);
constexpr size_t WS_WRI = al256c(WS_PLAN + (size_t)DEPTH * 1024 * 4);
constexpr size_t WS_WRO = al256c(WS_WRI + (size_t)2 * 8192 * 1024 * 2);
constexpr size_t WS_WMI = al256c(WS_WRO + (size_t)2 * 1024 * 2048 * 2);
constexpr size_t WS_WUQ = al256c(WS_WMI + (size_t)2 * MINP * 1024 * 2);
constexpr size_t WS_WUKV = al256c(WS_WUQ + (size_t)2 * 1536 * 384 * 2);
constexpr size_t WS_WMO = al256c(WS_WUKV + (size_t)2 * 2048 * 256 * 2);
constexpr size_t WS_WUP = al256c(WS_WMO + (size_t)2 * 1024 * 1024 * 2);
constexpr size_t WS_WDN = al256c(WS_WUP + (size_t)DEPTH * NE * 2048 * 1024 * 2);
constexpr size_t WS_X = al256c(WS_WDN + (size_t)DEPTH * NE * 1024 * 1024 * 2);
constexpr size_t WS_H = al256c(WS_X + (size_t)NTOK * D * 4);
constexpr size_t WS_RA = al256c(WS_H + (size_t)NTOK * D * 2);
constexpr size_t WS_RB = al256c(WS_RA + (size_t)MAXSLOTS * 2048 * 4);
constexpr size_t WS_RC = al256c(WS_RB + (size_t)1107296256 + 4096);
constexpr size_t WS_END = al256c(WS_RC + (size_t)NTOK * D * 4 + (size_t)MAXSLOTS * D * 4);
constexpr int CW_CNT = 1024, CW_BAR = 4096;
constexpr int LDS_MISC = LDS_MISC_BASE, LDS_BYTES = 159744;
#define XB_TMO      128
#define XB_XCNT(j)  (256  + 64 * (j))
#define XB_XSUB(j)  (1280 + 64 * (j))
#define XB_XGEN(j)  (2304 + 64 * (j))
#define XB_TOP      3328
#define XB_TOPGEN   3392
#define XCD_BAR_WORDS 3456
#define XB_SPIN_CAP (1u << 22)
__device__ __forceinline__ unsigned xb_ld(unsigned* p)              { return __hip_atomic_load(p, __ATOMIC_RELAXED, __HIP_MEMORY_SCOPE_AGENT); }
__device__ __forceinline__ unsigned xb_add(unsigned* p, unsigned v) { return __hip_atomic_fetch_add(p, v, __ATOMIC_RELAXED, __HIP_MEMORY_SCOPE_AGENT); }
__device__ __forceinline__ unsigned xb_xcc_id() { return (unsigned)__builtin_amdgcn_s_getreg((3 << 11) | 20) & 0xFu; }
#define XB_SPIN(cond, bar) do { unsigned _sp = 0; while (cond) { __builtin_amdgcn_s_sleep(1); \
    if ((++_sp & 255u) == 0u) { if (xb_ld(&(bar)[XB_TMO])) break; if (_sp > XB_SPIN_CAP) { atomicAdd(&(bar)[XB_TMO], 1u); break; } } } } while (0)
struct XcdBarrier { unsigned* bar; unsigned x; volatile LAS unsigned* st; };
__device__ __forceinline__ XcdBarrier xcd_barrier_post(unsigned* bar, volatile LAS unsigned* st) {
    XcdBarrier b; b.bar = bar; b.x = xb_xcc_id(); b.st = st;
    if (threadIdx.x == 0) (void)xb_add(&bar[XB_XCNT(b.x)], 1u);
    return b;
}
__device__ __forceinline__ void xcd_barrier_complete(unsigned* bar, unsigned x, unsigned& nloc, unsigned& nx) {
    const unsigned G = gridDim.x * gridDim.y * gridDim.z;
    unsigned sum, cnt, mine, sp = 0u;
    for (;;) {
        sum = 0u; cnt = 0u; mine = 0u;
#pragma unroll
        for (unsigned j = 0; j < 16; ++j) { const unsigned c = xb_ld(&bar[XB_XCNT(j)]); sum += c; cnt += (c > 0u) ? 1u : 0u; mine = (j == x) ? c : mine; }
        if (sum == G) break;
        __builtin_amdgcn_s_sleep(1);
        if ((++sp & 255u) == 0u) { if (xb_ld(&bar[XB_TMO])) break; if (sp > XB_SPIN_CAP) { atomicAdd(&bar[XB_TMO], 1u); break; } }
    }
    nloc = mine > 0u ? mine : 1u; nx = cnt > 0u ? cnt : 1u;
}
__device__ __forceinline__ void xcd_barrier(const XcdBarrier& b0) {
    XcdBarrier b; { unsigned* q = b0.bar; unsigned xx = b0.x; asm volatile("" : "+s"(q), "+s"(xx)); b.bar = q; b.x = xx; b.st = b0.st; }
    asm volatile("s_waitcnt vmcnt(0)" ::: "memory");
    __syncthreads();
    if (threadIdx.x == 0) {
        unsigned* bar = b.bar;
        __builtin_amdgcn_s_waitcnt(0);
        unsigned nloc = b.st[0], nx = b.st[1];
        if (nloc == 0u) { xcd_barrier_complete(bar, b.x, nloc, nx); b.st[0] = nloc; b.st[1] = nx; }
        const unsigned old = xb_add(&bar[XB_XSUB(b.x)], 1u);
        const unsigned gen = old / nloc;
        if (old + 1u == (gen + 1u) * nloc) {
            __builtin_amdgcn_fence(__ATOMIC_RELEASE, "agent");
            asm volatile("s_waitcnt vmcnt(0)" ::: "memory");
            const unsigned og = xb_add(&bar[XB_TOP], 1u);
            const unsigned tg = og / nx;
            if (og + 1u == (tg + 1u) * nx) xb_add(&bar[XB_TOPGEN], 1u);
            else XB_SPIN(xb_ld(&bar[XB_TOPGEN]) == tg, bar);
            __builtin_amdgcn_fence(__ATOMIC_ACQUIRE, "agent");
            xb_add(&bar[XB_XGEN(b.x)], 1u);
            asm volatile("s_waitcnt vmcnt(0)" ::: "memory");
        } else {
            XB_SPIN(xb_ld(&bar[XB_XGEN(b.x)]) == gen, bar);
            __builtin_amdgcn_fence(__ATOMIC_ACQUIRE, "agent");
            asm volatile("s_waitcnt vmcnt(0)" ::: "memory");
        }
    }
    __syncthreads();
}
#define PH_TID ph_tid()
__device__ __forceinline__ void gemm_f32_phase(LAS unsigned char* lds, const bf16_t* A, const bf16_t* Bt, float* C, int M, int N, int K, int lda, int ldb, int ldc) {
    pg8::Gemm g{A, Bt, K, lda, ldb};
    pg8::StaticOrder S; S.init(M, N, (int)gridDim.x, (int)blockIdx.x);
    pg8::EpiF32 E{C, ldc, nullptr, 1 << 30, 0};
    pg8::gemm_phase<pg8::EpiF32, pg8::StaticOrder, true, true>(lds, g, S, E);
}
struct MoeOrder {
    static constexpr bool GATHER = false;
    const int* plan; int nN, G, c;
    __device__ bool next(int i, pg8::Unit& u) const {
        const int T = __builtin_amdgcn_readfirstlane(plan[64]); const long L = (long)i * G + c; const int nwg = T * nN; if (L >= nwg) return false;
        int wgid = (int)L; { const int q = nwg / 8, r = nwg % 8, xcd = wgid % 8, off = wgid / 8; wgid = (xcd < r ? xcd * (q + 1) : r * (q + 1) + (xcd - r) * q) + off; }
        const int nig = 8 * nN, gid = wgid / nig, fm = gid * 8, gsz = (T - fm) < 8 ? (T - fm) : 8;
        const int pm = fm + ((wgid % nig) % gsz), pcl = (wgid % nig) / gsz; const int e = __builtin_amdgcn_readfirstlane(plan[128 + pm]);
        u.pm = pm; u.pn = e * nN + pcl; u.pc = pcl; u.ka = 0u; u.kb = 0u; return true;
    }
    __device__ __forceinline__ void a_ready(const pg8::Unit&) const {}
    __device__ __forceinline__ void done(const pg8::Unit&) const {}
};
__device__ __forceinline__ void moe_gemm_f32_phase(LAS unsigned char* lds, const bf16_t* A, const bf16_t* Bt, float* C, const float* bias, const int* plan, int nN, int K, int ldc, int bstride) {
    pg8::Gemm g{A, Bt, K, K, K};
    MoeOrder S{plan, nN, (int)gridDim.x, (int)blockIdx.x};
    pg8::EpiF32 E{C, ldc, bias, nN, bstride};
    pg8::gemm_phase<pg8::EpiF32, MoeOrder, true, true>(lds, g, S, E);
}
template <int MODE = 0> __device__ __forceinline__ void ph_transpose(LAS unsigned char* lds, const float* src, bf16_t* dst, int K, int N, int ldd, int nbatch, long sstride, long dstride, int bid, int nblk) {
    LAS float* tile = (LAS float*)lds;
    const int tid = PH_TID;
    const int nkb = K / 64, nnb = (N + 127) / 128; const long per = (long)nkb * nnb, ntl = per * nbatch;
    for (long it = bid; it < ntl; it += nblk) {
        const int bt = (int)(it / per), r = (int)(it % per), kb = r / nnb, nb = r % nnb, k0 = kb * 64, n0 = nb * 128;
        const float* s = src + (size_t)bt * sstride; bf16_t* d = dst + (size_t)bt * dstride;
#pragma unroll
        for (int i = 0; i < 16; ++i) { const int kk = i * 4 + (tid >> 7), nn = tid & 127; tile[kk * 129 + nn] = (n0 + nn < N) ? s[(size_t)(k0 + kk) * N + n0 + nn] : 0.f; }
        __syncthreads();
#pragma unroll
        for (int j = 0; j < 2; ++j) { const int nn = (tid >> 3) + 64 * j, c = tid & 7;
            if (MODE == 3 || n0 + nn < N) { u32x4 o; o.x = pk2(tile[(8 * c) * 129 + nn]    , tile[(8 * c + 1) * 129 + nn]); o.y = pk2(tile[(8 * c + 2) * 129 + nn], tile[(8 * c + 3) * 129 + nn]);
                o.z = pk2(tile[(8 * c + 4) * 129 + nn], tile[(8 * c + 5) * 129 + nn]); o.w = pk2(tile[(8 * c + 6) * 129 + nn], tile[(8 * c + 7) * 129 + nn]);
                int rown = n0 + nn; if (MODE == 1) { const int jn = rown & 1023; rown = (jn >> 7) * 256 + (rown >> 10) * 128 + (jn & 127); }
                if (MODE == 2) { const int hd = rown / 192, dd = rown % 192; if (dd < 128) rown = hd * 128 + dd; else { const int rr = dd - 128; rown = 1024 + (hd >> 2) * 256 + (rr >> 5) * 128 + (hd & 3) * 32 + (rr & 31); } }
                *(u32x4*)(d + (size_t)rown * ldd + k0 + 8 * c) = o; } }
        __syncthreads();
    }
}
template <int MODE> __device__ __forceinline__ int tr_rowmap(int rown) {
    if (MODE == 1) { const int jn = rown & 1023; return (jn >> 7) * 256 + (rown >> 10) * 128 + (jn & 127); }
    return rown;
}
template <int MODE = 0> __device__ __forceinline__ void ph_transpose_direct(const float* src, bf16_t* dst, int K, int N, int ldd, int nbatch, long sstride, long dstride, int bid, int nblk) {
    const int tid = PH_TID, n4 = tid & 63, kc = tid >> 6;
    const int nkb = K / 64, nnb = N / 256; const long per = (long)nkb * nnb, ntl = per * nbatch;
    constexpr int NT_ = 4;
    for (long it0 = bid; it0 < ntl; it0 += (long)NT_ * nblk) {
        f32x4 v[NT_][8]; bf16_t* dp[NT_][4]; bool ok[NT_];
#pragma unroll
        for (int u = 0; u < NT_; ++u) { const long it = it0 + (long)u * nblk; ok[u] = it < ntl; const long itc = ok[u] ? it : it0;
            const int bt = (int)(itc / per), r = (int)(itc % per), kb = r / nnb, nb = r % nnb, k0 = kb * 64, n0 = nb * 256;
            const float* sp = src + (size_t)bt * sstride + (size_t)(k0 + 8 * kc) * N + n0 + 4 * n4;
#pragma unroll
            for (int q = 0; q < 4; ++q) dp[u][q] = dst + (size_t)bt * dstride + (size_t)tr_rowmap<MODE>(n0 + 4 * n4 + q) * ldd + k0 + 8 * kc;
#pragma unroll
            for (int i = 0; i < 8; ++i) v[u][i] = *(const f32x4*)(sp + (size_t)i * N); }
#pragma unroll
        for (int u = 0; u < NT_; ++u) if (ok[u]) {
#pragma unroll
            for (int q = 0; q < 4; ++q) { u32x4 o; o.x = pk2(v[u][0][q], v[u][1][q]); o.y = pk2(v[u][2][q], v[u][3][q]); o.z = pk2(v[u][4][q], v[u][5][q]); o.w = pk2(v[u][6][q], v[u][7][q]);
                *(u32x4*)dp[u][q] = o; } }
    }
}
constexpr float W8S = 32.0f, W8I = 1.0f / 32.0f;
template <int MODE = 0> __device__ __forceinline__ void ph_transpose_direct8(const float* src, unsigned char* dst, int K, int N, int ldd, int nbatch, long sstride, long dstride, int bid, int nblk) {
    const int tid = PH_TID, n4 = tid & 63, kc = tid >> 6;
    const int nkb = K / 64, nnb = N / 256; const long per = (long)nkb * nnb, ntl = per * nbatch;
    constexpr int NT_ = 4;
    for (long it0 = bid; it0 < ntl; it0 += (long)NT_ * nblk) {
        f32x4 v[NT_][8]; unsigned char* dp[NT_][4]; bool ok[NT_];
#pragma unroll
        for (int u = 0; u < NT_; ++u) { const long it = it0 + (long)u * nblk; ok[u] = it < ntl; const long itc = ok[u] ? it : it0;
            const int bt = (int)(itc / per), r = (int)(itc % per), kb = r / nnb, nb = r % nnb, k0 = kb * 64, n0 = nb * 256;
            const float* sp = src + (size_t)bt * sstride + (size_t)(k0 + 8 * kc) * N + n0 + 4 * n4;
#pragma unroll
            for (int q = 0; q < 4; ++q) dp[u][q] = dst + (size_t)bt * dstride + (size_t)tr_rowmap<MODE>(n0 + 4 * n4 + q) * ldd + k0 + 8 * kc;
#pragma unroll
            for (int i = 0; i < 8; ++i) v[u][i] = *(const f32x4*)(sp + (size_t)i * N); }
#pragma unroll
        for (int u = 0; u < NT_; ++u) if (ok[u]) {
#pragma unroll
            for (int q = 0; q < 4; ++q) { u32x2 o; o.x = pk4_fp8(v[u][0][q] * W8S, v[u][1][q] * W8S, v[u][2][q] * W8S, v[u][3][q] * W8S); o.y = pk4_fp8(v[u][4][q] * W8S, v[u][5][q] * W8S, v[u][6][q] * W8S, v[u][7][q] * W8S);
                *(u32x2*)dp[u][q] = o; } }
    }
}
constexpr int CT_PER_LAYER = 6144, CT_TOTAL = 3 * CT_PER_LAYER;
constexpr int CT_NSLOT = 10;
constexpr int CT_THR[CT_NSLOT] = {128, 64, 16, 32, 16, 128, 64, 16, 32, 16};
constexpr int CT_TPW[CT_NSLOT] = {10, 12, 16, 4, 8, 10, 12, 16, 4, 8};
constexpr int ct_deadline_after(int s) { return s == 4 ? 1 : (s == 7 ? 2 : (s == 9 ? 3 : 0)); }
constexpr int ct_slot_start(int s) {
    int pos = 0;
    for (int i = 0; i < s; ++i) { pos += (256 - CT_THR[i]) * CT_TPW[i]; const int d = ct_deadline_after(i); if (d && pos < d * CT_PER_LAYER) pos = d * CT_PER_LAYER; }
    return pos;
}
constexpr int ct_drain_start(int layer) {
    const int s = layer == 1 ? 4 : (layer == 2 ? 7 : 9);
    const int pos = ct_slot_start(s) + (256 - CT_THR[s]) * CT_TPW[s];
    return pos < layer * CT_PER_LAYER ? pos : layer * CT_PER_LAYER;
}
__device__ __forceinline__ void ct_convert(const float* exp_w_up, const float* exp_w_down, unsigned char* WUP, unsigned char* WDN, int g0, int n) {
    if (g0 >= CT_TOTAL) return;
    const int tid = PH_TID, n4 = tid & 63, kc = tid >> 6;
    for (int base = 0; base < n; base += 4) {
        f32x4 v[4][8]; unsigned char* dp[4][4]; bool ok[4];
#pragma unroll
        for (int u = 0; u < 4; ++u) { const int g = g0 + base + u; ok[u] = (base + u < n) && g < CT_TOTAL; const int gc = ok[u] ? g : 0;
            const int L = 1 + gc / CT_PER_LAYER, t = gc % CT_PER_LAYER; const bool up = t < 4096; const int tt = up ? t : t - 4096;
            const int e = up ? (tt >> 7) : (tt >> 6), w = up ? (tt & 127) : (tt & 63), kb = up ? (w >> 3) : (w >> 2), nb = up ? (w & 7) : (w & 3), N = up ? 2048 : 1024;
            const float* sp = (up ? exp_w_up + (size_t)(L * NE + e) * 1024 * 2048 : exp_w_down + (size_t)(L * NE + e) * 1024 * 1024) + (size_t)(kb * 64 + 8 * kc) * N + nb * 256 + 4 * n4;
            unsigned char* db = (up ? WUP + (size_t)(L * NE + e) * 2048 * 1024 : WDN + (size_t)(L * NE + e) * 1024 * 1024) + kb * 64 + 8 * kc;
#pragma unroll
            for (int q = 0; q < 4; ++q) { const int col = nb * 256 + 4 * n4 + q; dp[u][q] = db + (size_t)(up ? tr_rowmap<1>(col) : col) * 1024; }
#pragma unroll
            for (int i = 0; i < 8; ++i) v[u][i] = *(const f32x4*)(sp + (size_t)i * N); }
#pragma unroll
        for (int u = 0; u < 4; ++u) if (ok[u]) {
#pragma unroll
            for (int q = 0; q < 4; ++q) { u32x2 o; o.x = pk4_fp8(v[u][0][q] * W8S, v[u][1][q] * W8S, v[u][2][q] * W8S, v[u][3][q] * W8S); o.y = pk4_fp8(v[u][4][q] * W8S, v[u][5][q] * W8S, v[u][6][q] * W8S, v[u][7][q] * W8S);
                *(u32x2*)dp[u][q] = o; } }
    }
}
template <int SLOT> __device__ __forceinline__ void ct_slot(const float* exp_w_up, const float* exp_w_down, unsigned char* WUP, unsigned char* WDN, int bid) {
    constexpr int start = ct_slot_start(SLOT), thr = CT_THR[SLOT], tpw = CT_TPW[SLOT];
    if (start < CT_TOTAL && bid >= thr) ct_convert(exp_w_up, exp_w_down, WUP, WDN, start + (bid - thr) * tpw, tpw);
}
template <int LAYER> __device__ __forceinline__ void ct_drain(const float* exp_w_up, const float* exp_w_down, unsigned char* WUP, unsigned char* WDN, int bid, int nblk) {
    constexpr int a = ct_drain_start(LAYER), b = LAYER * CT_PER_LAYER;
    if constexpr (a < b) { const int per = (b - a + nblk - 1) / nblk; const int g0 = a + bid * per; const int n = g0 + per <= b ? per : (b > g0 ? b - g0 : 0); if (n > 0) ct_convert(exp_w_up, exp_w_down, WUP, WDN, g0, n); }
}
__device__ __forceinline__ void ph_zero16(u32x4* p, long n16, int bid, int nblk) { for (long i = bid * 512L + PH_TID; i < n16; i += nblk * 512L) p[i] = (u32x4){0u, 0u, 0u, 0u}; }
__device__ __forceinline__ void ph_adaln(LAS unsigned char* lds, const float* c, const float* c_ctx, const float* ada_w, const float* ada_b, float* MOD, int bid, int nblk) {
    LAS float* sv = (LAS float*)lds; LAS float* red = sv + 5 * 1024;
    const int tid = PH_TID;
    for (int i = tid; i < 5 * 1024; i += 512) { const int v = i >> 10, k = i & 1023; const float x = v < 4 ? c[v * 1024 + k] : c_ctx[k]; sv[i] = silu_f(x); }
    __syncthreads();
    for (int item = bid; item < DEPTH * 96; item += nblk) {
        const int l = item / 96, n0 = (item % 96) * 64, cc = tid & 63, ks = tid >> 6;
        const float* w = ada_w + (size_t)l * 1024 * 6144 + n0 + cc;
        float a0 = 0, a1 = 0, a2 = 0, a3 = 0, a4 = 0;
        for (int k = ks * 128; k < ks * 128 + 128; ++k) { const float wv = w[(size_t)k * 6144]; a0 += sv[k] * wv; a1 += sv[1024 + k] * wv; a2 += sv[2048 + k] * wv; a3 += sv[3072 + k] * wv; a4 += sv[4096 + k] * wv; }
        red[(ks * 5 + 0) * 64 + cc] = a0; red[(ks * 5 + 1) * 64 + cc] = a1; red[(ks * 5 + 2) * 64 + cc] = a2; red[(ks * 5 + 3) * 64 + cc] = a3; red[(ks * 5 + 4) * 64 + cc] = a4;
        __syncthreads();
        if (tid < 320) { const int v = tid >> 6; float s = 0; for (int q = 0; q < 8; ++q) s += red[(q * 5 + v) * 64 + cc]; MOD[((size_t)l * 5 + v) * 6144 + n0 + cc] = s + ada_b[(size_t)l * 6144 + n0 + cc]; }
        __syncthreads();
    }
}
__device__ __forceinline__ void ph_rot_tables(float* COSR, float* SINR, float* COSM, float* SINM, int bid, int nblk) {
    const long gt = bid * 512L + PH_TID, NG = nblk * 512L;
    for (long i = gt; i < (long)SEQ * 128; i += NG) { const int t = (int)(i >> 7), d = (int)(i & 127); float s, c; sincos_red((float)t * ret_theta(d), s, c); COSR[i] = c; SINR[i] = s; }
    for (long i = gt; i < (long)SEQ * 32; i += NG) { const int t = (int)(i >> 5), j = (int)(i & 31); const int row = t >> 6, col = t & 63;
        const float ang = j < 16 ? (float)row * ax_freq(j) : (float)col * ax_freq(j - 16); float s, c; sincos_red(ang, s, c); COSM[i] = c; SINM[i] = s; }
}

struct EpiSwiGLU {
    static constexpr bool PERM = true, AFTER_DRAIN = false;
    unsigned char* ACT; const float* bias; int nN;
    __device__ __forceinline__ void operator()(const pg8::f32x4 (&acc)[2][2][4][2], const pg8::Unit& u, int wr, int wc, int fr, int fq) const {
        int row0 = u.pm * 256 + wr * 64 + fr, j0 = u.pc * 128 + wc * 32 + 8 * fq; asm volatile("" : "+v"(row0), "+v"(j0));
        const float* bp = bias + (size_t)(u.pn / nN) * 2048 + j0;
        const pg8::f32x4 bg0 = *(const pg8::f32x4*)bp, bg1 = *(const pg8::f32x4*)(bp + 4), bl0 = *(const pg8::f32x4*)(bp + 1024), bl1 = *(const pg8::f32x4*)(bp + 1028);
#pragma unroll
        for (int ai = 0; ai < 2; ++ai)
#pragma unroll
            for (int m = 0; m < 4; ++m) { float o[8];
#pragma unroll
                for (int n = 0; n < 2; ++n)
#pragma unroll
                    for (int e = 0; e < 4; ++e) { const float g = fminf(acc[ai][0][m][n][e] * W8I + (n ? bg1[e] : bg0[e]), 7.0f), l = fminf(fmaxf(acc[ai][1][m][n][e] * W8I + (n ? bl1[e] : bl0[e]), -7.0f), 7.0f);
                        o[n * 4 + e] = g * __builtin_amdgcn_rcpf(1.0f + __expf(-1.702f * g)) * (l + 1.0f); }
                u32x2 w; w.x = pk4_fp8(o[0], o[1], o[2], o[3]); w.y = pk4_fp8(o[4], o[5], o[6], o[7]);
                *(u32x2*)(ACT + (size_t)(row0 + ai * 128 + m * 16) * 1024 + j0) = w; }
    }
};
constexpr float YD8S = 8.0f, YD8I = 0.125f;
struct EpiDownBf16 {
    static constexpr bool PERM = true, AFTER_DRAIN = false;
    bf16_t* YD; const float* bias; int nN;
    __device__ __forceinline__ void operator()(const pg8::f32x4 (&acc)[2][2][4][2], const pg8::Unit& u, int wr, int wc, int fr, int fq) const {
        int row0 = u.pm * 256 + wr * 64 + fr, c0 = u.pc * 256 + wc * 32 + 8 * fq; asm volatile("" : "+v"(row0), "+v"(c0));
        const float* bp = bias + (size_t)(u.pn / nN) * 1024 + c0;
        pg8::f32x4 bv[2][2];
#pragma unroll
        for (int bj = 0; bj < 2; ++bj) { bv[bj][0] = *(const pg8::f32x4*)(bp + bj * 128); bv[bj][1] = *(const pg8::f32x4*)(bp + bj * 128 + 4); }
#pragma unroll
        for (int ai = 0; ai < 2; ++ai)
#pragma unroll
            for (int m = 0; m < 4; ++m)
#pragma unroll
                for (int bj = 0; bj < 2; ++bj) { const pg8::f32x4 v0 = acc[ai][bj][m][0] * W8I + bv[bj][0], v1 = acc[ai][bj][m][1] * W8I + bv[bj][1];
                    u32x2 w; w.x = pk4_fp8(v0[0] * YD8S, v0[1] * YD8S, v0[2] * YD8S, v0[3] * YD8S); w.y = pk4_fp8(v1[0] * YD8S, v1[1] * YD8S, v1[2] * YD8S, v1[3] * YD8S);
                    *(u32x2*)((unsigned char*)YD + (size_t)(row0 + ai * 128 + m * 16) * 1024 + c0 + bj * 128) = w; }
    }
};
struct MoeOrderG : MoeOrder { static constexpr bool GATHER = true; };
__device__ __forceinline__ void moe_plan_local(LAS unsigned char* lds, const int* cnt, int* plan_g, int bid);
__device__ __forceinline__ void moe_up_phase(LAS unsigned char* lds, const unsigned char* H8, const unsigned char* Wup8, unsigned char* ACT8, const float* b_up, const int* cnt, int* plan_g, const int* list) {
    moe_plan_local(lds, cnt, plan_g, (int)blockIdx.x);
    const int* plan = (const int*)(lds + 151552);
    pg8::Gemm g{(const bf16_t*)H8, (const bf16_t*)Wup8, 512, 512, 512};
    MoeOrderG S; S.plan = plan; S.nN = 8; S.G = (int)gridDim.x; S.c = (int)blockIdx.x; EpiSwiGLU E{ACT8, b_up, 8};
    { const int tid = ph_tid(); LAS unsigned* tab = (LAS unsigned*)(lds + LDS_GTAB);
      int tk[20], pmv[20]; bool okv[20];
#pragma unroll
      for (int ui = 0; ui < 20; ++ui) { pg8::Unit u; okv[ui] = S.next(ui, u); pmv[ui] = u.pm; }
      const LAS int* lp = (const LAS int*)(lds + 151552);
#pragma unroll
      for (int ui = 0; ui < 20; ++ui) { tk[ui] = 0;
          if (okv[ui] && tid < 256) { const int r = pmv[ui] * 256 + tid, e = lp[128 + pmv[ui]], pos = r - lp[e]; if (pos < lp[32 + e]) tk[ui] = ((const GAS int*)list)[(size_t)e * NTOK + pos]; } }
#pragma unroll
      for (int ui = 0; ui < 20; ++ui) if (okv[ui] && tid < 256) tab[ui * 256 + tid] = (unsigned)tk[ui] * 1024u;
      __syncthreads(); }
    pg8::gemm_phase<EpiSwiGLU, MoeOrderG, true, true, true>(lds, g, S, E);
}
__device__ __forceinline__ void moe_down_phase(LAS unsigned char* lds, const unsigned char* ACT8, const unsigned char* Wdn8, bf16_t* YD, const float* b_down, const int* plan) {
    pg8::Gemm g{(const bf16_t*)ACT8, (const bf16_t*)Wdn8, 512, 512, 512}; MoeOrder S{plan, 4, (int)gridDim.x, (int)blockIdx.x}; EpiDownBf16 E{YD, b_down, 4};
    pg8::gemm_phase<EpiDownBf16, MoeOrder, true, true, true>(lds, g, S, E);
}
__device__ __forceinline__ u32x4 pk8(const pg8::f32x4& a, const pg8::f32x4& b) { u32x4 w; w.x = pk2(a[0], a[1]); w.y = pk2(a[2], a[3]); w.z = pk2(b[0], b[1]); w.w = pk2(b[2], b[3]); return w; }
struct EpiMlaQ {
    static constexpr bool PERM = true, AFTER_DRAIN = false;
    unsigned char* Q8; const float* COSM; const float* SINM;
    __device__ __forceinline__ void operator()(const pg8::f32x4 (&acc)[2][2][4][2], const pg8::Unit& u, int wr, int wc, int fr, int fq) const {
        const int t2 = ph_tid(), wd2 = t2 >> 6, ln2 = t2 & 63; wc = wd2 & 3;
        const int row0 = u.pm * 256 + (wd2 >> 2) * 64 + (ln2 & 15), c8 = wc * 32 + 8 * (ln2 >> 4);
        if (u.pc < 4) {
#pragma unroll
            for (int ai = 0; ai < 2; ++ai)
#pragma unroll
                for (int m = 0; m < 4; ++m) { const unsigned qo = (unsigned)(row0 + ai * 128 + m * 16) * 1536u + (unsigned)c8;
#pragma unroll
                    for (int bj = 0; bj < 2; ++bj) { const pg8::f32x4 a = acc[ai][bj][m][0], b = acc[ai][bj][m][1]; u32x2 w; w.x = pk4_fp8(a[0], a[1], a[2], a[3]); w.y = pk4_fp8(b[0], b[1], b[2], b[3]);
                        *(u32x2*)(Q8 + (qo + (unsigned)((u.pc * 2 + bj) * 192))) = w; } }
        } else {
            const int hd = (u.pc - 4) * 4 + wc, i0 = c8 - wc * 32;
#pragma unroll
            for (int ai = 0; ai < 2; ++ai)
#pragma unroll
                for (int m = 0; m < 4; ++m) { const int tok = row0 + ai * 128 + m * 16, s = tok % LT; const bool lat = s >= CTXL;
                    const unsigned ro = lat ? (unsigned)(s - CTXL) * 128u + (unsigned)i0 * 4u : 0u;
                    const unsigned qo = (unsigned)tok * 1536u + (unsigned)(hd * 192 + 128 + i0); u32x2 w1, w2;
#pragma unroll
                    for (int n = 0; n < 2; ++n) { pg8::f32x4 c = *(const pg8::f32x4*)((const char*)COSM + ro + 16 * n), sn = *(const pg8::f32x4*)((const char*)SINM + ro + 16 * n);
                        if (!lat) { c = (pg8::f32x4){1.f, 1.f, 1.f, 1.f}; sn = (pg8::f32x4){0.f, 0.f, 0.f, 0.f}; }
                        const pg8::f32x4 x1 = acc[ai][0][m][n], x2 = acc[ai][1][m][n], o1 = x1 * c - x2 * sn, o2 = x1 * sn + x2 * c;
                        const unsigned p1 = pk4_fp8(o1[0], o1[1], o1[2], o1[3]), p2 = pk4_fp8(o2[0], o2[1], o2[2], o2[3]);
                        if (n == 0) { w1.x = p1; w2.x = p2; } else { w1.y = p1; w2.y = p2; } }
                    *(u32x2*)(Q8 + qo) = w1; *(u32x2*)(Q8 + (qo + 32u)) = w2; }
        }
    }
};
struct EpiMlaKV {
    static constexpr bool PERM = true, AFTER_DRAIN = false;
    unsigned char* K8; bf16_t* Vh;
    __device__ __forceinline__ void operator()(const pg8::f32x4 (&acc)[2][2][4][2], const pg8::Unit& u, int wr, int wc, int fr, int fq) const {
        const int t2 = ph_tid(), wd2 = t2 >> 6, ln2 = t2 & 63;
        const int row0 = u.pm * 256 + (wd2 >> 2) * 64 + (ln2 & 15), c8 = (wd2 & 3) * 32 + 8 * (ln2 >> 4);
#pragma unroll
        for (int ai = 0; ai < 2; ++ai)
#pragma unroll
            for (int m = 0; m < 4; ++m) { const unsigned tok = (unsigned)(row0 + ai * 128 + m * 16);
                const pg8::f32x4 a = acc[ai][0][m][0], b = acc[ai][0][m][1]; u32x2 w; w.x = pk4_fp8(a[0], a[1], a[2], a[3]); w.y = pk4_fp8(b[0], b[1], b[2], b[3]);
                *(u32x2*)(K8 + (tok * 1536u + (unsigned)(u.pc * 192 + c8))) = w;
                *(u32x4*)((unsigned char*)Vh + (tok * 2048u + (unsigned)(u.pc * 128 + c8) * 2u)) = pk8(acc[ai][1][m][0], acc[ai][1][m][1]); }
    }
};
__device__ __forceinline__ void mla_q_phase(LAS unsigned char* lds, const bf16_t* CQ, const bf16_t* Wuq, unsigned char* Qh, const float* COSM, const float* SINM) {
    pg8::Gemm g{CQ, Wuq, 384, 384, 384}; pg8::StaticOrder S; S.init(NTOK, 1536, (int)gridDim.x, (int)blockIdx.x); EpiMlaQ E{Qh, COSM, SINM};
    pg8::gemm_phase<EpiMlaQ, pg8::StaticOrder, true, true>(lds, g, S, E);
}
__device__ __forceinline__ void mla_kv_phase(LAS unsigned char* lds, const bf16_t* CKV, const bf16_t* Wukv, unsigned char* Kh, bf16_t* Vh) {
    pg8::Gemm g{CKV, Wukv, 256, 256, 256}; pg8::StaticOrder S; S.init(NTOK, 2048, (int)gridDim.x, (int)blockIdx.x); EpiMlaKV E{Kh, Vh};
    pg8::gemm_phase<EpiMlaKV, pg8::StaticOrder, true, true>(lds, g, S, E);
}

struct EpiResid {
    static constexpr bool PERM = false, AFTER_DRAIN = false;
    float* X; const float* gvec;
    __device__ __forceinline__ void operator()(const pg8::f32x4 (&acc)[2][2][4][2], const pg8::Unit& u, int wr, int wc, int fr, int fq) const {
        const int t2 = ph_tid(), wd2 = t2 >> 6, ln2 = t2 & 63;
        const int row0 = u.pm * 256 + (wd2 >> 2) * 64 + (ln2 & 15), col0 = u.pc * 256 + (wd2 & 3) * 32 + 4 * (ln2 >> 4);
#pragma unroll
        for (int ai = 0; ai < 2; ++ai)
#pragma unroll
            for (int m = 0; m < 4; ++m) { const int tok = row0 + ai * 128 + m * 16, b = tok / LT, v = (tok - b * LT) < CTXL ? 4 : b;
                float* xr = X + (size_t)tok * D + col0; const float* gr = gvec + (size_t)v * 6144 + col0;
#pragma unroll
                for (int bj = 0; bj < 2; ++bj)
#pragma unroll
                    for (int n = 0; n < 2; ++n) { const pg8::f32x4 g = *(const pg8::f32x4*)(gr + bj * 128 + n * 16); pg8::f32x4 x = *(const pg8::f32x4*)(xr + bj * 128 + n * 16);
                        x += g * acc[ai][bj][m][n]; *(pg8::f32x4*)(xr + bj * 128 + n * 16) = x; } }
    }
};
__device__ __forceinline__ void resid_gemm_phase(LAS unsigned char* lds, const bf16_t* A, const bf16_t* Wt, int K, float* X, const float* gvec) {
    pg8::Gemm g{A, Wt, K, K, K}; pg8::StaticOrder S; S.init(NTOK, 1024, (int)gridDim.x, (int)blockIdx.x); EpiResid E{X, gvec};
    pg8::gemm_phase<EpiResid, pg8::StaticOrder, true, true>(lds, g, S, E);
}
struct RowP {
    const float* x_in; const float* ctx_in;
    float* X; bf16_t* H; float* out;
    const float* Z;
    const bf16_t* YD; const int* tokinfo; const int* planprev;
    const float* gvec;
    const float* normw; const float* shiftv; const float* scalev;
    const float* router_w; const float* router_b;
    int* cnt; int* tokinfo_out; int* list;
    int skip_ctx;
};
#ifndef EXPERIMENT_MOE_SCALE
#define EXPERIMENT_MOE_SCALE 1.0f
#endif
enum { RP_FIRST = 1, RP_ADD_DENSE = 2, RP_ADD_MOE = 4, RP_ROUTER = 8, RP_FINAL = 16 };
template <int F> __device__ __forceinline__ void ph_rowphase(LAS unsigned char* lds, const RowP& p, int bid, int nblk) {
    LAS float* rw = (LAS float*)lds;
    LAS int* hist = (LAS int*)(lds + 131072); LAS int* base = hist + 32; LAS int* rec = (LAS int*)(lds + 131072 + 256);
    const int tid = PH_TID, lane = tid & 63, wave = tid >> 6;
    if (F & RP_ROUTER) {
        for (int i4 = tid; i4 < 1024 * 8; i4 += 512) { const int d = i4 >> 3, ec = i4 & 7; const int ln = (d & 255) >> 2, ii = d & 3, j = d >> 8;
            *(LAS f32x4*)(rw + (((j * 4 + ii) * 8 + ec) * 64 + ln) * 4) = *(const f32x4*)(p.router_w + (size_t)i4 * 4); }
        if (tid < 32) hist[tid] = 0;
        __syncthreads();
    }
    const int gw = bid * 8 + wave, NGW = nblk * 8; int nrec = 0;
    const float rbias = p.router_b[lane & 31];
#define RP_SRC(t_) ((F & RP_FIRST) ? (((t_) % LT) < CTXL ? p.ctx_in + ((size_t)((t_) / LT) * CTXL + ((t_) % LT)) * D : p.x_in + ((size_t)((t_) / LT) * SEQ + (((t_) % LT) - CTXL)) * D) : p.X + (size_t)(t_) * D)
    f32x4 nx[4];
    if (gw < NTOK) { const float* s0 = RP_SRC(gw);
#pragma unroll
        for (int j = 0; j < 4; ++j) nx[j] = *(const f32x4*)(s0 + 4 * lane + 256 * j); }
    for (int tok = gw; tok < NTOK; tok += NGW) {
        const int b = tok / LT, s = tok % LT; const bool isctx = s < CTXL; const int v = isctx ? 4 : b;
        f32x4 xv[4];
#pragma unroll
        for (int j = 0; j < 4; ++j) xv[j] = nx[j];
        if (tok + NGW < NTOK) { const float* s1 = RP_SRC(tok + NGW);
#pragma unroll
            for (int j = 0; j < 4; ++j) nx[j] = *(const f32x4*)(s1 + 4 * lane + 256 * j); }
        if ((F & RP_FINAL) && isctx) continue;
        if (F & RP_ADD_DENSE) {
#pragma unroll
            for (int j = 0; j < 4; ++j) { const f32x4 g = *(const f32x4*)(p.gvec + (size_t)v * 6144 + 4 * lane + 256 * j); const f32x4 z = *(const f32x4*)(p.Z + (size_t)tok * D + 4 * lane + 256 * j); xv[j] += g * z; }
        }
        if (F & RP_ADD_MOE) {
            if (!(p.skip_ctx && isctx)) {
            f32x4 a[4] = {{0,0,0,0},{0,0,0,0},{0,0,0,0},{0,0,0,0}};
            for (int k = 0; k < 4; ++k) { const int e = p.tokinfo[(tok * 4 + k) * 4], pos = p.tokinfo[(tok * 4 + k) * 4 + 1]; const float gt = __builtin_bit_cast(float, p.tokinfo[(tok * 4 + k) * 4 + 2]);
                const unsigned char* yr = (const unsigned char*)p.YD + (size_t)(p.planprev[e] + pos) * D; const float gs = gt * YD8I;
#pragma unroll
                for (int j = 0; j < 4; ++j) { const unsigned w = *(const unsigned*)(yr + 4 * lane + 256 * j); const auto lo2 = __builtin_amdgcn_cvt_pk_f32_fp8(w, false), hi2 = __builtin_amdgcn_cvt_pk_f32_fp8(w, true);
                    a[j] += gs * (f32x4){lo2[0], lo2[1], hi2[0], hi2[1]}; } }
#pragma unroll
            for (int j = 0; j < 4; ++j) { const f32x4 g = *(const f32x4*)(p.gvec + (size_t)v * 6144 + 4 * lane + 256 * j); xv[j] += g * a[j] * EXPERIMENT_MOE_SCALE; }
            }
        }
        if (F & (RP_FIRST | RP_ADD_DENSE | RP_ADD_MOE)) {
            if (!(F & RP_FINAL)) {
#pragma unroll
            for (int j = 0; j < 4; ++j) *(f32x4*)(p.X + (size_t)tok * D + 4 * lane + 256 * j) = xv[j]; }
        }
        float ss = 0.f;
#pragma unroll
        for (int j = 0; j < 4; ++j) ss += (xv[j].x * xv[j].x + xv[j].y * xv[j].y) + (xv[j].z * xv[j].z + xv[j].w * xv[j].w);
        const float r = rsqrtf(wave_sum(ss) * (1.0f / D) + EPS);
        if (F & RP_FINAL) {
#pragma unroll
            for (int j = 0; j < 4; ++j) { const f32x4 nw = *(const f32x4*)(p.normw + 4 * lane + 256 * j); *(f32x4*)(p.out + ((size_t)b * SEQ + (s - CTXL)) * D + 4 * lane + 256 * j) = xv[j] * r * nw; }
            continue;
        }
        f32x4 h[4];
#pragma unroll
        for (int j = 0; j < 4; ++j) { const int col = 4 * lane + 256 * j; const f32x4 nw = *(const f32x4*)(p.normw + col), sh = *(const f32x4*)(p.shiftv + (size_t)v * 6144 + col), sc = *(const f32x4*)(p.scalev + (size_t)v * 6144 + col);
            h[j] = (xv[j] * r * nw) * (1.0f + sc) + sh;
            u32x2 w; w.x = pk2(h[j].x, h[j].y); w.y = pk2(h[j].z, h[j].w); *(u32x2*)(p.H + (size_t)tok * D + col) = w; }
        if (F & RP_ROUTER) {
            if (p.skip_ctx && isctx) continue;
            float lg[32];
#pragma unroll
            for (int e = 0; e < 32; ++e) lg[e] = 0.f;
#pragma unroll
            for (int j = 0; j < 4; ++j)
#pragma unroll
                for (int ii = 0; ii < 4; ++ii) { const float hv = h[j][ii];
#pragma unroll
                    for (int ec = 0; ec < 8; ++ec) { const f32x4 w = *(const LAS f32x4*)(rw + (((j * 4 + ii) * 8 + ec) * 64 + lane) * 4);
                        lg[ec * 4 + 0] += hv * w.x; lg[ec * 4 + 1] += hv * w.y; lg[ec * 4 + 2] += hv * w.z; lg[ec * 4 + 3] += hv * w.w; } }
#pragma unroll
            for (int e = 0; e < 32; ++e) lg[e] = wave_sum(lg[e]) + p.router_b[e];
            float v0 = -3.0e38f, v1 = -3.0e38f, v2 = -3.0e38f, v3 = -3.0e38f; int i0 = 0, i1 = 0, i2 = 0, i3 = 0;
#pragma unroll
            for (int e = 0; e < 32; ++e) { const float xx = lg[e]; const bool g0 = xx > v0, g1 = xx > v1, g2 = xx > v2, g3 = xx > v3;
                v3 = g2 ? v2 : (g3 ? xx : v3); i3 = g2 ? i2 : (g3 ? e : i3);
                v2 = g1 ? v1 : (g2 ? xx : v2); i2 = g1 ? i1 : (g2 ? e : i2);
                v1 = g0 ? v0 : (g1 ? xx : v1); i1 = g0 ? i0 : (g1 ? e : i1);
                v0 = g0 ? xx : v0; i0 = g0 ? e : i0; }
            const float pe0 = 1.0f, pe1 = __expf(v1 - v0), pe2 = __expf(v2 - v0), pe3 = __expf(v3 - v0); const float ps = (pe0 + pe1) + (pe2 + pe3);
            if (lane < 4) { int e = i0; float g = pe0;
                if (lane == 1) { e = i1; g = pe1; } if (lane == 2) { e = i2; g = pe2; } if (lane == 3) { e = i3; g = pe3; }
                g = g / ps;
                const int lpos = __hip_atomic_fetch_add(&hist[e], 1, __ATOMIC_RELAXED, __HIP_MEMORY_SCOPE_WORKGROUP);
                LAS int* rc = rec + ((wave * 17 + nrec) * 4 + lane) * 4; rc[0] = tok; rc[1] = e; rc[2] = lpos; rc[3] = __builtin_bit_cast(int, g); }
            ++nrec;
        }
    }
#undef RP_SRC
    if (F & RP_ROUTER) {
        __syncthreads();
        if (tid < 32) base[tid] = atomicAdd(&p.cnt[tid], hist[tid]);
        __syncthreads();
        for (int i = lane; i < nrec * 4; i += 64) { const LAS int* rc = rec + (wave * 17 * 4 + i) * 4; const int tok = rc[0], e = rc[1], pos = base[e] + rc[2]; const int k = i & 3;
            int* ti = p.tokinfo_out + (tok * 4 + k) * 4; ti[0] = e; ti[1] = pos; ti[2] = rc[3]; ti[3] = 0;
            p.list[(size_t)e * NTOK + pos] = tok; }
    }
}

#define RR_ROW(HX, TOK, DOSTORE) do { const int tok_ = (TOK); const int b_ = tok_ / LT, s_ = tok_ % LT; const int v_ = s_ < CTXL ? 4 : b_; \
        f32x4 xv_[4]; float ss_ = 0.f; \
        _Pragma("unroll") for (int j = 0; j < 4; ++j) { xv_[j] = *(const f32x4*)(p.X + (size_t)tok_ * D + 4 * lane + 256 * j); ss_ += (xv_[j].x * xv_[j].x + xv_[j].y * xv_[j].y) + (xv_[j].z * xv_[j].z + xv_[j].w * xv_[j].w); } \
        const float r_ = rsqrtf(wave_sum(ss_) * (1.0f / D) + EPS); \
        _Pragma("unroll") for (int j = 0; j < 4; ++j) { const int col = 4 * lane + 256 * j; const f32x4 nw = *(const f32x4*)(p.normw + col), sh = *(const f32x4*)(p.shiftv + (size_t)v_ * 6144 + col), sc = *(const f32x4*)(p.scalev + (size_t)v_ * 6144 + col); \
            HX[j] = (xv_[j] * r_ * nw) * (1.0f + sc) + sh; \
            if (DOSTORE) { *(unsigned*)((unsigned char*)p.H + (size_t)tok_ * D + col) = pk4_fp8(HX[j].x, HX[j].y, HX[j].z, HX[j].w); } } } while (0)
#define RR_FINISH(LG, TOK) do { \
        _Pragma("unroll") for (int e = 0; e < 32; ++e) LG[e] = LG[e] + p.router_b[e]; \
        float v0 = -3.0e38f, v1 = -3.0e38f, v2 = -3.0e38f, v3 = -3.0e38f; int i0 = 0, i1 = 0, i2 = 0, i3 = 0; \
        _Pragma("unroll") for (int e = 0; e < 32; ++e) { const float xx = LG[e]; const bool g0 = xx > v0, g1 = xx > v1, g2 = xx > v2, g3 = xx > v3; \
            v3 = g2 ? v2 : (g3 ? xx : v3); i3 = g2 ? i2 : (g3 ? e : i3); \
            v2 = g1 ? v1 : (g2 ? xx : v2); i2 = g1 ? i1 : (g2 ? e : i2); \
            v1 = g0 ? v0 : (g1 ? xx : v1); i1 = g0 ? i0 : (g1 ? e : i1); \
            v0 = g0 ? xx : v0; i0 = g0 ? e : i0; } \
        const float pe1 = __expf(v1 - v0), pe2 = __expf(v2 - v0), pe3 = __expf(v3 - v0); const float ps = (1.0f + pe1) + (pe2 + pe3); \
        if (lane < 4) { int e = i0; float g = 1.0f; \
            if (lane == 1) { e = i1; g = pe1; } if (lane == 2) { e = i2; g = pe2; } if (lane == 3) { e = i3; g = pe3; } \
            g = g / ps; \
            const int lpos = __hip_atomic_fetch_add(&hist[e], 1, __ATOMIC_RELAXED, __HIP_MEMORY_SCOPE_WORKGROUP); \
            LAS int* rc = rec + ((wave * 17 + nrec) * 4 + lane) * 4; rc[0] = (TOK); rc[1] = e; rc[2] = lpos; rc[3] = __builtin_bit_cast(int, g); } \
        ++nrec; } while (0)
__device__ __forceinline__ void ph_rowrouter(LAS unsigned char* lds, const RowP& p, int bid, int nblk) {
    LAS float* rw = (LAS float*)lds;
    LAS int* hist = (LAS int*)(lds + 131072); LAS int* base = hist + 32; LAS int* rec = (LAS int*)(lds + 131072 + 256);
    const int tid = PH_TID, lane = tid & 63, wave = tid >> 6;
    for (int i4 = tid; i4 < 1024 * 8; i4 += 512) { const int d = i4 >> 3, ec = i4 & 7; const int ln = (d & 255) >> 2, ii = d & 3, j = d >> 8;
        *(LAS f32x4*)(rw + (((j * 4 + ii) * 8 + ec) * 64 + ln) * 4) = *(const f32x4*)(p.router_w + (size_t)i4 * 4); }
    if (tid < 32) hist[tid] = 0;
    __syncthreads();
    const int gw = bid * 8 + wave, NGW = nblk * 8; int nrec = 0;
    const float rbias = p.router_b[lane & 31];
    for (int tokA = gw; tokA < NTOK; tokA += 2 * NGW) {
        const int tokB = tokA + NGW; const bool hasB = tokB < NTOK; const int tokBc = hasB ? tokB : tokA;
        f32x4 hA[4], hB[4];
        RR_ROW(hA, tokA, true);
        RR_ROW(hB, tokBc, hasB);
        const bool routeA = !(p.skip_ctx && (tokA % LT) < CTXL), routeB = hasB && !(p.skip_ctx && (tokBc % LT) < CTXL);
        if (!(routeA || routeB)) continue;
        const int le = lane & 31; float L = 0.f;
#pragma unroll
        for (int half = 0; half < 2; ++half) {
            typedef float f32x2 __attribute__((ext_vector_type(2)));
            f32x2 aA[8], aB[8];
#pragma unroll
            for (int e = 0; e < 8; ++e) { aA[e] = (f32x2){0.f, 0.f}; aB[e] = (f32x2){0.f, 0.f}; }
#pragma unroll
            for (int j = 0; j < 4; ++j)
#pragma unroll
                for (int ii = 0; ii < 4; ++ii) { const f32x2 ha = {hA[j][ii], hA[j][ii]}, hb = {hB[j][ii], hB[j][ii]};
#pragma unroll
                    for (int ec = 0; ec < 4; ++ec) { const f32x4 w = *(const LAS f32x4*)(rw + (((j * 4 + ii) * 8 + half * 4 + ec) * 64 + lane) * 4);
                        const f32x2 w01 = {w.x, w.y}, w23 = {w.z, w.w};
                        aA[ec * 2 + 0] = __builtin_elementwise_fma(ha, w01, aA[ec * 2 + 0]); aA[ec * 2 + 1] = __builtin_elementwise_fma(ha, w23, aA[ec * 2 + 1]);
                        aB[ec * 2 + 0] = __builtin_elementwise_fma(hb, w01, aB[ec * 2 + 0]); aB[ec * 2 + 1] = __builtin_elementwise_fma(hb, w23, aB[ec * 2 + 1]); } }
#pragma unroll
            for (int e = 0; e < 8; ++e) { const float s0 = wave_sum2v(aA[e].x, aB[e].x), s1 = wave_sum2v(aA[e].y, aB[e].y);
                L = le == half * 16 + 2 * e ? s0 : L; L = le == half * 16 + 2 * e + 1 ? s1 : L; }
        }
        L += rbias;
        float vk[4]; int iA[4], iB[4]; float wv = L;
#pragma unroll
        for (int k = 0; k < 4; ++k) { float m = wv; m = fmaxf(m, SWZ_XOR(m, 1)); m = fmaxf(m, SWZ_XOR(m, 2)); m = fmaxf(m, SWZ_XOR(m, 4)); m = fmaxf(m, SWZ_XOR(m, 8)); m = fmaxf(m, SWZ_XOR(m, 16));
            const unsigned long long bal = __builtin_amdgcn_ballot_w64(wv == m);
            iA[k] = __builtin_ctz((unsigned)bal); iB[k] = __builtin_ctz((unsigned)(bal >> 32)); vk[k] = m;
            wv = le == (lane < 32 ? iA[k] : iB[k]) ? -3.0e38f : wv; }
        const float pe1 = __expf(vk[1] - vk[0]), pe2 = __expf(vk[2] - vk[0]), pe3 = __expf(vk[3] - vk[0]); const float ps = (1.0f + pe1) + (pe2 + pe3);
        { const bool hiB = lane >= 32; const bool mine = hiB ? routeB : routeA; const int myrec = nrec + ((hiB && routeA) ? 1 : 0);
          if (le < 4 && mine) { int e = hiB ? iB[0] : iA[0]; float g = 1.0f;
              if (le == 1) { e = hiB ? iB[1] : iA[1]; g = pe1; } if (le == 2) { e = hiB ? iB[2] : iA[2]; g = pe2; } if (le == 3) { e = hiB ? iB[3] : iA[3]; g = pe3; }
              g = g / ps;
              const int lpos = __hip_atomic_fetch_add(&hist[e], 1, __ATOMIC_RELAXED, __HIP_MEMORY_SCOPE_WORKGROUP);
              LAS int* rc = rec + ((wave * 17 + myrec) * 4 + le) * 4; rc[0] = hiB ? tokB : tokA; rc[1] = e; rc[2] = lpos; rc[3] = __builtin_bit_cast(int, g); }
          nrec += (routeA ? 1 : 0) + (routeB ? 1 : 0); }
    }
    __syncthreads();
    if (tid < 32) base[tid] = atomicAdd(&p.cnt[tid], hist[tid]);
    __syncthreads();
    for (int i = lane; i < nrec * 4; i += 64) { const LAS int* rc = rec + (wave * 17 * 4 + i) * 4; const int tok = rc[0], e = rc[1], pos = base[e] + rc[2]; const int k = i & 3;
        int* ti = p.tokinfo_out + (tok * 4 + k) * 4; ti[0] = e; ti[1] = pos; ti[2] = rc[3]; ti[3] = 0;
        p.list[(size_t)e * NTOK + pos] = tok; }
}
#undef RR_ROW
#undef RR_FINISH
struct RetPostP { const float* P; const float* COSR; const float* SINR; bf16_t* Q; bf16_t* Kb; bf16_t* VT; bf16_t* GF; bf16_t* GB; };
__device__ __forceinline__ void ph_ret_post(const RetPostP& p, int bid, int nblk) {
    const int tid_ = PH_TID, lane = tid_ & 63, gw = bid * 8 + (tid_ >> 6), NGW = nblk * 8;
    for (int grp = gw; grp < NTOK / 8; grp += NGW) {
        const int tok0 = grp * 8, b = tok0 / LT, s0 = tok0 % LT; const bool isctx = s0 < CTXL;
        for (int i = 0; i < 8; ++i) {
            const int tok = tok0 + i; const float* pr = p.P + (size_t)tok * RIN; const int t = s0 + i - CTXL;
#pragma unroll
            for (int qk = 0; qk < 2; ++qk) {
                const float sc = qk ? 0.0625f : 1.0f; bf16_t* dst = (qk ? p.Kb : p.Q) + (size_t)tok * 1024;
#pragma unroll
                for (int h = 0; h < 4; ++h)
#pragma unroll
                    for (int jj = 0; jj < 2; ++jj) { const int d = lane + 64 * jj; const float x1 = pr[qk * 1024 + h * 256 + d] * sc, x2 = pr[qk * 1024 + h * 256 + 128 + d] * sc; float o1 = x1, o2 = x2;
                        if (!isctx) { const float c = p.COSR[(size_t)t * 128 + d], sn = p.SINR[(size_t)t * 128 + d]; o1 = x1 * c - x2 * sn; o2 = x1 * sn + x2 * c; }
                        dst[h * 256 + d] = (bf16_t)f2bf(o1); dst[h * 256 + 128 + d] = (bf16_t)f2bf(o2); }
            }
#pragma unroll
            for (int jj = 0; jj < 8; ++jj) { const int c4 = (lane + 64 * jj) * 4; const f32x4 gf = *(const f32x4*)(pr + 4096 + c4), gb = *(const f32x4*)(pr + 6144 + c4);
                u32x2 w; w.x = pk2(silu_f(gf.x), silu_f(gf.y)); w.y = pk2(silu_f(gf.z), silu_f(gf.w)); *(u32x2*)(p.GF + (size_t)tok * 2048 + c4) = w;
                w.x = pk2(silu_f(gb.x), silu_f(gb.y)); w.y = pk2(silu_f(gb.z), silu_f(gb.w)); *(u32x2*)(p.GB + (size_t)tok * 2048 + c4) = w; }
        }
        for (int jj = 0; jj < 32; ++jj) { const int col = lane + 64 * jj;
            float vv[8];
#pragma unroll
            for (int i = 0; i < 8; ++i) vv[i] = p.P[(size_t)(tok0 + i) * RIN + 2048 + col];
            u32x4 o; o.x = pk2(vv[0], vv[1]); o.y = pk2(vv[2], vv[3]); o.z = pk2(vv[4], vv[5]); o.w = pk2(vv[6], vv[7]);
            *(u32x4*)(p.VT + ((size_t)b * 2048 + col) * LT + s0) = o; }
    }
}
struct RetDecayP { const float* S; bf16_t* PF; bf16_t* PB; const float* logit; int h; };
__device__ __forceinline__ void ph_ret_decay(const RetDecayP& p, int bid, int nblk) {
    const float lf = -log1pf(expf(-p.logit[p.h])) * 1.4426950408889634f, lb = -log1pf(expf(-p.logit[4 + p.h])) * 1.4426950408889634f;
    const long n8 = (long)LT * (LT / 8);
    for (long i8 = bid * 512L + PH_TID; i8 < n8; i8 += nblk * 512L) {
        const int i = (int)(i8 / (LT / 8)), j0 = (int)(i8 % (LT / 8)) * 8; const int ibi = i < CTXL ? 255 - i : 8703 - i;
        const f32x4 s0 = *(const f32x4*)(p.S + (size_t)i * LT + j0), s1 = *(const f32x4*)(p.S + (size_t)i * LT + j0 + 4);
        float sv[8] = {s0.x, s0.y, s0.z, s0.w, s1.x, s1.y, s1.z, s1.w}; float f[8], bk[8];
#pragma unroll
        for (int q = 0; q < 8; ++q) { const int j = j0 + q; const int ibj = j < CTXL ? 255 - j : 8703 - j;
            f[q] = i >= j ? sv[q] * exp2f((float)(i - j) * lf) : 0.f; bk[q] = ibi >= ibj ? sv[q] * exp2f((float)(ibi - ibj) * lb) : 0.f; }
        u32x4 o; o.x = pk2(f[0], f[1]); o.y = pk2(f[2], f[3]); o.z = pk2(f[4], f[5]); o.w = pk2(f[6], f[7]); *(u32x4*)(p.PF + (size_t)i * LT + j0) = o;
        o.x = pk2(bk[0], bk[1]); o.y = pk2(bk[2], bk[3]); o.z = pk2(bk[4], bk[5]); o.w = pk2(bk[6], bk[7]); *(u32x4*)(p.PB + (size_t)i * LT + j0) = o;
    }
}
struct RetGateP { const float* OF; const float* OB; const bf16_t* GF; const bf16_t* GB; const float* gn; bf16_t* Y; };
__device__ __forceinline__ void ph_ret_gate(const RetGateP& p, int bid, int nblk) {
    const int tid_ = PH_TID, lane = tid_ & 63, gw = bid * 8 + (tid_ >> 6), NGW = nblk * 8;
    for (int tok = gw; tok < NTOK; tok += NGW) {
#pragma unroll
        for (int h = 0; h < 4; ++h) {
            const int c0 = h * 512 + lane * 8; float yo[8];
#pragma unroll
            for (int dir = 0; dir < 2; ++dir) {
                const float* o = (dir ? p.OB : p.OF) + (size_t)tok * 2048 + c0; const f32x4 a = *(const f32x4*)o, bq = *(const f32x4*)(o + 4);
                float v[8] = {a.x, a.y, a.z, a.w, bq.x, bq.y, bq.z, bq.w}; float sm = 0.f;
#pragma unroll
                for (int q = 0; q < 8; ++q) sm += v[q];
                const float mu = wave_sum(sm) * (1.0f / 512.0f); float sq = 0.f;
#pragma unroll
                for (int q = 0; q < 8; ++q) { v[q] -= mu; sq += v[q] * v[q]; }
                const float rstd = rsqrtf(wave_sum(sq) * (1.0f / 512.0f) + GN_EPS);
                const u32x4 gw4 = *(const u32x4*)((dir ? p.GB : p.GF) + (size_t)tok * 2048 + c0);
                const float g[8] = {bflo(gw4.x), bfhi(gw4.x), bflo(gw4.y), bfhi(gw4.y), bflo(gw4.z), bfhi(gw4.z), bflo(gw4.w), bfhi(gw4.w)};
                const float* gnp = p.gn + dir * 2048 + c0;
#pragma unroll
                for (int q = 0; q < 8; ++q) { const float t = g[q] * (v[q] * rstd * gnp[q]); yo[q] = dir ? yo[q] + t : t; }
            }
            u32x4 o; o.x = pk2(yo[0], yo[1]); o.y = pk2(yo[2], yo[3]); o.z = pk2(yo[4], yo[5]); o.w = pk2(yo[6], yo[7]);
            *(u32x4*)(p.Y + (size_t)tok * 2048 + c0) = o;
        }
    }
}
struct MlaPostP { const float* P; const float* qn; const float* kvn; const float* COSM; const float* SINM; bf16_t* CQ; bf16_t* CKV; float* KR; };
__device__ __forceinline__ void ph_mla_post(const MlaPostP& p, int bid, int nblk) {
    const int tid_ = PH_TID, lane = tid_ & 63, gw = bid * 8 + (tid_ >> 6), NGW = nblk * 8;
    for (int tok = gw; tok < NTOK; tok += NGW) {
        const float* pr = p.P + (size_t)tok * MINP; const int s = tok % LT; const bool isctx = s < CTXL; const int t = s - CTXL;
        float q[6], ss = 0.f;
#pragma unroll
        for (int i = 0; i < 6; ++i) { q[i] = pr[lane + 64 * i]; ss += q[i] * q[i]; }
        float r = rsqrtf(wave_sum(ss) * (1.0f / 384.0f) + EPS);
#pragma unroll
        for (int i = 0; i < 6; ++i) p.CQ[(size_t)tok * 384 + lane + 64 * i] = (bf16_t)f2bf(q[i] * r * p.qn[lane + 64 * i]);
        float kv[4]; ss = 0.f;
#pragma unroll
        for (int i = 0; i < 4; ++i) { kv[i] = pr[384 + lane + 64 * i]; ss += kv[i] * kv[i]; }
        r = rsqrtf(wave_sum(ss) * (1.0f / 256.0f) + EPS);
#pragma unroll
        for (int i = 0; i < 4; ++i) p.CKV[(size_t)tok * 256 + lane + 64 * i] = (bf16_t)f2bf(kv[i] * r * p.kvn[lane + 64 * i]);
        if (lane < 32) { const float x1 = pr[640 + lane], x2 = pr[672 + lane]; float o1 = x1, o2 = x2;
            if (!isctx) { const float c = p.COSM[(size_t)t * 32 + lane], sn = p.SINM[(size_t)t * 32 + lane]; o1 = x1 * c - x2 * sn; o2 = x1 * sn + x2 * c; }
            p.KR[(size_t)tok * 64 + lane] = o1; p.KR[(size_t)tok * 64 + 32 + lane] = o2; }
    }
}
struct MlaBuildP { const float* QF; const float* KVF; const float* KR; const float* COSM; const float* SINM; bf16_t* Qp; bf16_t* Kp; bf16_t* VT; };
__device__ __forceinline__ void ph_mla_build(const MlaBuildP& p, int bid, int nblk) {
    const int tid_ = PH_TID, lane = tid_ & 63, gw = bid * 8 + (tid_ >> 6), NGW = nblk * 8;
    for (int grp = gw; grp < NTOK / 8; grp += NGW) {
        const int tok0 = grp * 8, b = tok0 / LT, s0 = tok0 % LT; const bool isctx = s0 < CTXL;
        for (int i = 0; i < 8; ++i) {
            const int tok = tok0 + i, t = s0 + i - CTXL; const float* qf = p.QF + (size_t)tok * 1536; const float* kvf = p.KVF + (size_t)tok * 2048; const float* kr = p.KR + (size_t)tok * 64;
#pragma unroll
            for (int h = 0; h < 8; ++h) {
                bf16_t* qd = p.Qp + (size_t)tok * 2048 + h * 256; bf16_t* kd = p.Kp + (size_t)tok * 2048 + h * 256;
                qd[lane] = (bf16_t)f2bf(qf[h * 192 + lane]); qd[64 + lane] = (bf16_t)f2bf(qf[h * 192 + 64 + lane]);
                { const int ii = lane & 31; const float x1 = qf[h * 192 + 128 + ii], x2 = qf[h * 192 + 160 + ii]; float o1 = x1, o2 = x2;
                  if (!isctx) { const float c = p.COSM[(size_t)t * 32 + ii], sn = p.SINM[(size_t)t * 32 + ii]; o1 = x1 * c - x2 * sn; o2 = x1 * sn + x2 * c; }
                  qd[128 + lane] = (bf16_t)f2bf(lane < 32 ? o1 : o2); }
                qd[192 + lane] = 0;
                kd[lane] = (bf16_t)f2bf(kvf[h * 256 + lane]); kd[64 + lane] = (bf16_t)f2bf(kvf[h * 256 + 64 + lane]);
                kd[128 + lane] = (bf16_t)f2bf(kr[lane]); kd[192 + lane] = 0;
            }
        }
        for (int jj = 0; jj < 16; ++jj) { const int col = lane + 64 * jj; const int h = col >> 7, dv = col & 127;
            float vv[8];
#pragma unroll
            for (int i = 0; i < 8; ++i) vv[i] = p.KVF[(size_t)(tok0 + i) * 2048 + h * 256 + 128 + dv];
            u32x4 o; o.x = pk2(vv[0], vv[1]); o.y = pk2(vv[2], vv[3]); o.z = pk2(vv[4], vv[5]); o.w = pk2(vv[6], vv[7]);
            *(u32x4*)(p.VT + (((size_t)b * 8 + h) * 256 + dv) * LT + s0) = o; }
    }
}
__device__ __forceinline__ void ph_softmax(const float* S, bf16_t* P, int M, int N, int ldsm, int ldp, float scale, int bid, int nblk) {
    const int tid_ = PH_TID, lane = tid_ & 63, gw = bid * 8 + (tid_ >> 6), NGW = nblk * 8;
    const float c = scale * 1.4426950408889634f;
    for (int r = gw; r < M; r += NGW) {
        const float* sr = S + (size_t)r * ldsm; float mx = -3.0e38f;
        for (int j = lane * 4; j < N; j += 256) { const f32x4 v = *(const f32x4*)(sr + j); mx = fmaxf(fmaxf(mx, fmaxf(v.x, v.y)), fmaxf(v.z, v.w)); }
        mx = wave_max(mx); float sm = 0.f;
        for (int j = lane * 4; j < N; j += 256) { const f32x4 v = *(const f32x4*)(sr + j); sm += exp2f((v.x - mx) * c) + exp2f((v.y - mx) * c) + exp2f((v.z - mx) * c) + exp2f((v.w - mx) * c); }
        const float inv = 1.0f / wave_sum(sm);
        for (int j = lane * 4; j < N; j += 256) { const f32x4 v = *(const f32x4*)(sr + j); u32x2 w; w.x = pk2(exp2f((v.x - mx) * c) * inv, exp2f((v.y - mx) * c) * inv); w.y = pk2(exp2f((v.z - mx) * c) * inv, exp2f((v.w - mx) * c) * inv);
            *(u32x2*)(P + (size_t)r * ldp + j) = w; }
    }
}
__device__ __forceinline__ void ph_mla_opack(const float* OFm, bf16_t* O, int bid, int nblk) {
    for (long i = bid * 512L + PH_TID; i < (long)NTOK * 256; i += nblk * 512L) { const long tok = i >> 8; const int c4 = (int)(i & 255) * 4; const int h = c4 >> 7, dv = c4 & 127;
        const f32x4 v = *(const f32x4*)(OFm + tok * 2048 + h * 256 + dv); u32x2 w; w.x = pk2(v.x, v.y); w.y = pk2(v.z, v.w); *(u32x2*)(O + tok * 1024 + c4) = w; }
}
__device__ __forceinline__ void ph_moe_plan(const int* cnt, int* plan, int bid, int nblk) {
    if (PH_TID == 0 && bid == 0) { int off = 0, nt = 0;
        for (int e = 0; e < NE; ++e) { const int c = cnt[e]; plan[e] = off; plan[32 + e] = c; const int tl = (c + 255) / 256; for (int q = 0; q < tl; ++q) plan[128 + nt + q] = e; nt += tl; off += tl * 256; }
        plan[64] = nt; }
}
__device__ __forceinline__ void ph_moe_gather(const bf16_t* H, const int* plan, const int* list, bf16_t* AP, int bid, int nblk) {
    const int tid_ = PH_TID, lane = tid_ & 63, gw = bid * 8 + (tid_ >> 6), NGW = nblk * 8; const int nrows = plan[64] * 256;
    for (int r = gw; r < nrows; r += NGW) { const int e = plan[128 + (r >> 8)], pos = r - plan[e]; u32x4 a = {0, 0, 0, 0}, bq = {0, 0, 0, 0};
        if (pos < plan[32 + e]) { const int tok = list[(size_t)e * NTOK + pos]; a = *(const u32x4*)(H + (size_t)tok * D + lane * 8); bq = *(const u32x4*)(H + (size_t)tok * D + 512 + lane * 8); }
        *(u32x4*)(AP + (size_t)r * D + lane * 8) = a; *(u32x4*)(AP + (size_t)r * D + 512 + lane * 8) = bq; }
}
__device__ __forceinline__ void ph_moe_act(const float* U, const int* plan, bf16_t* ACT, int bid, int nblk) {
    const long n = (long)plan[64] * 256 * 256;
    for (long i = bid * 512L + PH_TID; i < n; i += nblk * 512L) { const long r = i >> 8; const int c4 = (int)(i & 255) * 4;
        const f32x4 g = *(const f32x4*)(U + r * 2048 + c4), l = *(const f32x4*)(U + r * 2048 + 1024 + c4); float o[4];
#pragma unroll
        for (int q = 0; q < 4; ++q) { const float gl = fminf(g[q], 7.0f), ln = fminf(fmaxf(l[q], -7.0f), 7.0f); o[q] = gl / (1.0f + __expf(-1.702f * gl)) * (ln + 1.0f); }
        u32x2 w; w.x = pk2(o[0], o[1]); w.y = pk2(o[2], o[3]); *(u32x2*)(ACT + r * 1024 + c4) = w; }
}

struct MlaBuild2P { const float* QF; const float* KVF; const float* KR; const float* COSM; const float* SINM; bf16_t* Qh; bf16_t* Kh; bf16_t* Vh; };
__device__ __forceinline__ void ph_mla_build2(const MlaBuild2P& p, int bid, int nblk) {
    const int tid_ = PH_TID, lane = tid_ & 63, gw = bid * 8 + (tid_ >> 6), NGW = nblk * 8;
    for (int tok = gw; tok < NTOK; tok += NGW) {
        const int s = tok % LT; const bool isctx = s < CTXL; const int t = s - CTXL;
        const float* qf = p.QF + (size_t)tok * 1536; const float* kvf = p.KVF + (size_t)tok * 2048; const float* kr = p.KR + (size_t)tok * 64;
#pragma unroll
        for (int h = 0; h < 8; ++h) {
            bf16_t* qd = p.Qh + (size_t)tok * 1536 + h * 192; bf16_t* kd = p.Kh + (size_t)tok * 1536 + h * 192; bf16_t* vd = p.Vh + (size_t)tok * 1024 + h * 128;
            qd[lane] = (bf16_t)f2bf(qf[h * 192 + lane]); qd[64 + lane] = (bf16_t)f2bf(qf[h * 192 + 64 + lane]);
            { const int ii = lane & 31; const float x1 = qf[h * 192 + 128 + ii], x2 = qf[h * 192 + 160 + ii]; float o1 = x1, o2 = x2;
              if (!isctx) { const float c = p.COSM[(size_t)t * 32 + ii], sn = p.SINM[(size_t)t * 32 + ii]; o1 = x1 * c - x2 * sn; o2 = x1 * sn + x2 * c; }
              qd[128 + lane] = (bf16_t)f2bf(lane < 32 ? o1 : o2); }
            kd[lane] = (bf16_t)f2bf(kvf[h * 256 + lane]); kd[64 + lane] = (bf16_t)f2bf(kvf[h * 256 + 64 + lane]); kd[128 + lane] = (bf16_t)f2bf(kr[lane]);
            vd[lane] = (bf16_t)f2bf(kvf[h * 256 + 128 + lane]); vd[64 + lane] = (bf16_t)f2bf(kvf[h * 256 + 192 + lane]);
        }
    }
}

struct MlaPost2P { const float* P; const float* qn; const float* kvn; const float* COSM; const float* SINM; bf16_t* CQ; bf16_t* CKV; unsigned char* Kh; };
__device__ __forceinline__ void ph_mla_post2(const MlaPost2P& p, int bid, int nblk) {
    const int tid_ = PH_TID, lane = tid_ & 63, gw = bid * 8 + (tid_ >> 6), NGW = nblk * 8;
    const bool lo32 = lane < 32; const int g = lane & 15, hq = lane >> 4, idx0 = 4 * (g & 7); const bool first = g < 8;
    const f32x4 qnA = *(const f32x4*)(p.qn + 4 * lane), qnB = lo32 ? *(const f32x4*)(p.qn + 256 + 4 * lane) : (f32x4){0.f, 0.f, 0.f, 0.f}, kvnA = *(const f32x4*)(p.kvn + 4 * lane);
    for (int tok = gw; tok < NTOK; tok += NGW) {
        const float* pr = p.P + (size_t)tok * MINP; const int s = tok % LT; const bool isctx = s < CTXL; const int t = s - CTXL;
        const f32x4 qa = *(const f32x4*)(pr + 4 * lane), qb = lo32 ? *(const f32x4*)(pr + 256 + 4 * lane) : (f32x4){0.f, 0.f, 0.f, 0.f}, ka = *(const f32x4*)(pr + 384 + 4 * lane);
        const f32x4 x1v = *(const f32x4*)(pr + 640 + idx0), x2v = *(const f32x4*)(pr + 672 + idx0);
        f32x4 cv = {1.f, 1.f, 1.f, 1.f}, sv = {0.f, 0.f, 0.f, 0.f};
        if (!isctx) { cv = *(const f32x4*)(p.COSM + (size_t)t * 32 + idx0); sv = *(const f32x4*)(p.SINM + (size_t)t * 32 + idx0); }
        const float ssq = ((qa.x * qa.x + qa.y * qa.y) + (qa.z * qa.z + qa.w * qa.w)) + ((qb.x * qb.x + qb.y * qb.y) + (qb.z * qb.z + qb.w * qb.w));
        const float ssk = (ka.x * ka.x + ka.y * ka.y) + (ka.z * ka.z + ka.w * ka.w);
        float tq, tk; wave_sum2(ssq, ssk, tq, tk);
        const float rq = rsqrtf(tq * (1.0f / 384.0f) + EPS), rk = rsqrtf(tk * (1.0f / 256.0f) + EPS);
        { const f32x4 o = qa * rq * qnA; u32x2 w; w.x = pk2(o.x, o.y); w.y = pk2(o.z, o.w); *(u32x2*)(p.CQ + (size_t)tok * 384 + 4 * lane) = w; }
        if (lo32) { const f32x4 o = qb * rq * qnB; u32x2 w; w.x = pk2(o.x, o.y); w.y = pk2(o.z, o.w); *(u32x2*)(p.CQ + (size_t)tok * 384 + 256 + 4 * lane) = w; }
        { const f32x4 o = ka * rk * kvnA; u32x2 w; w.x = pk2(o.x, o.y); w.y = pk2(o.z, o.w); *(u32x2*)(p.CKV + (size_t)tok * 256 + 4 * lane) = w; }
        { const f32x4 o = first ? x1v * cv - x2v * sv : x1v * sv + x2v * cv; const unsigned w = pk4_fp8(o.x, o.y, o.z, o.w);
          unsigned char* kb = p.Kh + (size_t)tok * 1536 + 128 + 4 * g;
          *(unsigned*)(kb + hq * 192) = w; *(unsigned*)(kb + (hq + 4) * 192) = w; }
    }
}

__device__ __forceinline__ void ph_moe_plan_gather(LAS unsigned char* lds, const int* cnt, int* plan_g, const bf16_t* H, const int* list, bf16_t* AP, int bid, int nblk) {
    LAS int* pl = (LAS int*)lds;
    const int tid_ = PH_TID, lane = tid_ & 63, gw = bid * 8 + (tid_ >> 6), NGW = nblk * 8;
    if (tid_ == 0) { int off = 0, nt = 0;
        for (int e = 0; e < NE; ++e) { const int c = cnt[e]; pl[e] = off; pl[32 + e] = c; const int tl = (c + 255) / 256; for (int q = 0; q < tl; ++q) pl[128 + nt + q] = e; nt += tl; off += tl * 256; }
        pl[64] = nt; }
    __syncthreads();
    if (bid == 0) for (int i = tid_; i < 128 + MAXTILES; i += 512) plan_g[i] = pl[i];
    const int nrows = pl[64] * 256;
    for (int r = gw; r < nrows; r += NGW) { const int e = pl[128 + (r >> 8)], pos = r - pl[e]; u32x4 a = {0, 0, 0, 0}, bq = {0, 0, 0, 0};
        if (pos < pl[32 + e]) { const int tok = list[(size_t)e * NTOK + pos]; a = *(const u32x4*)(H + (size_t)tok * D + lane * 8); bq = *(const u32x4*)(H + (size_t)tok * D + 512 + lane * 8); }
        *(u32x4*)(AP + (size_t)r * D + lane * 8) = a; *(u32x4*)(AP + (size_t)r * D + 512 + lane * 8) = bq; }
    __syncthreads();
}

constexpr int LDS_PLAN = 151552;
__device__ __forceinline__ void moe_plan_local(LAS unsigned char* lds, const int* cnt, int* plan_g, int bid) {
    LAS int* pl = (LAS int*)(lds + LDS_PLAN); LAS int* ts = pl + 704;
    const int tid = PH_TID;
    if (tid < 32) pl[32 + tid] = cnt[tid];
    __syncthreads();
    if (tid == 0) { int nt = 0; for (int e = 0; e < NE; ++e) { ts[e] = nt; nt += (pl[32 + e] + 255) / 256; } ts[32] = nt; pl[64] = nt; }
    __syncthreads();
    if (tid < 32) pl[tid] = ts[tid] * 256;
    for (int t = tid; t < ts[32]; t += 512) { int e = 0;
#pragma unroll
        for (int q = 1; q < 32; ++q) e += (ts[q] <= t) ? 1 : 0;
        pl[128 + t] = e; }
    __syncthreads();
    if (bid == 0) for (int i = tid; i < 128 + MAXTILES; i += 512) plan_g[i] = pl[i];
}
namespace att {
typedef short s16x4 __attribute__((ext_vector_type(4)));
typedef float f32x16 __attribute__((ext_vector_type(16)));
constexpr int QBLK = 32, KVBLK = 64, NW = 8, DQK = 192, DV = 128;
constexpr int LDQ = 8 * DQK, LDK = 8 * DQK, LDV = 8 * DV, LDO = 8 * DV;
constexpr float SCALE = 0.07216878364870322f, THR = 8.f;
constexpr int SHM_V = KVBLK * DV * 2, SHM_K = KVBLK * DQK, NRING = 4, LDS_K = 0, LDS_V = NRING * SHM_K, LDS_WS = LDS_V + NRING * SHM_V, LDS_ATT = LDS_WS + NW * 64 * 4;
#define KSWZ8(row, ch8) ((row) * 192 + ((((ch8)) ^ (((row) >> 2) & 7)) << 3))
#define SBAR() __builtin_amdgcn_sched_barrier(0)
__device__ __forceinline__ int crow(int r, int hi) { return (r & 3) + 8 * (r >> 2) + 4 * hi; }
__device__ __forceinline__ unsigned cvtpk(float lo, float hi) { unsigned r; asm volatile("v_cvt_pk_bf16_f32 %0, %1, %2" : "=v"(r) : "v"(lo), "v"(hi)); return r; }
__device__ __forceinline__ void partialSM(f32x16& p0, f32x16& p1, float& m_reg, float& mn, float& alpha) {
  constexpr float C = SCALE * 1.4426950408889634f;
  float pmax = p0[0];
#pragma unroll
  for (int r = 1; r < 16; ++r) pmax = fmaxf(pmax, p0[r]);
#pragma unroll
  for (int r = 0; r < 16; ++r) pmax = fmaxf(pmax, p1[r]);
  { unsigned y_ = __float_as_uint(pmax); asm volatile("" : "+v"(y_)); auto rr = __builtin_amdgcn_permlane32_swap(__float_as_uint(pmax), y_, false, false); pmax = fmaxf(__uint_as_float(rr[0]), __uint_as_float(rr[1])); }
  if (__builtin_expect(__all(pmax - m_reg <= THR / SCALE), 1)) { mn = m_reg; alpha = 1.f; }
  else { mn = fmaxf(m_reg, pmax); alpha = __builtin_amdgcn_exp2f((m_reg - mn) * C); m_reg = mn; }
  const float mnC = -mn * C;
#pragma unroll
  for (int r = 0; r < 16; ++r) p0[r] = fmaf(p0[r], C, mnC);
#pragma unroll
  for (int r = 0; r < 16; ++r) p1[r] = fmaf(p1[r], C, mnC);
#pragma unroll
  for (int r = 0; r < 16; ++r) p0[r] = __builtin_amdgcn_exp2f(p0[r]);
}
__device__ __forceinline__ void finishSM(f32x16& p0, f32x16& p1, float alpha, float& l_reg, bf16x8& pa0, bf16x8& pa1, bf16x8& pa2, bf16x8& pa3) {
#pragma unroll
  for (int r = 0; r < 16; ++r) p1[r] = __builtin_amdgcn_exp2f(p1[r]);
  float ps = 0;
#pragma unroll
  for (int r = 0; r < 16; ++r) ps += p0[r];
#pragma unroll
  for (int r = 0; r < 16; ++r) ps += p1[r];
  { unsigned y_ = __float_as_uint(ps); asm volatile("" : "+v"(y_)); auto rr = __builtin_amdgcn_permlane32_swap(__float_as_uint(ps), y_, false, false); ps = __uint_as_float(rr[0]) + __uint_as_float(rr[1]); }
  l_reg = l_reg * alpha + ps;
#define PK4(P, BASE, OUT) do { unsigned a0 = cvtpk(P[BASE + 0], P[BASE + 1]), a1 = cvtpk(P[BASE + 2], P[BASE + 3]);   \
    unsigned b0 = cvtpk(P[BASE + 4], P[BASE + 5]), b1 = cvtpk(P[BASE + 6], P[BASE + 7]);                              \
    auto r0 = __builtin_amdgcn_permlane32_swap(a0, b0, false, false); auto r1 = __builtin_amdgcn_permlane32_swap(a1, b1, false, false); \
    u32x4 w = {r0[0], r1[0], r0[1], r1[1]}; OUT = __builtin_bit_cast(bf16x8, w); } while (0)
  PK4(p0, 0, pa0); PK4(p0, 8, pa1); PK4(p1, 0, pa2); PK4(p1, 8, pa3);
#undef PK4
}
typedef int i32x2 __attribute__((ext_vector_type(2)));
template <int OFF> __device__ __forceinline__ i32x2 k_read(int addr) { i32x2 r; asm volatile("ds_read_b64 %0, %1 offset:%2" : "=v"(r) : "v"(addr), "i"(OFF)); return r; }
#define KQ_WAIT(n, A, B) asm volatile("s_waitcnt lgkmcnt(" #n ")" : "+v"(A[0]), "+v"(A[1]), "+v"(A[2]), "+v"(A[3]), "+v"(B[0]), "+v"(B[1]), "+v"(B[2]), "+v"(B[3]))
template <int KB> __device__ __forceinline__ void qkt(f32x16& p0, f32x16& p1, const int* kad, const pg8::i32x8* qr) {
  p0 = f32x16{}; p1 = f32x16{};
  i32x2 a[2][4], b[2][4];
#define KQ_RD(bf, i) do { _Pragma("unroll") for (int d = 0; d < 4; ++d) { a[bf][d] = k_read<KB * SHM_K>(kad[(i) * 4 + d]); b[bf][d] = k_read<KB * SHM_K + 32 * 192>(kad[(i) * 4 + d]); } } while (0)
#define KQ_MM(bf, i) do { const pg8::i32x8 a0 = {a[bf][0].x, a[bf][0].y, a[bf][1].x, a[bf][1].y, a[bf][2].x, a[bf][2].y, a[bf][3].x, a[bf][3].y}, a1 = {b[bf][0].x, b[bf][0].y, b[bf][1].x, b[bf][1].y, b[bf][2].x, b[bf][2].y, b[bf][3].x, b[bf][3].y}; \
    p0 = __builtin_amdgcn_mfma_scale_f32_32x32x64_f8f6f4(a0, qr[i], p0, 0, 0, 0, 0, 0, 0); p1 = __builtin_amdgcn_mfma_scale_f32_32x32x64_f8f6f4(a1, qr[i], p1, 0, 0, 0, 0, 0, 0); } while (0)
  KQ_RD(0, 0); KQ_RD(1, 1);
  KQ_WAIT(8, a[0], b[0]); KQ_MM(0, 0);
  KQ_RD(0, 2);
  KQ_WAIT(8, a[1], b[1]); KQ_MM(1, 1);
  KQ_WAIT(0, a[0], b[0]); KQ_MM(0, 2);
#undef KQ_RD
#undef KQ_MM
}
#undef KQ_WAIT
__device__ __forceinline__ int v_st(int k, int c) { const int kk = (k & ~0xC) | ((k & 4) << 1) | ((k & 8) >> 1); return ((kk >> 3) * 4 + (c >> 5)) * 512 + ((kk & 7) * 32 + (c & 31)) * 2; }
__device__ __forceinline__ int v_rd_base(int lane) { return ((lane & 3) << 3) | (((lane >> 2) & 3) << 6) | (((lane >> 4) & 1) << 5) | (((lane >> 5) & 1) << 8); }
constexpr int v_rd_off(int d0, int ks, int half) { return d0 * 512 + ks * 4096 + half * 2048; }
template <int OFF> __device__ __forceinline__ s16x4 tr_read(int vb) { s16x4 r; asm volatile("ds_read_b64_tr_b16 %0, %1 offset:%2" : "=&v"(r) : "v"(vb), "i"(OFF) : "memory"); return r; }
template <int D0, int VB> __device__ __forceinline__ void pv_one(f32x16& od, int vb, bf16x8 pa0, bf16x8 pa1, bf16x8 pa2, bf16x8 pa3) {
  constexpr int B = VB * SHM_V;
  const s16x4 l0 = tr_read<B + v_rd_off(D0, 0, 0)>(vb), h0 = tr_read<B + v_rd_off(D0, 0, 1)>(vb), l1 = tr_read<B + v_rd_off(D0, 1, 0)>(vb), h1 = tr_read<B + v_rd_off(D0, 1, 1)>(vb);
  const s16x4 l2 = tr_read<B + v_rd_off(D0, 2, 0)>(vb), h2 = tr_read<B + v_rd_off(D0, 2, 1)>(vb), l3 = tr_read<B + v_rd_off(D0, 3, 0)>(vb), h3 = tr_read<B + v_rd_off(D0, 3, 1)>(vb);
  asm volatile("s_waitcnt lgkmcnt(0)" ::: "memory"); SBAR();
#define PK(L, H) (bf16x8){L[0], L[1], L[2], L[3], H[0], H[1], H[2], H[3]}
  od = __builtin_amdgcn_mfma_f32_32x32x16_bf16(PK(l0, h0), pa0, od, 0, 0, 0);
  od = __builtin_amdgcn_mfma_f32_32x32x16_bf16(PK(l1, h1), pa1, od, 0, 0, 0);
  od = __builtin_amdgcn_mfma_f32_32x32x16_bf16(PK(l2, h2), pa2, od, 0, 0, 0);
  od = __builtin_amdgcn_mfma_f32_32x32x16_bf16(PK(l3, h3), pa3, od, 0, 0, 0);
#undef PK
}
template <int VB> __device__ __forceinline__ void pv_d0(f32x16* o, int vb, bf16x8 pa0, bf16x8 pa1, bf16x8 pa2, bf16x8 pa3) {
  pv_one<0, VB>(o[0], vb, pa0, pa1, pa2, pa3); pv_one<1, VB>(o[1], vb, pa0, pa1, pa2, pa3); pv_one<2, VB>(o[2], vb, pa0, pa1, pa2, pa3); pv_one<3, VB>(o[3], vb, pa0, pa1, pa2, pa3);
}
__device__ __forceinline__ void attn_unit(const unsigned char* __restrict__ Qb, const unsigned char* __restrict__ Kh, const bf16_t* __restrict__ Vh, bf16_t* __restrict__ Ob, int seq, LAS unsigned char* lds) {
  const int tid = ph_tid(), wid = tid >> 6, lane = tid & 63, r32 = lane & 31, hi = lane >> 5;
  LAS unsigned char* V_lds = lds + LDS_V; LAS unsigned char* K_lds = lds + LDS_K;
  LAS float* wsf = (LAS float*)(lds + LDS_WS) + wid * 64; LAS float* li_l = wsf; LAS float* al_l = wsf + 32;
  float m_reg = -1e30f, l_reg = 0; f32x16 o[4] = {}; pg8::i32x8 qr[3];
  const unsigned char* Qw = Qb + (long)(wid * QBLK + r32) * LDQ + hi * 8;
#pragma unroll
  for (int i = 0; i < 3; ++i) { typedef int i32x2 __attribute__((ext_vector_type(2))); i32x2 q[4];
#pragma unroll
    for (int d = 0; d < 4; ++d) q[d] = *(const GAS i32x2*)(Qw + (i * 4 + d) * 16);
    qr[i] = (pg8::i32x8){q[0].x, q[0].y, q[1].x, q[1].y, q[2].x, q[2].y, q[3].x, q[3].y}; }
  const int sr = tid >> 4, sc = (tid & 15) * 8, vst0 = v_st(sr, sc);
  const int kr0 = tid / 12, kc0 = tid % 12, kr1 = (tid + 512) / 12, kc1 = (tid + 512) % 12; const bool k2 = tid < 256;
  const int kg0 = kr0 * LDK + kc0 * 16, kg1 = kr1 * LDK + kc1 * 16;
  const int kw0a = KSWZ8(kr0, 2 * kc0), kw0b = KSWZ8(kr0, 2 * kc0 + 1), kw1a = KSWZ8(kr1, 2 * kc1), kw1b = KSWZ8(kr1, 2 * kc1 + 1);
  const int vb0 = (int)(unsigned long long)V_lds + v_rd_base(lane);
  int kad[12];
#pragma unroll
  for (int j = 0; j < 12; ++j) kad[j] = (int)(unsigned long long)K_lds + KSWZ8(r32, j * 2 + hi);
  LAS unsigned char* Vw = V_lds + vst0; LAS unsigned char* Kwa0 = K_lds + kw0a; LAS unsigned char* Kwb0 = K_lds + kw0b; LAS unsigned char* Kwa1 = K_lds + kw1a; LAS unsigned char* Kwb1 = K_lds + kw1b;
  asm volatile("" : "+v"(Vw), "+v"(Kwa0), "+v"(Kwb0), "+v"(Kwa1), "+v"(Kwb1));
  const int kg1c = k2 ? kg1 : kg0;
  bf16x8 vs0E, vs1E, vs0O, vs1O; u32x4 ks0E, ks1E, ks0O, ks1O;
#define SLOAD(S, k0) do { vs0##S = *(const GAS bf16x8*)(&Vh[(long)((k0) + sr) * LDV + sc]); vs1##S = *(const GAS bf16x8*)(&Vh[(long)((k0) + 32 + sr) * LDV + sc]); \
    ks0##S = *(const GAS u32x4*)(Kh + (long)(k0) * LDK + kg0); ks1##S = *(const GAS u32x4*)(Kh + (long)(k0) * LDK + kg1c); } while (0)
#define SWRITE(b, S) do { *(LAS bf16x8*)(Vw + (b) * SHM_V) = vs0##S; *(LAS bf16x8*)(Vw + (b) * SHM_V + 8192) = vs1##S; \
    *(LAS u32x2*)(Kwa0 + (b) * SHM_K) = (u32x2){ks0##S.x, ks0##S.y}; *(LAS u32x2*)(Kwb0 + (b) * SHM_K) = (u32x2){ks0##S.z, ks0##S.w}; \
    if (k2) { *(LAS u32x2*)(Kwa1 + (b) * SHM_K) = (u32x2){ks1##S.x, ks1##S.y}; *(LAS u32x2*)(Kwb1 + (b) * SHM_K) = (u32x2){ks1##S.z, ks1##S.w}; } } while (0)
#define SWAIT() asm volatile("s_waitcnt vmcnt(4)" ::: "memory")
#define RESC(a) do { if (__any((a) < 1.f)) { \
    _Pragma("unroll") for (int d = 0; d < 4; ++d) _Pragma("unroll") for (int r = 0; r < 16; ++r) o[d][r] *= (a); } } while (0)
  f32x16 pA0, pA1, pB0, pB1; float mnA, mnB, alA, alB; bf16x8 pa0, pa1, pa2, pa3; const int NT = seq / KVBLK;
  if (__builtin_amdgcn_readfirstlane(wid) >= 4) __builtin_amdgcn_s_setprio(1);
#define TSTEP(PX0, PX1, MNX, ALX, PY0, PY1, ALY, KB, VB, WB, SL, SW, jj, LD, WR) do { \
    SBAR(); qkt<KB>(PX0, PX1, kad, qr); \
    finishSM(PY0, PY1, ALY, l_reg, pa0, pa1, pa2, pa3); SBAR(); \
    if (LD) SLOAD(SL, ((jj) + 3) * KVBLK); SBAR(); \
    pv_d0<VB>(o, vb0, pa0, pa1, pa2, pa3); partialSM(PX0, PX1, m_reg, MNX, ALX); \
    if (WR) { if (LD) SWAIT(); SWRITE(WB, SW); } \
    RESC(ALX); } while (0)
#define TODD(KB, VB, WB, jj, LD, WR) TSTEP(pB0, pB1, mnB, alB, pA0, pA1, alA, KB, VB, WB, E, O, jj, LD, WR)
#define TEVEN(KB, VB, WB, jj, LD, WR) TSTEP(pA0, pA1, mnA, alA, pB0, pB1, alB, KB, VB, WB, O, E, jj, LD, WR)
  SLOAD(E, 0); asm volatile("s_waitcnt vmcnt(0)" ::: "memory"); SWRITE(0, E);
  SLOAD(O, KVBLK); SLOAD(E, 2 * KVBLK);
  SWAIT(); SWRITE(1, O); __syncthreads();
  qkt<0>(pA0, pA1, kad, qr); partialSM(pA0, pA1, m_reg, mnA, alA);
  SLOAD(O, 3 * KVBLK);
  SWAIT(); SWRITE(2, E); __syncthreads();
  int j = 1;
  for (; j + 4 < NT; j += 4) {
    TODD(1, 0, 3, j, true, true); __syncthreads();
    TEVEN(2, 1, 0, j + 1, true, true); __syncthreads();
    TODD(3, 2, 1, j + 2, true, true); __syncthreads();
    TEVEN(0, 3, 2, j + 3, true, true); __syncthreads();
  }
  TODD(1, 0, 3, j, false, true); __syncthreads();
  TEVEN(2, 1, 0, j + 1, false, false); __syncthreads();
  SBAR(); qkt<3>(pB0, pB1, kad, qr);
  finishSM(pA0, pA1, alA, l_reg, pa0, pa1, pa2, pa3); SBAR();
  pv_d0<2>(o, vb0, pa0, pa1, pa2, pa3); partialSM(pB0, pB1, m_reg, mnB, alB);
  RESC(alB);
  finishSM(pB0, pB1, alB, l_reg, pa0, pa1, pa2, pa3); SBAR();
  pv_d0<3>(o, vb0, pa0, pa1, pa2, pa3);
#undef TSTEP
#undef TODD
#undef TEVEN
  __builtin_amdgcn_s_setprio(0);
  { const int te = ph_tid(), wide = te >> 6, r32e = te & 31, hie = (te >> 5) & 1; const float rl = __builtin_amdgcn_rcpf(l_reg);
    bf16_t* Ow = Ob + (long)(wide * QBLK + r32e) * LDO + 8 * hie;
#pragma unroll
    for (int d0 = 0; d0 < 4; ++d0)
#pragma unroll
      for (int gp = 0; gp < 2; ++gp) { const int r0 = gp * 8;
        unsigned a0 = cvtpk(o[d0][r0 + 0] * rl, o[d0][r0 + 1] * rl), a1 = cvtpk(o[d0][r0 + 2] * rl, o[d0][r0 + 3] * rl);
        unsigned b0 = cvtpk(o[d0][r0 + 4] * rl, o[d0][r0 + 5] * rl), b1 = cvtpk(o[d0][r0 + 6] * rl, o[d0][r0 + 7] * rl);
        auto s0 = __builtin_amdgcn_permlane32_swap(a0, b0, false, false); auto s1 = __builtin_amdgcn_permlane32_swap(a1, b1, false, false);
        const u32x4 w = {s0[0], s1[0], s0[1], s1[1]};
        *(GAS u32x4*)(Ow + d0 * 32 + gp * 16) = w; } }
#undef SLOAD
#undef SWRITE
#undef SWAIT
#undef RESC
}
#undef KSWZ8
#undef SBAR
__device__ __forceinline__ void attn_phase(LAS unsigned char* lds, const unsigned char* Qh, const unsigned char* Kh, const bf16_t* Vh, bf16_t* O, int bid, int nblk) {
  const int vcu = (nblk % 8 == 0) ? (bid % 8) * (nblk / 8) + bid / 8 : bid;
  for (int u = vcu; u < 1056; u += nblk) {
    const bool isctx = u >= 1024; const int bh = isctx ? u - 1024 : (u >> 5), qb = isctx ? 0 : (u & 31), b = bh >> 3, h = bh & 7;
    const long tokq = (long)b * LT + (isctx ? 0 : CTXL + qb * 256), tokk = (long)b * LT;
    attn_unit(Qh + tokq * LDQ + h * DQK, Kh + tokk * LDK + h * DQK, Vh + tokk * LDV + h * DV, O + tokq * LDO + h * DV, isctx ? CTXL : LT, lds);
    __syncthreads();
  }
}
}
namespace ret {
constexpr int NCH = LT / 128;
__device__ __forceinline__ float lg2_decay(const float* logit, int dir, int h) { return -log1pf(expf(-logit[dir * 4 + h])) * 1.4426950408889634f; }
struct PostP { const float* P; const float* COSR; const float* SINR; const float* logit; bf16_t* Q; bf16_t* Kb; bf16_t* KT; bf16_t* VT; bf16_t* GF; bf16_t* GB; };
__device__ __forceinline__ void ph_post(const PostP& p, int bid, int nblk) {
    const int tid_ = PH_TID, lane = tid_ & 63, gw = bid * 8 + (tid_ >> 6), NGW = nblk * 8;
    for (int grp = gw; grp < NTOK / 8; grp += NGW) {
        const int tok0 = grp * 8, b = tok0 / LT, s0 = tok0 % LT; const bool isctx = s0 < CTXL; const int p0 = s0 & 127;
        for (int i = 0; i < 8; ++i) {
            const int tok = tok0 + i; const float* pr = p.P + (size_t)tok * RIN; const int t = s0 + i - CTXL;
#pragma unroll
            for (int h = 0; h < 4; ++h)
#pragma unroll
                for (int jj = 0; jj < 2; ++jj) { const int d = lane + 64 * jj; const float x1 = pr[h * 256 + d], x2 = pr[h * 256 + 128 + d]; float o1 = x1, o2 = x2;
                    if (!isctx) { const float c = p.COSR[(size_t)t * 128 + d], sn = p.SINR[(size_t)t * 128 + d]; o1 = x1 * c - x2 * sn; o2 = x1 * sn + x2 * c; }
                    p.Q[(size_t)tok * 1024 + h * 256 + d] = (bf16_t)f2bf(o1); p.Q[(size_t)tok * 1024 + h * 256 + 128 + d] = (bf16_t)f2bf(o2); }
#pragma unroll
            for (int jj = 0; jj < 8; ++jj) { const int c4 = (lane + 64 * jj) * 4; const f32x4 gf = *(const f32x4*)(pr + 4096 + c4), gb = *(const f32x4*)(pr + 6144 + c4);
                u32x2 w; w.x = pk2(silu_f(gf.x), silu_f(gf.y)); w.y = pk2(silu_f(gf.z), silu_f(gf.w)); *(u32x2*)(p.GF + (size_t)tok * 2048 + c4) = w;
                w.x = pk2(silu_f(gb.x), silu_f(gb.y)); w.y = pk2(silu_f(gb.z), silu_f(gb.w)); *(u32x2*)(p.GB + (size_t)tok * 2048 + c4) = w; }
        }
#pragma unroll 1
        for (int h = 0; h < 4; ++h) {
            const float lf = lg2_decay(p.logit, 0, h), lb = lg2_decay(p.logit, 1, h);
#pragma unroll
            for (int jj = 0; jj < 2; ++jj) { const int d = lane + 64 * jj; float o1[8], o2[8];
#pragma unroll
                for (int i = 0; i < 8; ++i) { const float* pr = p.P + (size_t)(tok0 + i) * RIN + 1024 + h * 256; const float x1 = pr[d] * 0.0625f, x2 = pr[128 + d] * 0.0625f; o1[i] = x1; o2[i] = x2;
                    if (!isctx) { const int t = s0 + i - CTXL; const float c = p.COSR[(size_t)t * 128 + d], sn = p.SINR[(size_t)t * 128 + d]; o1[i] = x1 * c - x2 * sn; o2[i] = x1 * sn + x2 * c; }
                    p.Kb[(size_t)(tok0 + i) * 1024 + h * 256 + d] = (bf16_t)f2bf(o1[i]); p.Kb[(size_t)(tok0 + i) * 1024 + h * 256 + 128 + d] = (bf16_t)f2bf(o2[i]); }
#pragma unroll
                for (int dir = 0; dir < 2; ++dir) { float f[8];
#pragma unroll
                    for (int i = 0; i < 8; ++i) f[i] = dir ? exp2f((float)(p0 + i) * lb) : exp2f((float)(127 - p0 - i) * lf);
                    bf16_t* kt = p.KT + (((size_t)dir * 16 + b * 4 + h) * 256) * LT + s0;
                    u32x4 o; o.x = pk2(o1[0] * f[0], o1[1] * f[1]); o.y = pk2(o1[2] * f[2], o1[3] * f[3]); o.z = pk2(o1[4] * f[4], o1[5] * f[5]); o.w = pk2(o1[6] * f[6], o1[7] * f[7]);
                    *(u32x4*)(kt + (size_t)d * LT) = o;
                    o.x = pk2(o2[0] * f[0], o2[1] * f[1]); o.y = pk2(o2[2] * f[2], o2[3] * f[3]); o.z = pk2(o2[4] * f[4], o2[5] * f[5]); o.w = pk2(o2[6] * f[6], o2[7] * f[7]);
                    *(u32x4*)(kt + (size_t)(128 + d) * LT) = o; }
            }
        }
        for (int jj = 0; jj < 32; ++jj) { const int col = lane + 64 * jj; float vv[8];
#pragma unroll
            for (int i = 0; i < 8; ++i) vv[i] = p.P[(size_t)(tok0 + i) * RIN + 2048 + col];
            u32x4 o; o.x = pk2(vv[0], vv[1]); o.y = pk2(vv[2], vv[3]); o.z = pk2(vv[4], vv[5]); o.w = pk2(vv[6], vv[7]);
            *(u32x4*)(p.VT + ((size_t)b * 2048 + col) * LT + s0) = o; }
    }
}

struct EpiRetIn {
    static constexpr bool PERM = true, AFTER_DRAIN = false;
    bf16_t* Q; bf16_t* Kb; bf16_t* Vr; bf16_t* GF; bf16_t* GB; const float* COSR; const float* SINR;
    __device__ __forceinline__ void operator()(const pg8::f32x4 (&acc)[2][2][4][2], const pg8::Unit& u, int wr, int wc, int fr, int fq) const {
        const int t2 = ph_tid(), wd2 = t2 >> 6, ln2 = t2 & 63;
        const int row0 = u.pm * 256 + (wd2 >> 2) * 64 + (ln2 & 15), c8 = (wd2 & 3) * 32 + 8 * (ln2 >> 4);
        if (u.pc < 8) {
            const float sc = u.pc < 4 ? 1.0f : 0.0625f; bf16_t* dst = (u.pc < 4 ? Q : Kb) + (u.pc & 3) * 256 + c8;
#pragma unroll
            for (int ai = 0; ai < 2; ++ai)
#pragma unroll
                for (int m = 0; m < 4; ++m) { const int tok = row0 + ai * 128 + m * 16, s = tok % LT; const bool lat = s >= CTXL;
                    const unsigned ro = lat ? (unsigned)(s - CTXL) * 512u + (unsigned)c8 * 4u : 0u;
                    bf16_t* qd = dst + (size_t)tok * 1024;
#pragma unroll
                    for (int n = 0; n < 2; ++n) { pg8::f32x4 c = *(const pg8::f32x4*)((const char*)COSR + ro + 16 * n), sn = *(const pg8::f32x4*)((const char*)SINR + ro + 16 * n);
                        if (!lat) { c = (pg8::f32x4){1.f, 1.f, 1.f, 1.f}; sn = (pg8::f32x4){0.f, 0.f, 0.f, 0.f}; }
                        const pg8::f32x4 x1 = acc[ai][0][m][n] * sc, x2 = acc[ai][1][m][n] * sc, o1 = x1 * c - x2 * sn, o2 = x1 * sn + x2 * c;
                        u32x2 w; w.x = pk2(o1[0], o1[1]); w.y = pk2(o1[2], o1[3]); *(u32x2*)(qd + 4 * n) = w;
                        w.x = pk2(o2[0], o2[1]); w.y = pk2(o2[2], o2[3]); *(u32x2*)(qd + 128 + 4 * n) = w; } }
        } else if (u.pc < 16) {
            bf16_t* dst = Vr + (u.pc - 8) * 256 + c8;
#pragma unroll
            for (int ai = 0; ai < 2; ++ai)
#pragma unroll
                for (int m = 0; m < 4; ++m)
#pragma unroll
                    for (int bj = 0; bj < 2; ++bj) *(u32x4*)(dst + (size_t)(row0 + ai * 128 + m * 16) * 2048 + bj * 128) = pk8(acc[ai][bj][m][0], acc[ai][bj][m][1]);
        } else {
            bf16_t* dst = (u.pc < 24 ? GF : GB) + (u.pc & 7) * 256 + c8;
#pragma unroll
            for (int ai = 0; ai < 2; ++ai)
#pragma unroll
                for (int m = 0; m < 4; ++m)
#pragma unroll
                    for (int bj = 0; bj < 2; ++bj) { pg8::f32x4 a = acc[ai][bj][m][0], b = acc[ai][bj][m][1];
#pragma unroll
                        for (int e = 0; e < 4; ++e) { a[e] = a[e] * __builtin_amdgcn_rcpf(1.0f + __expf(-a[e])); b[e] = b[e] * __builtin_amdgcn_rcpf(1.0f + __expf(-b[e])); }
                        *(u32x4*)(dst + (size_t)(row0 + ai * 128 + m * 16) * 2048 + bj * 128) = pk8(a, b); }
        }
    }
};
__device__ __forceinline__ void in_phase(LAS unsigned char* lds, const bf16_t* H, const bf16_t* Wri, bf16_t* Q, bf16_t* Kb, bf16_t* Vr, bf16_t* GF, bf16_t* GB, const float* COSR, const float* SINR) {
    pg8::Gemm g{H, Wri, 1024, 1024, 1024}; pg8::StaticOrder S; S.init(NTOK, 8192, (int)gridDim.x, (int)blockIdx.x); EpiRetIn E{Q, Kb, Vr, GF, GB, COSR, SINR};
    pg8::gemm_phase<EpiRetIn, pg8::StaticOrder, true, true>(lds, g, S, E);
}
__device__ __forceinline__ void ph_tr(LAS unsigned char* lds, const bf16_t* Kb, const bf16_t* Vr, bf16_t* KT, bf16_t* VT, const float* logit, int bid, int nblk) {
    constexpr int PITCH = 520;
    const int tid = PH_TID, r = tid >> 3, c8 = tid & 7;
#define TR_SRC(it_, q_) (((it_) % 12 < 4 ? Kb + ((size_t)((it_) / (12 * 132)) * LT + (((it_) / 12) % 132) * 64) * 1024 + ((it_) % 12) * 256 + (size_t)r * 1024 \
                                        : Vr + ((size_t)((it_) / (12 * 132)) * LT + (((it_) / 12) % 132) * 64) * 2048 + ((it_) % 12 - 4) * 256 + (size_t)r * 2048) + (c8 + 8 * (q_)) * 8)
    u32x4 nxt[4];
    if (bid < NB * 132 * 12) {
#pragma unroll
        for (int q = 0; q < 4; ++q) nxt[q] = *(const u32x4*)TR_SRC(bid, q); }
    for (int it = bid; it < NB * 132 * 12; it += nblk) {
        const int cb = it % 12, tg = (it / 12) % 132, b = it / (12 * 132); const int s0 = tg * 64;
        const bool isk = cb < 4;
#pragma unroll
        for (int q = 0; q < 4; ++q) *(LAS u32x4*)(lds + r * PITCH + (c8 + 8 * q) * 16) = nxt[q];
        __syncthreads();
        if (it + nblk < NB * 132 * 12) {
#pragma unroll
            for (int q = 0; q < 4; ++q) nxt[q] = *(const u32x4*)TR_SRC(it + nblk, q); }
        const int g = tid & 7, sg = s0 + 8 * g;
        float ff[8], fb[8];
        if (isk) { const float lf = lg2_decay(logit, 0, cb), lb = lg2_decay(logit, 1, cb); const int p0 = sg & 127;
#pragma unroll
            for (int i = 0; i < 8; ++i) { ff[i] = exp2f((float)(127 - p0 - i) * lf); fb[i] = exp2f((float)(p0 + i) * lb); } }
#pragma unroll
        for (int q = 0; q < 4; ++q) { const int c = (tid >> 3) + 64 * q; float v[8];
#pragma unroll
            for (int i = 0; i < 8; ++i) v[i] = bf2f(*(const LAS unsigned short*)(lds + (8 * g + i) * PITCH + c * 2));
            if (isk) {
                u32x4 o; o.x = pk2(v[0] * ff[0], v[1] * ff[1]); o.y = pk2(v[2] * ff[2], v[3] * ff[3]); o.z = pk2(v[4] * ff[4], v[5] * ff[5]); o.w = pk2(v[6] * ff[6], v[7] * ff[7]);
                *(u32x4*)(KT + (((size_t)(b * 4 + cb)) * 256 + c) * LT + sg) = o;
                o.x = pk2(v[0] * fb[0], v[1] * fb[1]); o.y = pk2(v[2] * fb[2], v[3] * fb[3]); o.z = pk2(v[4] * fb[4], v[5] * fb[5]); o.w = pk2(v[6] * fb[6], v[7] * fb[7]);
                *(u32x4*)(KT + (((size_t)(16 + b * 4 + cb)) * 256 + c) * LT + sg) = o;
            } else {
                u32x4 o; o.x = pk2(v[0], v[1]); o.y = pk2(v[2], v[3]); o.z = pk2(v[4], v[5]); o.w = pk2(v[6], v[7]);
                *(u32x4*)(VT + ((size_t)b * 2048 + (cb - 4) * 256 + c) * LT + sg) = o;
            }
        }
        __syncthreads();
    }
}
#undef TR_SRC
struct StateOrder {      static constexpr bool GATHER = false;
    int G, c0;
    __device__ bool next(int i, pg8::Unit& u) const {
        const int L = i * G + c0; if (L >= 2 * NCH * 32) return false;
        const int mt = L & 1, q = L >> 1, c = q % NCH, bhd = q / NCH, bh = bhd >> 1, dir = bhd & 1;
        u.pm = bh * 2 + mt; u.pn = dir * 16 + bh; u.pc = L; u.ka = (unsigned)(c * 256); u.kb = (unsigned)(c * 256); return true;
    }
    __device__ __forceinline__ void a_ready(const pg8::Unit&) const {}
    __device__ __forceinline__ void done(const pg8::Unit&) const {}
};
struct EpiUT {
    static constexpr bool PERM = true, AFTER_DRAIN = false;
    unsigned char* UT;
    __device__ __forceinline__ void operator()(const pg8::f32x4 (&acc)[2][2][4][2], const pg8::Unit& u, int wr, int wc, int fr, int fq) const {
        const int L = u.pc, mt = L & 1, q = L >> 1;
        unsigned char* base = UT + ((size_t)q * 512 + mt * 256) * 256;
        unsigned lo = (unsigned)((wr * 64 + fr) * 256 + wc * 32 + 8 * fq); asm volatile("" : "+v"(lo));
#pragma unroll
        for (int ai = 0; ai < 2; ++ai)
#pragma unroll
            for (int m = 0; m < 4; ++m)
#pragma unroll
                for (int bj = 0; bj < 2; ++bj) { const pg8::f32x4 v0 = acc[ai][bj][m][0], v1 = acc[ai][bj][m][1]; u32x2 w; w.x = pk4_fp8(v0[0], v0[1], v0[2], v0[3]); w.y = pk4_fp8(v1[0], v1[1], v1[2], v1[3]);
                    *(u32x2*)(base + (lo + (unsigned)((ai * 128 + m * 16) * 256 + bj * 128))) = w; }
    }
};
__device__ __forceinline__ void state_phase(LAS unsigned char* lds, const bf16_t* VT, const bf16_t* KT, unsigned char* UT) {
    pg8::Gemm g{VT, KT, 128, LT, LT};
    StateOrder S{(int)gridDim.x, (int)blockIdx.x};
    EpiUT E{UT};
    pg8::gemm_phase<EpiUT, StateOrder, true, true>(lds, g, S, E);
}
__device__ __forceinline__ int scan_chunk(int dir, int k) { return dir == 0 ? k : (k < 2 ? 1 - k : NCH + 1 - k); }
__device__ __forceinline__ void ph_scan(const unsigned char* U8, bf16_t* ST, const float* logit, int bid, int nblk) {
    const long gt = bid * 512L + PH_TID, NG = nblk * 512L;
    for (long it = gt; it < 32L * 8192; it += NG) {
        const int bhd = (int)(it >> 13), e16 = (int)(it & 8191), dir = bhd & 1, h = (bhd >> 1) & 3;
        const float cd = exp2f(128.0f * lg2_decay(logit, dir, h));
        const unsigned char* ub = U8 + (size_t)bhd * NCH * 131072 + (size_t)e16 * 16; bf16_t* sb = ST + (size_t)bhd * NCH * 131072 + (size_t)e16 * 16;
        float run[16];
#pragma unroll
        for (int q = 0; q < 16; ++q) run[q] = 0.f;
        constexpr int PF = 6; u32x4 w[PF];
#pragma unroll
        for (int q = 0; q < PF; ++q) w[q] = *(const u32x4*)(ub + (size_t)scan_chunk(dir, q) * 131072);
#pragma unroll 1
        for (int k0 = 0; k0 < NCH; k0 += PF) {
#pragma unroll
            for (int q = 0; q < PF; ++q) { const int k = k0 + q; const int c = scan_chunk(dir, k); u32x4* ptr = (u32x4*)(sb + (size_t)c * 131072); const u32x4 ww = w[q];
                if (k + PF < NCH) w[q] = *(const u32x4*)(ub + (size_t)scan_chunk(dir, k + PF) * 131072);
                u32x4 o; o.x = pk2(run[0], run[1]); o.y = pk2(run[2], run[3]); o.z = pk2(run[4], run[5]); o.w = pk2(run[6], run[7]); ptr[0] = o;
                o.x = pk2(run[8], run[9]); o.y = pk2(run[10], run[11]); o.z = pk2(run[12], run[13]); o.w = pk2(run[14], run[15]); ptr[1] = o;
#pragma unroll
                for (int d = 0; d < 4; ++d) { const unsigned wd = d == 0 ? ww.x : (d == 1 ? ww.y : (d == 2 ? ww.z : ww.w)); const auto lo2 = __builtin_amdgcn_cvt_pk_f32_fp8(wd, false), hi2 = __builtin_amdgcn_cvt_pk_f32_fp8(wd, true);
                    run[4 * d + 0] = run[4 * d + 0] * cd + lo2[0]; run[4 * d + 1] = run[4 * d + 1] * cd + lo2[1]; run[4 * d + 2] = run[4 * d + 2] * cd + hi2[0]; run[4 * d + 3] = run[4 * d + 3] * cd + hi2[1]; } }
        }
    }
}
typedef float f32x16 __attribute__((ext_vector_type(16)));
constexpr int QROW = 528, PROW = 272, LDS_Q = 0, LDS_K = 128 * QROW, LDS_P = LDS_K, LDS_RET = 2 * 128 * QROW;
__device__ __forceinline__ int crow(int r, int hi) { return (r & 3) + 8 * (r >> 2) + 4 * hi; }
__device__ __forceinline__ void out_unit(LAS unsigned char* lds, const bf16_t* Qc, const bf16_t* Kc, const bf16_t* VTc, const bf16_t* STc, bf16_t* Oc, int dir, float lg) {
    const int tid = ph_tid(), wid = tid >> 6, lane = tid & 63, r32 = lane & 31, hi = lane >> 5;
    const GAS bf16_t* sa = (const GAS bf16_t*)(STc + (size_t)(wid * 64 + r32) * 256 + hi * 8);
    const GAS bf16_t* va = (const GAS bf16_t*)(VTc + (size_t)(wid * 64 + r32) * LT + hi * 8);
    bf16x8 A0[4], A1[4], N0[4], N1[4];
#define RO_LOAD(D0, D1, blk) do { _Pragma("unroll") for (int q = 0; q < 4; ++q) { if ((blk) < 4) { D0[q] = *(const GAS bf16x8*)(sa + ((blk) * 4 + q) * 16); D1[q] = *(const GAS bf16x8*)(sa + 32 * 256 + ((blk) * 4 + q) * 16); } \
        else { D0[q] = *(const GAS bf16x8*)(va + (((blk) - 4) * 4 + q) * 16); D1[q] = *(const GAS bf16x8*)(va + (size_t)32 * LT + (((blk) - 4) * 4 + q) * 16); } } } while (0)
    RO_LOAD(A0, A1, 0);
#pragma unroll
    for (int i = 0; i < 8; ++i) { const int id = tid + 512 * i, row = id >> 5, c16 = id & 31;
        *(LAS u32x4*)(lds + LDS_Q + row * QROW + c16 * 16) = *(const GAS u32x4*)(Qc + (size_t)row * 1024 + c16 * 8);
        *(LAS u32x4*)(lds + LDS_K + row * QROW + c16 * 16) = *(const GAS u32x4*)(Kc + (size_t)row * 1024 + c16 * 8); }
    __syncthreads();
    const int mtS = wid >> 1, nt0 = (wid & 1) * 2;
    f32x16 s0 = {}, s1 = {};
#pragma unroll
    for (int ks = 0; ks < 16; ++ks) { const int cb = (ks * 16 + hi * 8) * 2;
        const bf16x8 a = *(const LAS bf16x8*)(lds + LDS_K + (mtS * 32 + r32) * QROW + cb);
        const bf16x8 b0 = *(const LAS bf16x8*)(lds + LDS_Q + (nt0 * 32 + r32) * QROW + cb), b1 = *(const LAS bf16x8*)(lds + LDS_Q + (nt0 * 32 + 32 + r32) * QROW + cb);
        s0 = __builtin_amdgcn_mfma_f32_32x32x16_bf16(a, b0, s0, 0, 0, 0); s1 = __builtin_amdgcn_mfma_f32_32x32x16_bf16(a, b1, s1, 0, 0, 0); }
    __syncthreads();
#pragma unroll
    for (int t2 = 0; t2 < 2; ++t2) { const int i = (nt0 + t2) * 32 + r32;
#pragma unroll
        for (int rg = 0; rg < 4; ++rg) { float pv[4];
#pragma unroll
            for (int q = 0; q < 4; ++q) { const int r = rg * 4 + q, j = mtS * 32 + crow(r, hi); const float sv = t2 ? s1[r] : s0[r]; const int dist = dir ? j - i : i - j;
                pv[q] = dist >= 0 ? sv * exp2f((float)dist * lg) : 0.f; }
            u32x2 w; w.x = pk2(pv[0], pv[1]); w.y = pk2(pv[2], pv[3]);
            *(LAS u32x2*)(lds + LDS_P + i * PROW + (mtS * 32 + crow(rg * 4, hi)) * 2) = w; } }
    __syncthreads();
    f32x16 acc[2][4];
#pragma unroll
    for (int mt = 0; mt < 2; ++mt)
#pragma unroll
        for (int nt = 0; nt < 4; ++nt) acc[mt][nt] = f32x16{};
#pragma unroll
    for (int blk = 0; blk < 6; ++blk) {
        if (blk + 1 < 6) RO_LOAD(N0, N1, blk + 1);
        if (blk == 4) {
#pragma unroll
            for (int nt = 0; nt < 4; ++nt) { const int i = nt * 32 + r32; const float qd = exp2f((float)(dir ? 128 - i : i + 1) * lg);
#pragma unroll
                for (int mt = 0; mt < 2; ++mt)
#pragma unroll
                    for (int rr = 0; rr < 16; ++rr) acc[mt][nt][rr] *= qd; } }
#pragma unroll
        for (int q = 0; q < 4; ++q) {
#pragma unroll
            for (int nt = 0; nt < 4; ++nt) { const bf16x8 bq = blk < 4 ? *(const LAS bf16x8*)(lds + LDS_Q + (nt * 32 + r32) * QROW + ((blk * 4 + q) * 16 + hi * 8) * 2)
                                                                   : *(const LAS bf16x8*)(lds + LDS_P + (nt * 32 + r32) * PROW + (((blk - 4) * 4 + q) * 16 + hi * 8) * 2);
                acc[0][nt] = __builtin_amdgcn_mfma_f32_32x32x16_bf16(A0[q], bq, acc[0][nt], 0, 0, 0); acc[1][nt] = __builtin_amdgcn_mfma_f32_32x32x16_bf16(A1[q], bq, acc[1][nt], 0, 0, 0); } }
#pragma unroll
        for (int q = 0; q < 4; ++q) { A0[q] = N0[q]; A1[q] = N1[q]; }
    }
#undef RO_LOAD
#pragma unroll
    for (int nt = 0; nt < 4; ++nt) { bf16_t* orow = Oc + (size_t)(nt * 32 + r32) * 2048 + wid * 64;
#pragma unroll
        for (int mt = 0; mt < 2; ++mt)
#pragma unroll
            for (int rg = 0; rg < 4; ++rg) { u32x2 w; w.x = pk2(acc[mt][nt][rg * 4], acc[mt][nt][rg * 4 + 1]); w.y = pk2(acc[mt][nt][rg * 4 + 2], acc[mt][nt][rg * 4 + 3]);
                *(GAS u32x2*)(orow + mt * 32 + crow(rg * 4, hi)) = w; } }
    __syncthreads();
}
__device__ __forceinline__ void out_phase(LAS unsigned char* lds, const bf16_t* Q, const bf16_t* Kb, const bf16_t* VT, const bf16_t* ST, bf16_t* OFb, bf16_t* OBb, const float* logit, int bid, int nblk) {
    for (int u = bid; u < 32 * NCH; u += nblk) {
        const int c = u % NCH, bhd = u / NCH, dir = bhd & 1, bh = bhd >> 1, b = bh >> 2, h = bh & 3;
        const size_t tok0 = (size_t)b * LT + c * 128;
        out_unit(lds, Q + tok0 * 1024 + h * 256, Kb + tok0 * 1024 + h * 256, VT + ((size_t)b * 2048 + h * 512) * LT + c * 128, ST + ((size_t)bhd * NCH + c) * 131072,
                 (dir ? OBb : OFb) + tok0 * 2048 + h * 512, dir, lg2_decay(logit, dir, h));
    }
}
struct GateP { const bf16_t* OF; const bf16_t* OB; const bf16_t* GF; const bf16_t* GB; const float* gn; bf16_t* Y; };
__device__ __forceinline__ void ph_gate(const GateP& p, int bid, int nblk) {
    const int tid_ = PH_TID, lane = tid_ & 63, gw = bid * 8 + (tid_ >> 6), NGW = nblk * 8;
    for (int tok = gw; tok < NTOK; tok += NGW) {
#pragma unroll
        for (int h = 0; h < 4; ++h) {
            const int c0 = h * 512 + lane * 8; float yo[8];
#pragma unroll
            for (int dir = 0; dir < 2; ++dir) {
                const u32x4 ow = *(const u32x4*)((dir ? p.OB : p.OF) + (size_t)tok * 2048 + c0);
                float v[8] = {bflo(ow.x), bfhi(ow.x), bflo(ow.y), bfhi(ow.y), bflo(ow.z), bfhi(ow.z), bflo(ow.w), bfhi(ow.w)}; float sm = 0.f;
#pragma unroll
                for (int q = 0; q < 8; ++q) sm += v[q];
                const float mu = wave_sum(sm) * (1.0f / 512.0f); float sq = 0.f;
#pragma unroll
                for (int q = 0; q < 8; ++q) { v[q] -= mu; sq += v[q] * v[q]; }
                const float rstd = rsqrtf(wave_sum(sq) * (1.0f / 512.0f) + GN_EPS);
                const u32x4 gw4 = *(const u32x4*)((dir ? p.GB : p.GF) + (size_t)tok * 2048 + c0);
                const float g[8] = {bflo(gw4.x), bfhi(gw4.x), bflo(gw4.y), bfhi(gw4.y), bflo(gw4.z), bfhi(gw4.z), bflo(gw4.w), bfhi(gw4.w)};
                const float* gnp = p.gn + dir * 2048 + c0;
#pragma unroll
                for (int q = 0; q < 8; ++q) { const float t = g[q] * (v[q] * rstd * gnp[q]); yo[q] = dir ? yo[q] + t : t; }
            }
            u32x4 o; o.x = pk2(yo[0], yo[1]); o.y = pk2(yo[2], yo[3]); o.z = pk2(yo[4], yo[5]); o.w = pk2(yo[6], yo[7]);
            *(u32x4*)(p.Y + (size_t)tok * 2048 + c0) = o;
        }
    }
}
}
__device__ __forceinline__ int opq(int v) { asm volatile("" : "+s"(v)); return v; }
template <int OFF> __device__ __forceinline__ const void* lds_ptr() { unsigned a; asm volatile("v_mov_b32 %0, %1" : "=v"(a) : "i"(OFF)); volatile LAS unsigned* p = (volatile LAS unsigned*)(unsigned long long)a; unsigned lo = p[0], hi = p[1]; lo = __builtin_amdgcn_readfirstlane(lo); hi = __builtin_amdgcn_readfirstlane(hi); return (const void*)(((unsigned long long)hi << 32) | lo); }
__device__ __forceinline__ unsigned char* ws_ptr(unsigned char* ws, size_t off) { unsigned char* b = ws; asm volatile("" : "+s"(b)); return b + off; }
#define GRID_BAR() xcd_barrier(bar)
#define INP(i) ((const float*)lds_ptr<LDS_MISC + 256 + 8 * (i)>())
#define WSP(T, off) ((T*)ws_ptr(ws, (off)))
#define I_x INP(0)
#define I_c INP(1)
#define I_ctx INP(2)
#define I_c_ctx INP(3)
#define I_ret_w_in INP(4)
#define I_ret_decay INP(5)
#define I_ret_gn INP(6)
#define I_ret_w_out INP(7)
#define I_mla_w_in INP(8)
#define I_mla_qn INP(9)
#define I_mla_kvn INP(10)
#define I_mla_w_uq INP(11)
#define I_mla_w_ukv INP(12)
#define I_mla_w_out INP(13)
#define I_ada_w INP(14)
#define I_ada_b INP(15)
#define I_norm_mix INP(16)
#define I_norm_ffn INP(17)
#define I_router_w INP(18)
#define I_router_b INP(19)
#define I_exp_w_up INP(20)
#define I_exp_b_up INP(21)
#define I_exp_w_down INP(22)
#define I_exp_b_down INP(23)
#define I_final_norm INP(24)
#define W_MOD WSP(float, WS_MOD)
#define W_COSR WSP(float, WS_COSR)
#define W_SINR WSP(float, WS_SINR)
#define W_COSM WSP(float, WS_COSM)
#define W_SINM WSP(float, WS_SINM)
#define W_TOKINFO WSP(int, WS_TOKINFO)
#define W_LIST WSP(int, WS_LIST)
#define W_PLAN WSP(int, WS_PLAN)
#define W_WRI WSP(bf16_t, WS_WRI)
#define W_WRO WSP(bf16_t, WS_WRO)
#define W_WMI WSP(bf16_t, WS_WMI)
#define W_WUQ WSP(bf16_t, WS_WUQ)
#define W_WUKV WSP(bf16_t, WS_WUKV)
#define W_WMO WSP(bf16_t, WS_WMO)
#define W_WUP WSP(bf16_t, WS_WUP)
#define W_WDN WSP(bf16_t, WS_WDN)
#define W_X WSP(float, WS_X)
#define W_H WSP(bf16_t, WS_H)
#define W_RA WSP(unsigned char, WS_RA)
#define W_RB WSP(unsigned char, WS_RB)
#define W_RC WSP(unsigned char, WS_RC)
#define W_Z WSP(float, WS_RC)
#define W_YD WSP(bf16_t, WS_RC + (size_t)NTOK * D * 4)
#define W_CNT (WSP(int, WS_CTL) + CW_CNT)
template <int LAYER> __device__ __forceinline__ void layer_body(LAS unsigned char* lds, unsigned char* ws, const XcdBarrier& bar, int bid, int nblk) {
        constexpr int layer = LAYER; constexpr int j = layer >> 1; constexpr bool last = layer == DEPTH - 1;
        const float* modl = W_MOD + (size_t)layer * 5 * 6144;
        { RowP p{}; p.x_in = I_x; p.ctx_in = I_ctx; p.X = W_X; p.H = W_H; p.normw = I_norm_mix + layer * D; p.shiftv = modl + 0 * 1024; p.scalev = modl + 1 * 1024;
          if constexpr (layer == 0) ph_rowphase<RP_FIRST>(lds, p, opq(bid), opq(nblk));
          else { p.YD = W_YD; p.tokinfo = W_TOKINFO; p.planprev = W_PLAN + (layer - 1) * 1024; p.gvec = W_MOD + (size_t)(layer - 1) * 5 * 6144 + 5 * 1024; p.skip_ctx = 0;
                 ph_rowphase<RP_ADD_MOE>(lds, p, opq(bid), opq(nblk)); } }
        GRID_BAR();
        if constexpr ((layer & 1) == 0) {
            bf16_t* Q = (bf16_t*)W_RB; bf16_t* Kb = Q + (size_t)NTOK * 1024; bf16_t* VT = Kb + (size_t)NTOK * 1024; bf16_t* GF = VT + (size_t)NTOK * 2048; bf16_t* GB = GF + (size_t)NTOK * 2048;
            bf16_t* KT = GB + (size_t)NTOK * 2048; bf16_t* OFb = KT + (size_t)NTOK * 2048; bf16_t* OBb = OFb + (size_t)NTOK * 2048; bf16_t* Y = Q; bf16_t* UT = (bf16_t*)W_RA;
            bf16_t* Vr = OFb;
            ret::in_phase(lds, W_H, W_WRI + (size_t)j * 8192 * 1024, Q, Kb, Vr, GF, GB, W_COSR, W_SINR);
            ct_slot<(layer == 0 ? 0 : 5)>(I_exp_w_up, I_exp_w_down, (unsigned char*)W_WUP, (unsigned char*)W_WDN, bid);
            GRID_BAR();
            ret::ph_tr(lds, Kb, Vr, KT, VT, I_ret_decay + j * 8, opq(bid), opq(nblk));
            GRID_BAR();
            unsigned char* U8 = (unsigned char*)(UT + (size_t)32 * ret::NCH * 131072);
            ret::state_phase(lds, VT, KT, U8);
            GRID_BAR();
            ret::ph_scan(U8, UT, I_ret_decay + j * 8, opq(bid), opq(nblk));
            GRID_BAR();
            ret::out_phase(lds, Q, Kb, VT, UT, OFb, OBb, I_ret_decay + j * 8, opq(bid), opq(nblk));
            ct_slot<(layer == 0 ? 1 : 6)>(I_exp_w_up, I_exp_w_down, (unsigned char*)W_WUP, (unsigned char*)W_WDN, bid);
            GRID_BAR();
            { ret::GateP p{OFb, OBb, GF, GB, I_ret_gn + (size_t)j * 2 * 2048, Y}; ret::ph_gate(p, opq(bid), opq(nblk)); }
            GRID_BAR();
            resid_gemm_phase(lds, Y, W_WRO + (size_t)j * 1024 * 2048, 2048, W_X, modl + 2 * 1024);
            ct_slot<(layer == 0 ? 2 : 7)>(I_exp_w_up, I_exp_w_down, (unsigned char*)W_WUP, (unsigned char*)W_WDN, bid);
            GRID_BAR();
        } else {
            float* Pm = (float*)W_RA; float* QF = Pm + (size_t)NTOK * MINP; float* KVF = QF + (size_t)NTOK * 1536; float* S = KVF + (size_t)NTOK * 2048; bf16_t* Pa = (bf16_t*)(S + (size_t)SEQ * LT);
            bf16_t* CQ = (bf16_t*)W_RB; bf16_t* CKV = CQ + (size_t)NTOK * 384; float* KR = (float*)(CKV + (size_t)NTOK * 256); bf16_t* Qp = (bf16_t*)(KR + (size_t)NTOK * 64);
            bf16_t* Kp = Qp + (size_t)NTOK * 2048; bf16_t* VT = Kp + (size_t)NTOK * 2048; float* OFm = (float*)(VT + (size_t)NTOK * 2048); bf16_t* O = (bf16_t*)(OFm + (size_t)NTOK * 2048);
            gemm_f32_phase(lds, W_H, W_WMI + (size_t)j * MINP * 1024, Pm, NTOK, MINP, 1024, 1024, 1024, MINP);
            GRID_BAR();
            { MlaPost2P p{Pm, I_mla_qn + j * 384, I_mla_kvn + j * 256, W_COSM, W_SINM, CQ, CKV, (unsigned char*)Kp}; ph_mla_post2(p, opq(bid), opq(nblk)); }
            GRID_BAR();
            mla_q_phase(lds, CQ, W_WUQ + (size_t)j * 1536 * 384, (unsigned char*)Qp, W_COSM, W_SINM);
            mla_kv_phase(lds, CKV, W_WUKV + (size_t)j * 2048 * 256, (unsigned char*)Kp, VT);
            ct_slot<(layer == 1 ? 3 : 8)>(I_exp_w_up, I_exp_w_down, (unsigned char*)W_WUP, (unsigned char*)W_WDN, bid);
            GRID_BAR();
            att::attn_phase(lds, (const unsigned char*)Qp, (const unsigned char*)Kp, VT, O, opq(bid), opq(nblk));
            GRID_BAR();
            resid_gemm_phase(lds, O, W_WMO + (size_t)j * 1024 * 1024, 1024, W_X, modl + 2 * 1024);
            ct_slot<(layer == 1 ? 4 : 9)>(I_exp_w_up, I_exp_w_down, (unsigned char*)W_WUP, (unsigned char*)W_WDN, bid);
            GRID_BAR();
        }
        { RowP p{}; p.X = W_X; p.H = W_H; p.normw = I_norm_ffn + layer * D; p.shiftv = modl + 3 * 1024; p.scalev = modl + 4 * 1024;
          p.router_w = I_router_w + (size_t)layer * 1024 * 32; p.router_b = I_router_b + layer * 32; p.cnt = W_CNT + layer * 32; p.tokinfo_out = W_TOKINFO; p.list = W_LIST; p.skip_ctx = last ? 1 : 0;
          ph_rowrouter(lds, p, opq(bid), opq(nblk)); }
        if constexpr (layer > 0) ct_drain<layer>(I_exp_w_up, I_exp_w_down, (unsigned char*)W_WUP, (unsigned char*)W_WDN, opq(bid), opq(nblk));
        GRID_BAR();
        int* plan = W_PLAN + layer * 1024;
        unsigned char* ACT = (unsigned char*)W_RB;
        moe_up_phase(lds, (const unsigned char*)W_H, (const unsigned char*)W_WUP + (size_t)layer * NE * 2048 * 1024, ACT, I_exp_b_up + (size_t)layer * NE * 2048, W_CNT + layer * 32, plan, W_LIST);
        GRID_BAR();
        moe_down_phase(lds, ACT, (const unsigned char*)W_WDN + (size_t)layer * NE * 1024 * 1024, W_YD, I_exp_b_down + (size_t)layer * NE * 1024, plan);
        GRID_BAR();
}
struct Params { const float* in[25]; float* out; unsigned char* ws; };
__global__ void __launch_bounds__(512, 2) mega_fwd(Params P) {
    extern __shared__ __attribute__((aligned(16))) unsigned char lds_raw[];
    LAS unsigned char* lds = (LAS unsigned char*)lds_raw;
    const int bid = (int)blockIdx.x, nblk = (int)gridDim.x;
    volatile LAS unsigned* MISC = (volatile LAS unsigned*)(lds + LDS_MISC);
    { const int t0 = (int)threadIdx.x; if (t0 < 64) MISC[t0] = 0u; if ((t0 & 63) == 0) *(volatile LAS unsigned*)(lds + LDS_WVTAB + hw_wave_slot() * 4u) = (unsigned)(t0 >> 6); }
    __syncthreads();
    const int tid = PH_TID;
    unsigned char* ws = P.ws;
    unsigned* CTL = (unsigned*)(ws + WS_CTL);
    XcdBarrier bar = xcd_barrier_post(CTL + CW_BAR, MISC + 8);
    volatile LAS unsigned* INL = MISC + 64;
    if (tid == 0) {
#define ST_IN(i) { const unsigned long long v = (unsigned long long)P.in[i]; INL[2 * (i)] = (unsigned)v; INL[2 * (i) + 1] = (unsigned)(v >> 32); }
        ST_IN(0) ST_IN(1) ST_IN(2) ST_IN(3) ST_IN(4) ST_IN(5) ST_IN(6) ST_IN(7) ST_IN(8) ST_IN(9) ST_IN(10) ST_IN(11) ST_IN(12)
        ST_IN(13) ST_IN(14) ST_IN(15) ST_IN(16) ST_IN(17) ST_IN(18) ST_IN(19) ST_IN(20) ST_IN(21) ST_IN(22) ST_IN(23) ST_IN(24)
#undef ST_IN
        { const unsigned long long v = (unsigned long long)P.out; INL[50] = (unsigned)v; INL[51] = (unsigned)(v >> 32); }
    }
    __syncthreads();
    ph_transpose_direct<0>(I_ret_w_in, W_WRI, 1024, 8192, 1024, 2, (long)1024 * 8192, (long)8192 * 1024, opq(bid), opq(nblk));
    ph_transpose(lds, I_ret_w_out, W_WRO, 2048, 1024, 2048, 2, (long)2048 * 1024, (long)1024 * 2048, opq(bid), opq(nblk));
    ph_transpose<2>(lds, I_mla_w_uq, W_WUQ, 384, 1536, 384, 2, (long)384 * 1536, (long)1536 * 384, opq(bid), opq(nblk));
    ph_transpose(lds, I_mla_w_ukv, W_WUKV, 256, 2048, 256, 2, (long)256 * 2048, (long)2048 * 256, opq(bid), opq(nblk));
    ph_transpose(lds, I_mla_w_out, W_WMO, 1024, 1024, 1024, 2, (long)1024 * 1024, (long)1024 * 1024, opq(bid), opq(nblk));
    ph_transpose_direct8<1>(I_exp_w_up, (unsigned char*)W_WUP, 1024, 2048, 1024, NE, (long)1024 * 2048, (long)2048 * 1024, opq(bid), opq(nblk));
    ph_transpose_direct8<0>(I_exp_w_down, (unsigned char*)W_WDN, 1024, 1024, 1024, NE, (long)1024 * 1024, (long)1024 * 1024, opq(bid), opq(nblk));
    ph_adaln(lds, I_c, I_c_ctx, I_ada_w, I_ada_b, W_MOD, opq(bid), opq(nblk));
    ph_rot_tables(W_COSR, W_SINR, W_COSM, W_SINM, opq(bid), opq(nblk));
    __syncthreads();
    ph_transpose<3>(lds, I_mla_w_in, W_WMI, 1024, MIN_, 1024, 2, (long)1024 * MIN_, (long)MINP * 1024, opq(bid), opq(nblk));
    GRID_BAR();
    layer_body<0>(lds, ws, bar, bid, nblk);
    layer_body<1>(lds, ws, bar, bid, nblk);
    layer_body<2>(lds, ws, bar, bid, nblk);
    layer_body<3>(lds, ws, bar, bid, nblk);
    { RowP p{}; p.X = W_X; p.out = (float*)lds_ptr<LDS_MISC + 256 + 8 * 25>(); p.YD = W_YD; p.tokinfo = W_TOKINFO; p.planprev = W_PLAN + (DEPTH - 1) * 1024; p.gvec = W_MOD + (size_t)(DEPTH - 1) * 5 * 6144 + 5 * 1024; p.normw = I_final_norm; p.skip_ctx = 1;
      ph_rowphase<RP_ADD_MOE | RP_FINAL>(lds, p, opq(bid), opq(nblk)); }
#undef GRID_BAR
}
#undef I_x
#undef I_c
#undef I_ctx
#undef I_c_ctx
#undef I_ret_w_in
#undef I_ret_decay
#undef I_ret_gn
#undef I_ret_w_out
#undef I_mla_w_in
#undef I_mla_qn
#undef I_mla_kvn
#undef I_mla_w_uq
#undef I_mla_w_ukv
#undef I_mla_w_out
#undef I_ada_w
#undef I_ada_b
#undef I_norm_mix
#undef I_norm_ffn
#undef I_router_w
#undef I_router_b
#undef I_exp_w_up
#undef I_exp_b_up
#undef I_exp_w_down
#undef I_exp_b_down
#undef I_final_norm
#undef W_MOD
#undef W_COSR
#undef W_SINR
#undef W_COSM
#undef W_SINM
#undef W_TOKINFO
#undef W_LIST
#undef W_PLAN
#undef W_WRI
#undef W_WRO
#undef W_WMI
#undef W_WUQ
#undef W_WUKV
#undef W_WMO
#undef W_WUP
#undef W_WDN
#undef W_X
#undef W_H
#undef W_RA
#undef W_RB
#undef W_RC
#undef W_Z
#undef W_YD
#undef W_CNT
#undef INP
#undef WSP

extern "C" void kernel_launch(void* const* d_in, const int* in_sizes, int n_in, void* d_out, int out_size, void* d_ws, size_t ws_size, hipStream_t stream) {
    static int ok = 0;
    if (ok == 0) {
        if (n_in != 25 || ws_size < WS_END) { fprintf(stderr, "kernel_launch: bad shapes n_in %d ws %zu need %zu\n", n_in, ws_size, (size_t)WS_END); ok = -1; return; }
        if (hipFuncSetAttribute((const void*)mega_fwd, hipFuncAttributeMaxDynamicSharedMemorySize, LDS_BYTES) != hipSuccess) { fprintf(stderr, "kernel_launch: hipFuncSetAttribute failed\n"); ok = -1; return; }
        ok = 1;
    }
    if (ok < 0) return;
    (void)hipMemsetAsync((char*)d_ws + WS_CTL, 0, CTL_BYTES, stream);
    Params p{};
    for (int i = 0; i < 25; ++i) p.in[i] = (const float*)d_in[i];
    p.out = (float*)d_out; p.ws = (unsigned char*)d_ws;
    hipLaunchKernelGGL(mega_fwd, dim3(256), dim3(512), LDS_BYTES, stream, p);
}
```
